# Optimizing an MI355X kernel written in HIP

```python
import math, functools
import jax, jax.numpy as jnp
from jax import lax
import numpy as np

D_MODEL = 2048
BATCH = 32
SEQ = 256
DEPTH = 4
DEC_BATCH = 2
DEC_SEQ = 1024
PAST_LEN = 512

GRID_W = 64
HEAD_DIM = 128
N_HEADS_A = 8
W_A = N_HEADS_A * HEAD_DIM
GROUP_DIM = 128
N_GROUPS_F = 4
W_F = N_GROUPS_F * GROUP_DIM
N_GROUPS_C = 4
W_C = N_GROUPS_C * GROUP_DIM
CHUNK = 128
MAX_WIN_R = 8
WIN_C = 16
QBLK = 128
D_FF = 4 * D_MODEL
N_MOD = 6
IN_WIDTH = 3 * W_A + W_F + 2 * W_C + 3 * D_MODEL
RMS_EPS = 1e-6

kernel_name = "hybrid_natten_fnet_gmlp_diffusion_step"


def _rmsnorm(x, g):
    x32 = x.astype(jnp.float32)
    y = x32 * lax.rsqrt(jnp.mean(x32 * x32, axis=-1, keepdims=True) + RMS_EPS)
    return (y * g.astype(jnp.float32)).astype(x.dtype)


def _context_attention(q, k, v):
    B, S, H, hd = q.shape
    scale = 1.0 / math.sqrt(hd)
    qb = q.reshape(B, S // QBLK, QBLK, H, hd).transpose(1, 0, 2, 3, 4)

    def one_block(qi):
        s = jnp.einsum('bqhd,bkhd->bhqk', qi, k).astype(jnp.float32) * scale
        p = jax.nn.softmax(s, axis=-1).astype(v.dtype)
        return jnp.einsum('bhqk,bkhd->bqhd', p, v)

    o = lax.map(one_block, qb)
    return o.transpose(1, 0, 2, 3, 4).reshape(B, S, H * hd)


def _neighbourhood_attention(q, k, v, ck, cv, rpb):
    B, N, H, hd = q.shape
    rows = N // GRID_W
    win_r = min(MAX_WIN_R, rows)
    scale = 1.0 / math.sqrt(hd)
    r = jnp.arange(rows)
    r_start = jnp.clip(r - win_r // 2, 0, rows - win_r)
    row_idx = r_start[:, None] + jnp.arange(win_r)[None, :]
    qc = jnp.arange(GRID_W)
    c_start = jnp.clip(qc - WIN_C // 2, 0, GRID_W - WIN_C)
    kc = jnp.arange(GRID_W)
    col_valid = (kc[None, :] >= c_start[:, None]) & (kc[None, :] < c_start[:, None] + WIN_C)
    dr = row_idx - r[:, None] + (MAX_WIN_R - 1)
    dc = jnp.clip(kc[None, :] - qc[:, None], -(WIN_C - 1), WIN_C - 1) + (WIN_C - 1)
    bias = rpb[:, dr[:, None, :, None], dc[None, :, None, :]]
    bias = bias.transpose(1, 2, 0, 3, 4).astype(jnp.float32)

    qg = q.reshape(B, rows, GRID_W, H, hd)
    kg = k.reshape(B, rows, GRID_W, H, hd)
    vg = v.reshape(B, rows, GRID_W, H, hd)
    k_rows = kg[:, row_idx]
    v_rows = vg[:, row_idx]

    s_lat = jnp.einsum('brqhd,brikhd->brqhik', qg, k_rows).astype(jnp.float32) * scale + bias[None]
    s_lat = jnp.where(col_valid[None, None, :, None, None, :], s_lat, -jnp.inf)
    s_ctx = jnp.einsum('brqhd,blhd->brqhl', qg, ck).astype(jnp.float32) * scale
    n_lat = win_r * GRID_W
    s = jnp.concatenate([s_lat.reshape(B, rows, GRID_W, H, n_lat), s_ctx], axis=-1)
    p = jax.nn.softmax(s, axis=-1).astype(v.dtype)
    p_lat = p[..., :n_lat].reshape(B, rows, GRID_W, H, win_r, GRID_W)
    p_ctx = p[..., n_lat:]
    o = (jnp.einsum('brqhik,brikhd->brqhd', p_lat, v_rows)
         + jnp.einsum('brqhl,blhd->brqhd', p_ctx, cv))
    return o.reshape(B, N, H * hd)


def _fourier_mix(f):
    B, N, _ = f.shape
    fg = f.reshape(B, N, N_GROUPS_F, GROUP_DIM).astype(jnp.float32)
    y = jnp.fft.fft2(fg, axes=(1, 3), norm='ortho').real
    return y.astype(f.dtype).reshape(B, N, W_F)


def _spatial_gating(uv, g_sgu, w_sp, b_sp):
    B, N, _ = uv.shape
    uv = jax.nn.gelu(uv, approximate=False)
    u, v = jnp.split(uv, 2, axis=-1)
    v = _rmsnorm(v.reshape(B, N, N_GROUPS_C, GROUP_DIM), g_sgu)
    vc = v.reshape(B, N // CHUNK, CHUNK, N_GROUPS_C, GROUP_DIM)
    s = jnp.einsum('gpq,bcqgd->bcpgd', w_sp, vc) + b_sp.T[:, :, None]
    return u * s.reshape(B, N, W_C)


def _layer(x, mod, attend, w_in, w_br_a, w_br_f, w_br_c, w_out, g_sgu, w_sp, b_sp,
           g_pre_mix, g_post_mix, g_pre_mlp, g_post_mlp, w1, w2):
    sh1, sc1, gt1, sh2, sc2, gt2 = jnp.split(mod, N_MOD, axis=-1)
    B, N, _ = x.shape
    h = _rmsnorm(x, g_pre_mix) * (1.0 + sc1) + sh1
    proj = h @ w_in
    splits = (W_A, 2 * W_A, 3 * W_A, 3 * W_A + W_F, 3 * W_A + W_F + 2 * W_C,
              3 * W_A + W_F + 2 * W_C + D_MODEL, 3 * W_A + W_F + 2 * W_C + 2 * D_MODEL)
    q, k, v, f, uv, ga, gf, gc = jnp.split(proj, splits, axis=-1)
    q = q.reshape(B, N, N_HEADS_A, HEAD_DIM)
    k = k.reshape(B, N, N_HEADS_A, HEAD_DIM)
    v = v.reshape(B, N, N_HEADS_A, HEAD_DIM)
    o_a = attend(q, k, v)
    o_f = _fourier_mix(f)
    o_c = _spatial_gating(uv, g_sgu, w_sp, b_sp)
    merged = (jax.nn.sigmoid(ga) * (o_a @ w_br_a)
              + jax.nn.sigmoid(gf) * (o_f @ w_br_f)
              + jax.nn.sigmoid(gc) * (o_c @ w_br_c))
    x = x + gt1 * _rmsnorm(merged @ w_out, g_post_mix)
    h = _rmsnorm(x, g_pre_mlp) * (1.0 + sc2) + sh2
    ff = jnp.square(jax.nn.relu(h @ w1)) @ w2
    x = x + gt2 * _rmsnorm(ff, g_post_mlp)
    return x, k, v


def setup_inputs(seed: int = 0) -> dict:
    key = jax.random.key(seed)
    ks = jax.random.split(key, 32)

    def nrm(k, shape, scale):
        return jax.random.normal(k, shape, jnp.float32) * scale

    def gain(k, shape):
        return 1.0 + 0.02 * jax.random.normal(k, shape, jnp.float32)

    return {
        "x_prompt": nrm(ks[0], (BATCH, SEQ, D_MODEL), 1.0),
        "x_sample": nrm(ks[1], (DEC_BATCH, DEC_SEQ, D_MODEL), 1.0),
        "cache_k": nrm(ks[2], (DEC_BATCH, DEPTH, PAST_LEN, N_HEADS_A, HEAD_DIM), 1.0),
        "cache_v": nrm(ks[3], (DEC_BATCH, DEPTH, PAST_LEN, N_HEADS_A, HEAD_DIM), 1.0),
        "c": nrm(ks[4], (DEC_BATCH, D_MODEL), 1.0),
        "c_ctx": nrm(ks[5], (D_MODEL,), 1.0),
        "w_ada": nrm(ks[6], (DEPTH, D_MODEL, N_MOD * D_MODEL), 0.5 * D_MODEL ** -0.5),
        "b_ada": nrm(ks[7], (DEPTH, N_MOD * D_MODEL), 0.02),
        "g_pre_mix": gain(ks[8], (DEPTH, D_MODEL)),
        "g_post_mix": gain(ks[9], (DEPTH, D_MODEL)),
        "g_pre_mlp": gain(ks[10], (DEPTH, D_MODEL)),
        "g_post_mlp": gain(ks[11], (DEPTH, D_MODEL)),
        "w_in": nrm(ks[12], (DEPTH, D_MODEL, IN_WIDTH), D_MODEL ** -0.5),
        "rpb": nrm(ks[13], (DEPTH, N_HEADS_A, 2 * MAX_WIN_R - 1, 2 * WIN_C - 1), 0.5),
        "g_sgu": gain(ks[14], (DEPTH, N_GROUPS_C, GROUP_DIM)),
        "w_spatial": nrm(ks[15], (DEPTH, N_GROUPS_C, CHUNK, CHUNK), CHUNK ** -0.5),
        "b_spatial": gain(ks[16], (DEPTH, N_GROUPS_C, CHUNK)),
        "w_br_a": nrm(ks[17], (DEPTH, W_A, D_MODEL), W_A ** -0.5),
        "w_br_f": nrm(ks[18], (DEPTH, W_F, D_MODEL), W_F ** -0.5),
        "w_br_c": nrm(ks[19], (DEPTH, W_C, D_MODEL), W_C ** -0.5),
        "w_out": nrm(ks[20], (DEPTH, D_MODEL, D_MODEL), D_MODEL ** -0.5),
        "w_mlp1": nrm(ks[21], (DEPTH, D_MODEL, D_FF), D_MODEL ** -0.5),
        "w_mlp2": nrm(ks[22], (DEPTH, D_FF, D_MODEL), D_FF ** -0.5),
    }


def reference(x_prompt, x_sample, cache_k, cache_v, c, c_ctx, w_ada, b_ada,
              g_pre_mix, g_post_mix, g_pre_mlp, g_post_mlp, w_in, rpb, g_sgu,
              w_spatial, b_spatial, w_br_a, w_br_f, w_br_c, w_out, w_mlp1, w_mlp2):
    y_p = x_prompt
    y_s = x_sample
    silu_ctx = jax.nn.silu(c_ctx)
    silu_c = jax.nn.silu(c)
    new_k, new_v = [], []
    for l in range(DEPTH):
        shared = (w_in[l], w_br_a[l], w_br_f[l], w_br_c[l], w_out[l], g_sgu[l],
                  w_spatial[l], b_spatial[l], g_pre_mix[l], g_post_mix[l],
                  g_pre_mlp[l], g_post_mlp[l], w_mlp1[l], w_mlp2[l])
        mod_ctx = silu_ctx @ w_ada[l] + b_ada[l]
        mod_lat = (silu_c @ w_ada[l] + b_ada[l])[:, None, :]
        y_p, k_l, v_l = _layer(y_p, mod_ctx, _context_attention, *shared)
        new_k.append(k_l)
        new_v.append(v_l)
        attend_lat = functools.partial(_neighbourhood_attention, ck=cache_k[:, l],
                                       cv=cache_v[:, l], rpb=rpb[l])
        y_s, _, _ = _layer(y_s, mod_lat, attend_lat, *shared)
    new_cache_k = jnp.stack(new_k, axis=1)
    new_cache_v = jnp.stack(new_v, axis=1)
    return (y_p, y_s, new_cache_k, new_cache_v)
```

```cpp
#include <hip/hip_runtime.h>
#include <cstdio>
#include <cstdint>

#ifndef MK_PER_PHASE
#define MK_PER_PHASE 0
#endif

#define LAS __attribute__((address_space(3)))
#define GAS __attribute__((address_space(1)))
typedef unsigned short bf16_t;
typedef short bf16x8 __attribute__((ext_vector_type(8)));
typedef short s16x4 __attribute__((ext_vector_type(4)));
typedef float f32x2 __attribute__((ext_vector_type(2)));
typedef float f32x4 __attribute__((ext_vector_type(4)));
typedef float f32x16 __attribute__((ext_vector_type(16)));
typedef unsigned u32x2 __attribute__((ext_vector_type(2)));
typedef unsigned u32x4 __attribute__((ext_vector_type(4)));

constexpr int D = 2048, M_CTX = 8192, M_LAT = 2048, M = M_CTX + M_LAT, DEPTH = 4;
constexpr int IN_W = 10752, D_FF = 8192, P2W = 7680;
constexpr int P2_F = 0, P2_U = 512, P2_V = 1024, P2_GA = 1536, P2_GF = 3584, P2_GC = 5632;
constexpr int OB_A = 0, OB_F = 1024, OB_C = 1536;
constexpr float RMS_EPS = 1e-6f;
constexpr size_t OUT_YS = (size_t)M_CTX * D, OUT_CK = (size_t)M * D, OUT_CV = OUT_CK + (size_t)32 * 4 * 256 * 1024;

constexpr size_t MiB = 1u << 20;
constexpr size_t WS_CTL = 0, CTL_BYTES = MiB;
constexpr size_t SZ_WIN = (size_t)IN_W * D * 2, SZ_WSQ = (size_t)D * D * 2, SZ_W1 = (size_t)D_FF * D * 2;
constexpr size_t WS_WIN = CTL_BYTES;
constexpr size_t WS_WBR = WS_WIN + 4 * SZ_WIN;
constexpr size_t WS_WOUT = WS_WBR + 4 * SZ_WSQ;
constexpr size_t WS_W1 = WS_WOUT + 4 * SZ_WSQ;
constexpr size_t WS_W2 = WS_W1 + 4 * SZ_W1;
constexpr size_t WS_TW256 = WS_W2 + 4 * SZ_W1;
constexpr size_t WS_TW1024 = WS_TW256 + 256 * 512 * 2;
constexpr size_t WS_WF = WS_TW1024 + 1024 * 2048 * 2;
constexpr size_t WS_WSP = WS_WF + 1024 * 512 * 2;
constexpr size_t WS_CK = WS_WSP + 4 * 4 * 128 * 128 * 2;
constexpr size_t WS_CV = WS_CK + (size_t)2 * 4 * 512 * 1024 * 2;
constexpr size_t WS_MOD = WS_CV + (size_t)2 * 4 * 512 * 1024 * 2;
constexpr size_t WS_H = ((WS_MOD + 4 * 3 * 12288 * 4) + 4095) & ~(size_t)4095;
constexpr size_t WS_QKV = WS_H + (size_t)M * D * 2;
constexpr size_t WS_P2 = WS_QKV + (size_t)3 * M * 1024 * 2;
constexpr size_t WS_FF1 = WS_QKV;
constexpr size_t WS_TT = WS_P2 + (size_t)M * P2W * 2;
constexpr size_t WS_TTL = WS_TT + (size_t)32 * 4 * 128 * 512 * 2;
constexpr size_t WS_OBR = WS_TT + (size_t)M * 1024 * 2;
constexpr size_t WS_MRG = WS_OBR + (size_t)M * D * 2;
constexpr size_t WS_MIX = WS_MRG + (size_t)M * D * 2;
constexpr size_t WS_END = WS_MIX + (size_t)M * D * 4;
static_assert((size_t)M * D_FF * 2 <= (size_t)3 * M * 1024 * 2 + (size_t)M * P2W * 2, "FF1 overlay fits");
constexpr int CW_BAR = 4096;

constexpr int RING_BYTES = 131072, MISC_OFF = RING_BYTES + 320, LDS_BYTES = 147456;

#define LDS_WAIT() asm volatile("s_waitcnt lgkmcnt(0)" ::: "memory")
#define VM_WAIT() asm volatile("s_waitcnt vmcnt(0)" ::: "memory")

__device__ __forceinline__ unsigned cvt_pk_bf16(float lo, float hi) { unsigned r; asm volatile("v_cvt_pk_bf16_f32 %0, %1, %2" : "=v"(r) : "v"(lo), "v"(hi)); return r; }
__device__ __forceinline__ float bf2f(unsigned short h) { return __uint_as_float((unsigned)h << 16); }
__device__ __forceinline__ float bflo(unsigned w) { return __uint_as_float(w << 16); }
__device__ __forceinline__ float bfhi(unsigned w) { return __uint_as_float(w & 0xffff0000u); }
__device__ __forceinline__ float shx(float v, int o, int lane) { return __int_as_float(__builtin_amdgcn_ds_bpermute((lane ^ o) << 2, __float_as_int(v))); }
__device__ __forceinline__ float wave_sum(float v, int lane) {
#pragma unroll
    for (int o = 1; o < 64; o <<= 1) v += shx(v, o, lane);
    return v;
}

namespace pg8 {
constexpr int BM = 256, BK = 64, HALF = 128, HTB = HALF * BK * 2, STAGE_BYTES = 8 * HTB, NXCD = 8, WGM = 8;
__host__ __device__ __forceinline__ int lds_byte(int r, int c) { const int st = (r >> 4) * 2 + (c >> 5), rr = r & 15, cc = c & 31, ob = rr * 64 + cc * 2; return st * 1024 + (ob ^ (((ob >> 9) & 1) << 5)); }
__host__ __device__ __forceinline__ void stage_rc(int b, int& R, int& C) { const int st = b / 1024, sb = b % 1024, swz = sb ^ (((sb >> 9) & 1) << 5); R = (st >> 1) * 16 + swz / 64; C = (st & 1) * 32 + (swz % 64) / 2; }
__host__ __device__ __forceinline__ int perm32(int rho) { const int n = rho >> 4, i = rho & 15; return 8 * (i >> 2) + 4 * n + (i & 3); }

struct Unit { int pm, pn; const char* a; const char* b; };
struct Dims { int lda, ldb, K; };

struct TileOrder {
    const char* A; const char* Bt; size_t tA, tB; int nM, nN, nwg, G, c;
    __device__ __forceinline__ void init(const void* A_, size_t lda, const void* Bt_, size_t ldb, int M_, int N_, int G_, int c_) {
        A = (const char*)A_; Bt = (const char*)Bt_; tA = (size_t)BM * lda * 2; tB = (size_t)BM * ldb * 2; nM = M_ / BM; nN = N_ / BM; nwg = nM * nN; G = G_; c = c_; }
    __device__ __forceinline__ bool next(int i, Unit& u) const {
        const long L = (long)i * G + c; if (c < 0 || L >= nwg) return false;
        int wgid = (int)L; { const int q = nwg / NXCD, r = nwg % NXCD, xcd = wgid % NXCD, off = wgid / NXCD; wgid = (xcd < r ? xcd * (q + 1) : r * (q + 1) + (xcd - r) * q) + off; }
        const int nig = WGM * nN, gid = wgid / nig, fm = gid * WGM, gsz = (nM - fm) < WGM ? (nM - fm) : WGM;
        u.pm = fm + ((wgid % nig) % gsz); u.pn = (wgid % nig) / gsz; u.a = A + (size_t)u.pm * tA; u.b = Bt + (size_t)u.pn * tB; return true;
    }
};
struct BatchOrder {
    const char* A; const char* Bt; size_t tA, tB, bB; int nM, nN, nB, G, c, rt0;
    __device__ __forceinline__ bool next(int i, Unit& u) const {
        const long L = (long)i * G + c; if (c < 0 || L >= (long)nB * nM * nN) return false;
        const int b = (int)L / (nM * nN), r = (int)L % (nM * nN), pm = r / nN, pn = r % nN;
        u.a = A + (size_t)pm * tA; u.b = Bt + (size_t)b * bB + (size_t)pn * tB; u.pm = rt0 + b * nM + pm; u.pn = pn; return true;
    }
};

__device__ __forceinline__ f32x2 gelu_pk(f32x2 v) {
    const f32x2 av = __builtin_elementwise_abs(v), d = av * 0.2316418882f + 1.0f;
    f32x2 t; t.x = __builtin_amdgcn_rcpf(d.x); t.y = __builtin_amdgcn_rcpf(d.y);
    f32x2 q = t * 0.5307027145f + (-0.7265760135f); q = q * t + 0.7107068705f; q = q * t + (-0.142248368f); q = q * t + 0.127414796f; q = q * t;
    const f32x2 s = (v * v) * (-0.72134752044f);
    f32x2 e; e.x = __builtin_amdgcn_exp2f(s.x); e.y = __builtin_amdgcn_exp2f(s.y);
    const f32x2 m = v * (q * e), r = v - m;
    f32x2 o; o.x = v.x < 0.f ? m.x : r.x; o.y = v.y < 0.f ? m.y : r.y; return o;
}
__device__ __forceinline__ float sigmoidf_(float x) { return __builtin_amdgcn_rcpf(1.0f + __builtin_amdgcn_exp2f(-1.4426950408889634f * x)); }

typedef f32x4 Acc[2][2][4][2];
__device__ __forceinline__ u32x4 pack8(f32x4 v0, f32x4 v1) { u32x4 w; w.x = cvt_pk_bf16(v0[0], v0[1]); w.y = cvt_pk_bf16(v0[2], v0[3]); w.z = cvt_pk_bf16(v1[0], v1[1]); w.w = cvt_pk_bf16(v1[2], v1[3]); return w; }

struct EpiProj {
    static constexpr bool PERM = true;
    bf16_t* QKV; bf16_t* P2; float* ck; float* cv;
    __device__ __forceinline__ void operator()(const Acc& acc, const Unit& u, int wr, int wc, int fr, int fq) const {
        const int row0 = u.pm * BM + wr * 64 + fr, colw = wc * 32 + 8 * fq, pn = u.pn;
        if (pn < 12) {
            const int t = pn >> 2, cb = (pn & 3) * 256 + colw;
            bf16_t* base = QKV + (size_t)t * M * 1024 + cb;
            float* cbase = (t == 1 ? ck : cv) + cb;
            const bool wc_ = (t >= 1) && (u.pm < 32);
#pragma unroll
            for (int ai = 0; ai < 2; ++ai)
#pragma unroll
                for (int m = 0; m < 4; ++m) { const int row = row0 + ai * HALF + m * 16;
#pragma unroll
                    for (int bj = 0; bj < 2; ++bj) { const f32x4 v0 = acc[ai][bj][m][0], v1 = acc[ai][bj][m][1];
                        *(u32x4*)(base + (size_t)row * 1024 + bj * HALF) = pack8(v0, v1);
                        if (wc_) { float* cp = cbase + ((size_t)(row >> 8) * 1024 + (row & 255)) * 1024 + bj * HALF; *(f32x4*)cp = v0; *(f32x4*)(cp + 4) = v1; } } }
        } else {
            const int act = pn < 14 ? 0 : (pn < 18 ? 1 : 2);
            bf16_t* base = P2 + (pn - 12) * 256 + colw;
#pragma unroll
            for (int ai = 0; ai < 2; ++ai)
#pragma unroll
                for (int m = 0; m < 4; ++m) { const int row = row0 + ai * HALF + m * 16;
#pragma unroll
                    for (int bj = 0; bj < 2; ++bj) { f32x4 v0 = acc[ai][bj][m][0], v1 = acc[ai][bj][m][1];
                        if (act == 1) { f32x2 a = gelu_pk((f32x2){v0[0], v0[1]}), b = gelu_pk((f32x2){v0[2], v0[3]}), c = gelu_pk((f32x2){v1[0], v1[1]}), d = gelu_pk((f32x2){v1[2], v1[3]});
                            v0 = (f32x4){a.x, a.y, b.x, b.y}; v1 = (f32x4){c.x, c.y, d.x, d.y}; }
                        else if (act == 2) {
#pragma unroll
                            for (int e = 0; e < 4; ++e) { v0[e] = sigmoidf_(v0[e]); v1[e] = sigmoidf_(v1[e]); } }
                        *(u32x4*)(base + (size_t)row * P2W + bj * HALF) = pack8(v0, v1); } }
        }
    }
};
struct EpiTT {
    static constexpr bool PERM = true;
    bf16_t* TTC; bf16_t* TTL;
    __device__ __forceinline__ void operator()(const Acc& acc, const Unit& u, int wr, int wc, int fr, int fq) const {
        const int g = u.pm, tok0 = u.pn * BM + wc * 32 + 8 * fq;
#pragma unroll
        for (int bj = 0; bj < 2; ++bj) { const int tok = tok0 + bj * HALF;
            bf16_t* colp; int rs, js;
            if (tok < M_CTX) { const int b = tok >> 8, n1 = tok & 255; colp = TTC + ((size_t)(b * 4 + g) * 128) * 512 + n1; rs = 512; js = 256; }
            else { const int tl = tok - M_CTX, b = tl >> 10, n1 = tl & 1023; colp = TTL + ((size_t)(b * 4 + g) * 128) * 2048 + n1; rs = 2048; js = 1024; }
#pragma unroll
            for (int ai = 0; ai < 2; ++ai)
#pragma unroll
                for (int m = 0; m < 4; ++m) { const int k2 = wr * 64 + m * 16 + fr;
                    *(u32x4*)(colp + (size_t)k2 * rs + ai * js) = pack8(acc[ai][bj][m][0], acc[ai][bj][m][1]); } }
    }
};
struct EpiFour2 {
    static constexpr bool PERM = true;
    bf16_t* OBR; float scale;
    __device__ __forceinline__ void operator()(const Acc& acc, const Unit& u, int wr, int wc, int fr, int fq) const {
        const int row0 = u.pm * BM + wr * 64 + fr, col0 = OB_F + u.pn * BM + wc * 32 + 8 * fq;
#pragma unroll
        for (int ai = 0; ai < 2; ++ai)
#pragma unroll
            for (int m = 0; m < 4; ++m) { bf16_t* rowp = OBR + (size_t)(row0 + ai * HALF + m * 16) * D + col0;
#pragma unroll
                for (int bj = 0; bj < 2; ++bj) *(u32x4*)(rowp + bj * HALF) = pack8(acc[ai][bj][m][0] * scale, acc[ai][bj][m][1] * scale); }
    }
};
template <int SEG> struct EpiBranch {
    static constexpr bool PERM = true;
    const bf16_t* gate; float* T; bf16_t* MRG;
    __device__ __forceinline__ void operator()(const Acc& acc, const Unit& u, int wr, int wc, int fr, int fq) const {
        const int row0 = u.pm * BM + wr * 64 + fr, col0 = u.pn * BM + wc * 32 + 8 * fq;
#pragma unroll
        for (int ai = 0; ai < 2; ++ai)
#pragma unroll
            for (int m = 0; m < 4; ++m) { const size_t row = (size_t)(row0 + ai * HALF + m * 16);
#pragma unroll
                for (int bj = 0; bj < 2; ++bj) { const int col = col0 + bj * HALF;
                    const u32x4 gw = *(const u32x4*)(gate + row * P2W + col);
                    f32x4 v0 = acc[ai][bj][m][0], v1 = acc[ai][bj][m][1];
                    v0 = v0 * (f32x4){bflo(gw.x), bfhi(gw.x), bflo(gw.y), bfhi(gw.y)}; v1 = v1 * (f32x4){bflo(gw.z), bfhi(gw.z), bflo(gw.w), bfhi(gw.w)};
                    float* tp = T + row * D + col;
                    if (SEG > 0) { v0 = v0 + *(const f32x4*)tp; v1 = v1 + *(const f32x4*)(tp + 4); }
                    if (SEG < 2) { *(f32x4*)tp = v0; *(f32x4*)(tp + 4) = v1; }
                    else *(u32x4*)(MRG + row * D + col) = pack8(v0, v1); } }
    }
};
struct EpiF32 {
    static constexpr bool PERM = false;
    float* O; int ldc;
    __device__ __forceinline__ void operator()(const Acc& acc, const Unit& u, int wr, int wc, int fr, int fq) const {
        const int row0 = u.pm * BM + wr * 64 + fr, col0 = u.pn * BM + wc * 32 + 4 * fq;
#pragma unroll
        for (int ai = 0; ai < 2; ++ai)
#pragma unroll
            for (int m = 0; m < 4; ++m) { float* rowp = O + (size_t)(row0 + ai * HALF + m * 16) * ldc + col0;
#pragma unroll
                for (int bj = 0; bj < 2; ++bj)
#pragma unroll
                    for (int n = 0; n < 2; ++n) *(f32x4*)(rowp + bj * HALF + n * 16) = acc[ai][bj][m][n]; }
    }
};
struct EpiRelu2 {
    static constexpr bool PERM = true;
    bf16_t* O; int ldc;
    __device__ __forceinline__ void operator()(const Acc& acc, const Unit& u, int wr, int wc, int fr, int fq) const {
        const int row0 = u.pm * BM + wr * 64 + fr, col0 = u.pn * BM + wc * 32 + 8 * fq;
#pragma unroll
        for (int ai = 0; ai < 2; ++ai)
#pragma unroll
            for (int m = 0; m < 4; ++m) { bf16_t* rowp = O + (size_t)(row0 + ai * HALF + m * 16) * ldc + col0;
#pragma unroll
                for (int bj = 0; bj < 2; ++bj) { f32x4 v0 = acc[ai][bj][m][0], v1 = acc[ai][bj][m][1];
#pragma unroll
                    for (int e = 0; e < 4; ++e) { const float a = fmaxf(v0[e], 0.f), b = fmaxf(v1[e], 0.f); v0[e] = a * a; v1[e] = b * b; }
                    *(u32x4*)(rowp + bj * HALF) = pack8(v0, v1); } }
    }
};

template <class Epi, class Sched, bool ALIGN_EPI>
__device__ __forceinline__ void gemm_phase(LAS unsigned char* lds, const Dims g, const Sched& S, const Epi& E) {
    int tid_ = threadIdx.x; asm volatile("" : "+v"(tid_));
    const int tid = tid_, wid = __builtin_amdgcn_readfirstlane(tid >> 6), lane = tid & 63, wr = wid >> 2, wc = wid & 3, fr = lane & 15, fq = lane >> 4;
    const int nt = g.K / BK;
    unsigned voffA[2], voffB[2];
#pragma unroll
    for (int i = 0; i < 2; ++i) { int R, C; stage_rc(tid * 16 + i * 8192, R, C); const int Rb = Epi::PERM ? ((R & ~31) + perm32(R & 31)) : R;
        voffA[i] = (unsigned)(R * g.lda + C) * 2u; voffB[i] = (unsigned)(Rb * g.ldb + C) * 2u; }
    const size_t kstep = (size_t)(BK * 2);
    const size_t hA = (size_t)HALF * g.lda * 2, hB = (size_t)HALF * g.ldb * 2;
    const unsigned ldsw = (unsigned)wid * 1024u;
    const int aoff = lds_byte(wr * 64 + fr, fq * 8), boff = lds_byte(wc * 32 + fr, fq * 8);
#define PG8_SA(b, h) (((b) * 2 + (h)) * HTB)
#define PG8_SB(b, h) ((4 + (b) * 2 + (h)) * HTB)
#define PG8_STAGE(bufoff, gbase, voff) do { _Pragma("unroll") for (int _i = 0; _i < 2; ++_i) \
        __builtin_amdgcn_global_load_lds((const unsigned*)((const char*)(gbase) + (voff)[_i]), (LAS unsigned*)(lds + (bufoff) + ldsw + _i * 8192), 16, 0, 0); } while (0)
#define PG8_LDA(dst, b, h) do { _Pragma("unroll") for (int m = 0; m < 4; ++m) _Pragma("unroll") for (int k = 0; k < 2; ++k) dst[m][k] = *(const LAS bf16x8*)(lds + PG8_SA(b, h) + aoff + m * 2048 + k * 1024); } while (0)
#define PG8_LDB(dst, b, h) do { _Pragma("unroll") for (int n = 0; n < 2; ++n) _Pragma("unroll") for (int k = 0; k < 2; ++k) dst[n][k] = *(const LAS bf16x8*)(lds + PG8_SB(b, h) + boff + n * 2048 + k * 1024); } while (0)
#define PG8_MMA(ai, bj, At, Bt) do { __builtin_amdgcn_s_setprio(1); _Pragma("unroll") for (int m = 0; m < 4; ++m) _Pragma("unroll") for (int n = 0; n < 2; ++n) _Pragma("unroll") for (int k = 0; k < 2; ++k) \
        acc[ai][bj][m][n] = __builtin_amdgcn_mfma_f32_16x16x32_bf16(Bt[n][k], At[m][k], acc[ai][bj][m][n], 0, 0, 0); __builtin_amdgcn_s_setprio(0); } while (0)
#define PG8_WAIT_V(n) asm volatile("s_waitcnt vmcnt(" #n ")" ::: "memory")
#define PG8_WAIT_L(n) asm volatile("s_waitcnt lgkmcnt(" #n ")" ::: "memory")
#define PG8_BAR __builtin_amdgcn_s_barrier()
#define PG8_SCHED __builtin_amdgcn_sched_barrier(0)
    Unit cur, nxt; int ui = 0;
    if (!S.next(0, cur)) return;
    Acc acc;
#pragma unroll
    for (int a = 0; a < 2; ++a)
#pragma unroll
        for (int b = 0; b < 2; ++b)
#pragma unroll
            for (int m = 0; m < 4; ++m)
#pragma unroll
                for (int n = 0; n < 2; ++n) acc[a][b][m][n] = (f32x4){0.f, 0.f, 0.f, 0.f};
    bf16x8 At[4][2], B0[2][2], B1[2][2];
    const char* cA = cur.a; const char* cB = cur.b;
    PG8_STAGE(PG8_SB(0, 0), cB, voffB); PG8_STAGE(PG8_SB(0, 1), cB + hB, voffB); PG8_STAGE(PG8_SA(0, 0), cA, voffA); PG8_STAGE(PG8_SA(0, 1), cA + hA, voffA);
    if (wr == 1) PG8_BAR;
    PG8_WAIT_V(2); PG8_BAR;
    PG8_STAGE(PG8_SB(1, 0), cB + kstep, voffB); PG8_STAGE(PG8_SA(1, 0), cA + kstep, voffA); PG8_STAGE(PG8_SB(1, 1), cB + hB + kstep, voffB);
    PG8_WAIT_V(6); PG8_BAR;
    for (;;) {
        const bool has_next = S.next(ui + 1, nxt);
        const char* nA = has_next ? nxt.a : cA; const char* nB = has_next ? nxt.b : cB;
        for (int t = 0; t < nt; t += 2) {
            const bool last = (t == nt - 2);
            const char* a1 = cA + (size_t)(t + 1) * kstep;
            const char* a2 = last ? nA : cA + (size_t)(t + 2) * kstep; const char* b2 = last ? nB : cB + (size_t)(t + 2) * kstep;
            const char* a3 = a2 + kstep; const char* b3 = b2 + kstep;
            PG8_LDB(B0, 0, 0); PG8_LDB(B1, 0, 1); PG8_SCHED; PG8_LDA(At, 0, 0); PG8_STAGE(PG8_SA(1, 1), a1 + hA, voffA);
            PG8_WAIT_V(8); PG8_WAIT_L(0); PG8_BAR; PG8_MMA(0, 0, At, B0); PG8_MMA(0, 1, At, B1); PG8_BAR; PG8_SCHED;
            PG8_LDA(At, 0, 1); PG8_STAGE(PG8_SB(0, 0), b2, voffB); PG8_STAGE(PG8_SB(0, 1), b2 + hB, voffB); PG8_STAGE(PG8_SA(0, 0), a2, voffA);
            PG8_WAIT_V(8); PG8_WAIT_L(0); PG8_BAR; PG8_MMA(1, 0, At, B0); PG8_MMA(1, 1, At, B1); PG8_BAR; PG8_SCHED;
            PG8_LDB(B0, 1, 0); PG8_LDB(B1, 1, 1); PG8_SCHED; PG8_LDA(At, 1, 0); PG8_STAGE(PG8_SA(0, 1), a2 + hA, voffA);
            PG8_WAIT_V(8); PG8_WAIT_L(0); PG8_BAR; PG8_MMA(0, 0, At, B0); PG8_MMA(0, 1, At, B1); PG8_BAR; PG8_SCHED;
            PG8_LDA(At, 1, 1); PG8_STAGE(PG8_SB(1, 0), b3, voffB); PG8_STAGE(PG8_SB(1, 1), b3 + hB, voffB); PG8_STAGE(PG8_SA(1, 0), a3, voffA);
            PG8_WAIT_V(8); PG8_WAIT_L(0); PG8_BAR; PG8_MMA(1, 0, At, B0); PG8_MMA(1, 1, At, B1); PG8_BAR; PG8_SCHED;
        }
        if constexpr (ALIGN_EPI) { if (wr == 0) PG8_BAR; }
        E(acc, cur, wr, wc, fr, fq);
        if (!has_next) break;
#pragma unroll
        for (int a = 0; a < 2; ++a)
#pragma unroll
            for (int b = 0; b < 2; ++b)
#pragma unroll
                for (int m = 0; m < 4; ++m)
#pragma unroll
                    for (int n = 0; n < 2; ++n) acc[a][b][m][n] = (f32x4){0.f, 0.f, 0.f, 0.f};
        cur = nxt; cA = nA; cB = nB; ++ui;
        if constexpr (ALIGN_EPI) { if (wr == 1) PG8_BAR; }
    }
    PG8_WAIT_V(0);
    if constexpr (!ALIGN_EPI) { if (wr == 0) PG8_BAR; }
    PG8_BAR;
#undef PG8_SA
#undef PG8_SB
#undef PG8_STAGE
#undef PG8_LDA
#undef PG8_LDB
#undef PG8_MMA
#undef PG8_WAIT_V
#undef PG8_WAIT_L
#undef PG8_BAR
#undef PG8_SCHED
}
}

namespace att {
constexpr int NW = 8, QBLK = 32, KVBLK = 64, LD = 1024, LDO = D;
constexpr float SCALE = 0.088388347648318440f, THR = 8.f;
constexpr int SHM_V = KVBLK * 128 * 2, SHM_K = KVBLK * 128 * 2, OFF_WS = 2 * SHM_V + 2 * SHM_K, OFF_RPB = OFF_WS + NW * 64 * 4, ATT_LDS = OFF_RPB + 2048;
#define KSWZ(row, colB) ((row) * 256 + ((colB) ^ (((row) & 7) << 4)))
#define SBAR() __builtin_amdgcn_sched_barrier(0)
__device__ __forceinline__ int crow(int r, int hi) { return (r & 3) + 8 * (r >> 2) + 4 * hi; }
__device__ __forceinline__ bf16x8 ld8(const bf16_t* p) { return *reinterpret_cast<const bf16x8*>(p); }

__device__ __forceinline__ void partialSM(f32x16& p0, f32x16& p1, float& m_reg, float& mn, float& alpha) {
  constexpr float C = SCALE * 1.4426950408889634f;
  float pmax = p0[0];
#pragma unroll
  for (int r = 1; r < 16; ++r) pmax = fmaxf(pmax, p0[r]);
#pragma unroll
  for (int r = 0; r < 16; ++r) pmax = fmaxf(pmax, p1[r]);
  { auto rr = __builtin_amdgcn_permlane32_swap(__float_as_uint(pmax), __float_as_uint(pmax), false, false);
    pmax = fmaxf(__uint_as_float(rr[0]), __uint_as_float(rr[1])); }
  if (__builtin_expect(__all(pmax - m_reg <= THR / SCALE), 1)) { mn = m_reg; alpha = 1.f; }
  else { mn = fmaxf(m_reg, pmax); alpha = __builtin_amdgcn_exp2f((m_reg - mn) * C); m_reg = mn; }
  float mnC = -mn * C;
#pragma unroll
  for (int r = 0; r < 16; ++r) p0[r] = fmaf(p0[r], C, mnC);
#pragma unroll
  for (int r = 0; r < 16; ++r) p1[r] = fmaf(p1[r], C, mnC);
#pragma unroll
  for (int r = 0; r < 16; ++r) p0[r] = __builtin_amdgcn_exp2f(p0[r]);
}
__device__ __forceinline__ void finishSM(f32x16& p0, f32x16& p1, float alpha, float& l_reg, bf16x8& pa0, bf16x8& pa1, bf16x8& pa2, bf16x8& pa3) {
#pragma unroll
  for (int r = 0; r < 16; ++r) p1[r] = __builtin_amdgcn_exp2f(p1[r]);
  float ps = 0;
#pragma unroll
  for (int r = 0; r < 16; ++r) ps += p0[r];
#pragma unroll
  for (int r = 0; r < 16; ++r) ps += p1[r];
  { auto rr = __builtin_amdgcn_permlane32_swap(__float_as_uint(ps), __float_as_uint(ps), false, false);
    ps = __uint_as_float(rr[0]) + __uint_as_float(rr[1]); }
  l_reg = l_reg * alpha + ps;
#define PK4(P, BASE, OUT) do { unsigned a0 = cvt_pk_bf16(P[BASE + 0], P[BASE + 1]), a1 = cvt_pk_bf16(P[BASE + 2], P[BASE + 3]);   \
    unsigned b0 = cvt_pk_bf16(P[BASE + 4], P[BASE + 5]), b1 = cvt_pk_bf16(P[BASE + 6], P[BASE + 7]);                              \
    auto r0 = __builtin_amdgcn_permlane32_swap(a0, b0, false, false); auto r1 = __builtin_amdgcn_permlane32_swap(a1, b1, false, false); \
    u32x4 w = {r0[0], r1[0], r0[1], r1[1]}; OUT = *reinterpret_cast<bf16x8*>(&w); } while (0)
  PK4(p0, 0, pa0); PK4(p0, 8, pa1); PK4(p1, 0, pa2); PK4(p1, 8, pa3);
#undef PK4
}
__device__ __forceinline__ void qkt(f32x16& p0, f32x16& p1, const char* Ks, const bf16x8* qr, int r32, int hi) {
  p0 = f32x16{}; p1 = f32x16{};
#pragma unroll
  for (int d0 = 0; d0 < 8; ++d0) { int cb = (d0 * 16 + hi * 8) * 2;
    bf16x8 b0 = *reinterpret_cast<const bf16x8*>(Ks + KSWZ(r32, cb));
    bf16x8 b1 = *reinterpret_cast<const bf16x8*>(Ks + KSWZ(32 + r32, cb));
    p0 = __builtin_amdgcn_mfma_f32_32x32x16_bf16(b0, qr[d0], p0, 0, 0, 0);
    p1 = __builtin_amdgcn_mfma_f32_32x32x16_bf16(b1, qr[d0], p1, 0, 0, 0); }
}
__device__ __forceinline__ int v_st(int k, int c) { const int kk = (k & ~0xC) | ((k & 4) << 1) | ((k & 8) >> 1); return ((kk >> 3) * 4 + (c >> 5)) * 512 + ((kk & 7) * 32 + (c & 31)) * 2; }
__device__ __forceinline__ int v_rd_base(int lane) { return ((lane & 3) << 3) | (((lane >> 2) & 3) << 6) | (((lane >> 4) & 1) << 5) | (((lane >> 5) & 1) << 8); }
constexpr int v_rd_off(int d0, int ks, int half) { return d0 * 512 + ks * 4096 + half * 2048; }
template <int OFF> __device__ __forceinline__ s16x4 tr_read(int vb) {
  s16x4 r; asm volatile("ds_read_b64_tr_b16 %0, %1 offset:%2" : "=&v"(r) : "v"(vb), "i"(OFF) : "memory"); return r;
}
template <int D0> __device__ __forceinline__ void pv_one(f32x16& od, int vb, bf16x8 pa0, bf16x8 pa1, bf16x8 pa2, bf16x8 pa3) {
  const s16x4 l0 = tr_read<v_rd_off(D0, 0, 0)>(vb), h0 = tr_read<v_rd_off(D0, 0, 1)>(vb), l1 = tr_read<v_rd_off(D0, 1, 0)>(vb), h1 = tr_read<v_rd_off(D0, 1, 1)>(vb);
  const s16x4 l2 = tr_read<v_rd_off(D0, 2, 0)>(vb), h2 = tr_read<v_rd_off(D0, 2, 1)>(vb), l3 = tr_read<v_rd_off(D0, 3, 0)>(vb), h3 = tr_read<v_rd_off(D0, 3, 1)>(vb);
  asm volatile("s_waitcnt lgkmcnt(0)" ::: "memory"); SBAR();
#define PK(L, H) (bf16x8){L[0], L[1], L[2], L[3], H[0], H[1], H[2], H[3]}
  od = __builtin_amdgcn_mfma_f32_32x32x16_bf16(pa0, PK(l0, h0), od, 0, 0, 0);
  od = __builtin_amdgcn_mfma_f32_32x32x16_bf16(pa1, PK(l1, h1), od, 0, 0, 0);
  od = __builtin_amdgcn_mfma_f32_32x32x16_bf16(pa2, PK(l2, h2), od, 0, 0, 0);
  od = __builtin_amdgcn_mfma_f32_32x32x16_bf16(pa3, PK(l3, h3), od, 0, 0, 0);
#undef PK
}
__device__ __forceinline__ void pv_d0(f32x16* o, int vb, bf16x8 pa0, bf16x8 pa1, bf16x8 pa2, bf16x8 pa3) {
  pv_one<0>(o[0], vb, pa0, pa1, pa2, pa3); pv_one<1>(o[1], vb, pa0, pa1, pa2, pa3); pv_one<2>(o[2], vb, pa0, pa1, pa2, pa3); pv_one<3>(o[3], vb, pa0, pa1, pa2, pa3);
}
__device__ __forceinline__ void apply_bias(f32x16& p0, f32x16& p1, int kr, int qr, int rs, int qc, int cs, const float* rpbs, int hi) {
  const bool row_ok = (unsigned)(kr - rs) < 8u;
  const int base = (kr - qr + 7) * 31 + 15 - qc;
  const float ninf = -__builtin_inff();
#pragma unroll
  for (int r = 0; r < 16; ++r) {
    const int kc0 = crow(r, hi), kc1 = 32 + kc0;
    const bool ok0 = row_ok && ((unsigned)(kc0 - cs) < 16u), ok1 = row_ok && ((unsigned)(kc1 - cs) < 16u);
    const float b0 = rpbs[ok0 ? base + kc0 : 0], b1 = rpbs[ok1 ? base + kc1 : 0];
    p0[r] = ok0 ? p0[r] + b0 : ninf; p1[r] = ok1 ? p1[r] + b1 : ninf;
  }
}
template <bool LAT>
__device__ __forceinline__ void body(const bf16_t* __restrict__ Qb, const bf16_t* __restrict__ K0, const bf16_t* __restrict__ V0, int nt0,
                                     const bf16_t* __restrict__ K1, const bf16_t* __restrict__ V1, int NT, bf16_t* __restrict__ Ob, char* lds, int kr0, int qrb) {
  int tid_ = threadIdx.x; asm volatile("" : "+v"(tid_));
  const int tid = tid_, wid = tid >> 6, lane = tid & 63, r32 = lane & 31, hi = lane >> 5;
  char* V_lds = lds; char* K_lds = lds + 2 * SHM_V;
  float* ws = (float*)(lds + OFF_WS) + wid * 64; float* li_l = ws; float* al_l = ws + 32;
  const float* rpbs = (const float*)(lds + OFF_RPB);
  const int qr = qrb + (wid >> 1), qc = (wid & 1) * 32 + r32;
  const int rs = min(max(qr - 4, 0), 8), cs = min(max(qc - 8, 0), 48);
  float m_reg = -1e30f, l_reg = 0; f32x16 o[4] = {}; bf16x8 qreg[8];
  const bf16_t* Qw = Qb + (long)(wid * QBLK + r32) * LD + hi * 8;
#pragma unroll
  for (int d0 = 0; d0 < 8; ++d0) qreg[d0] = ld8(Qw + d0 * 16);
  const int sr = tid >> 4, sc = (tid & 15) * 8, vst0 = v_st(sr, sc), vst1 = v_st(32 + sr, sc);
  const int vb0 = (int)(uintptr_t)V_lds + v_rd_base(lane);
  struct { bf16x8 vs0, vs1, ks0, ks1; } sr_[2];
#define SLOAD(i, t) do { const int t_ = (t); const bf16_t* kp_ = (t_ < nt0) ? K0 + (long)t_ * KVBLK * LD : K1 + (long)(t_ - nt0) * KVBLK * LD; \
    const bf16_t* vp_ = (t_ < nt0) ? V0 + (long)t_ * KVBLK * LD : V1 + (long)(t_ - nt0) * KVBLK * LD; \
    sr_[i].vs0 = ld8(vp_ + (long)sr * LD + sc); sr_[i].vs1 = ld8(vp_ + (long)(32 + sr) * LD + sc); \
    sr_[i].ks0 = ld8(kp_ + (long)sr * LD + sc); sr_[i].ks1 = ld8(kp_ + (long)(32 + sr) * LD + sc); } while (0)
#define SWRITE(b, i) do { *(bf16x8*)(V_lds + (b) * SHM_V + vst0) = sr_[i].vs0;          \
    *(bf16x8*)(V_lds + (b) * SHM_V + vst1) = sr_[i].vs1; int kc = sc * 2;               \
    *(bf16x8*)(K_lds + (b) * SHM_K + KSWZ(sr, kc)) = sr_[i].ks0;                       \
    *(bf16x8*)(K_lds + (b) * SHM_K + KSWZ(32 + sr, kc)) = sr_[i].ks1; } while (0)
#define SWAIT() asm volatile("s_waitcnt vmcnt(4)" ::: "memory")
#define RESC(a) do { if (__any((a) < 1.f)) { if (hi == 0) al_l[r32] = (a); asm volatile("s_waitcnt lgkmcnt(0)" ::: "memory"); \
    _Pragma("unroll") for (int d = 0; d < 4; ++d) _Pragma("unroll") for (int r = 0; r < 16; ++r) o[d][r] *= al_l[crow(r, hi)]; } } while (0)
#define BIAS(P0, P1, t) do { if (LAT) { const int t_ = (t); if (t_ < nt0) apply_bias(P0, P1, kr0 + t_, qr, rs, qc, cs, rpbs, hi); } } while (0)
  f32x16 pA0, pA1, pB0, pB1; float mnA, mnB, alA, alB; bf16x8 pa0, pa1, pa2, pa3;
  constexpr int SE = 0, SO = 1;
  SLOAD(SE, 0); asm volatile("s_waitcnt vmcnt(0)" ::: "memory"); SWRITE(0, SE); __syncthreads();
  qkt(pA0, pA1, K_lds, qreg, r32, hi); BIAS(pA0, pA1, 0); partialSM(pA0, pA1, m_reg, mnA, alA);
  SLOAD(SO, 1); if (2 < NT) SLOAD(SE, 2);
  SWAIT(); SWRITE(1, SO); __syncthreads();
  for (int j = 1; j + 1 < NT; j += 2) {
    SBAR(); qkt(pB0, pB1, K_lds + SHM_K, qreg, r32, hi);
    finishSM(pA0, pA1, alA, l_reg, pa0, pa1, pa2, pa3); SBAR();
    SLOAD(SO, j + 2); SBAR();
    pv_d0(o, vb0, pa0, pa1, pa2, pa3); BIAS(pB0, pB1, j); partialSM(pB0, pB1, m_reg, mnB, alB);
    __syncthreads(); SWAIT(); SWRITE(0, SE);
    RESC(alB); __syncthreads();
    SBAR(); qkt(pA0, pA1, K_lds, qreg, r32, hi);
    finishSM(pB0, pB1, alB, l_reg, pa0, pa1, pa2, pa3); SBAR();
    if (j + 3 < NT) SLOAD(SE, j + 3); SBAR();
    pv_d0(o, vb0 + SHM_V, pa0, pa1, pa2, pa3); BIAS(pA0, pA1, j + 1); partialSM(pA0, pA1, m_reg, mnA, alA);
    __syncthreads(); SWAIT(); SWRITE(1, SO);
    RESC(alA); __syncthreads();
  }
  SBAR(); qkt(pB0, pB1, K_lds + SHM_K, qreg, r32, hi);
  finishSM(pA0, pA1, alA, l_reg, pa0, pa1, pa2, pa3); SBAR();
  pv_d0(o, vb0, pa0, pa1, pa2, pa3); BIAS(pB0, pB1, NT - 1); partialSM(pB0, pB1, m_reg, mnB, alB);
  __syncthreads(); RESC(alB);
  finishSM(pB0, pB1, alB, l_reg, pa0, pa1, pa2, pa3); SBAR();
  pv_d0(o, vb0 + SHM_V, pa0, pa1, pa2, pa3);
  if (hi == 0) li_l[r32] = l_reg; asm volatile("s_waitcnt lgkmcnt(0)" ::: "memory");
  float rli[16];
#pragma unroll
  for (int r = 0; r < 16; ++r) rli[r] = __builtin_amdgcn_rcpf(li_l[crow(r, hi)]);
  bf16_t* Ow = Ob + (long)(wid * QBLK) * LDO;
#pragma unroll
  for (int r = 0; r < 16; ++r) { const int orow = crow(r, hi);
#pragma unroll
    for (int d0 = 0; d0 < 4; ++d0) Ow[(long)orow * LDO + d0 * 32 + r32] = (bf16_t)(cvt_pk_bf16(o[d0][r] * rli[r], 0.f) & 0xffffu); }
#undef SLOAD
#undef SWRITE
#undef SWAIT
#undef RESC
#undef BIAS
}
}

#define XB_TMO      128
#define XB_XCNT(j)  (256  + 64 * (j))
#define XB_XSUB(j)  (1280 + 64 * (j))
#define XB_XGEN(j)  (2304 + 64 * (j))
#define XB_TOP      3328
#define XB_TOPGEN   3392
#define XCD_BAR_WORDS 3456
#define XB_SPIN_CAP (1u << 18)
__device__ __forceinline__ unsigned xb_ld(unsigned* p)              { return __hip_atomic_load(p, __ATOMIC_RELAXED, __HIP_MEMORY_SCOPE_AGENT); }
__device__ __forceinline__ unsigned xb_add(unsigned* p, unsigned v) { return __hip_atomic_fetch_add(p, v, __ATOMIC_RELAXED, __HIP_MEMORY_SCOPE_AGENT); }
__device__ __forceinline__ unsigned xb_xcc_id() { return (unsigned)__builtin_amdgcn_s_getreg((3 << 11) | 20) & 0xFu; }
#define XB_SPIN(cond, bar) do { unsigned _sp = 0; while (cond) { __builtin_amdgcn_s_sleep(1); \
    if ((++_sp & 255u) == 0u) { if (xb_ld(&(bar)[XB_TMO])) break; if (_sp > XB_SPIN_CAP) { atomicAdd(&(bar)[XB_TMO], 1u); break; } } } } while (0)
struct XcdBarrier { unsigned* bar; unsigned x; volatile LAS unsigned* st; };
__device__ __forceinline__ XcdBarrier xcd_barrier_post(unsigned* bar, volatile LAS unsigned* st) {
    XcdBarrier b; b.bar = bar; b.x = xb_xcc_id(); b.st = st;
    if (threadIdx.x == 0) (void)xb_add(&bar[XB_XCNT(b.x)], 1u);
    return b;
}
__device__ __forceinline__ void xcd_barrier_complete(unsigned* bar, unsigned x, unsigned& nloc, unsigned& nx) {
    const unsigned G = gridDim.x * gridDim.y * gridDim.z;
    unsigned sum, cnt, mine, sp = 0u;
    for (;;) {
        sum = 0u; cnt = 0u; mine = 0u;
#pragma unroll
        for (unsigned j = 0; j < 16; ++j) { const unsigned c = xb_ld(&bar[XB_XCNT(j)]); sum += c; cnt += (c > 0u) ? 1u : 0u; mine = (j == x) ? c : mine; }
        if (sum == G) break;
        __builtin_amdgcn_s_sleep(1);
        if ((++sp & 255u) == 0u) { if (xb_ld(&bar[XB_TMO])) break; if (sp > XB_SPIN_CAP) { atomicAdd(&bar[XB_TMO], 1u); break; } }
    }
    nloc = mine > 0u ? mine : 1u; nx = cnt > 0u ? cnt : 1u;
}
__device__ __forceinline__ void xcd_barrier(const XcdBarrier& b) {
    asm volatile("s_waitcnt vmcnt(0)" ::: "memory");
    __syncthreads();
    if (threadIdx.x == 0) {
        unsigned* bar = b.bar;
        __builtin_amdgcn_s_waitcnt(0);
        unsigned nloc = b.st[0], nx = b.st[1];
        if (nloc == 0u) { xcd_barrier_complete(bar, b.x, nloc, nx); b.st[0] = nloc; b.st[1] = nx; }
        const unsigned old = xb_add(&bar[XB_XSUB(b.x)], 1u);
        const unsigned gen = old / nloc;
        if (old + 1u == (gen + 1u) * nloc) {
            __builtin_amdgcn_fence(__ATOMIC_RELEASE, "agent");
            asm volatile("s_waitcnt vmcnt(0)" ::: "memory");
            const unsigned og = xb_add(&bar[XB_TOP], 1u);
            const unsigned tg = og / nx;
            if (og + 1u == (tg + 1u) * nx) xb_add(&bar[XB_TOPGEN], 1u);
            else XB_SPIN(xb_ld(&bar[XB_TOPGEN]) == tg, bar);
            __builtin_amdgcn_fence(__ATOMIC_ACQUIRE, "agent");
            xb_add(&bar[XB_XGEN(b.x)], 1u);
            asm volatile("s_waitcnt vmcnt(0)" ::: "memory");
        } else {
            XB_SPIN(xb_ld(&bar[XB_XGEN(b.x)]) == gen, bar);
            __builtin_amdgcn_fence(__ATOMIC_ACQUIRE, "agent");
            asm volatile("s_waitcnt vmcnt(0)" ::: "memory");
        }
    }
    __syncthreads();
}

struct Args { const float* in[23]; float* out; unsigned char* ws; int ph_lo, ph_hi; };
enum { I_XP = 0, I_XS, I_CK, I_CV, I_C, I_CCTX, I_WADA, I_BADA, I_GPREMIX, I_GPOSTMIX, I_GPREMLP, I_GPOSTMLP, I_WIN, I_RPB, I_GSGU, I_WSP, I_BSP, I_WBRA, I_WBRF, I_WBRC, I_WOUT, I_W1, I_W2 };
constexpr int NPRE = 2, NLP = 9, NPH = NPRE + DEPTH * NLP;

struct Frame {
    LAS unsigned char* lds; char* ldsg;
    int tid, lane, wave, G, bx;
};
typedef const __attribute__((address_space(4))) Args* KArgs;
__device__ __forceinline__ KArgs kargs() { KArgs p = (KArgs)__builtin_amdgcn_kernarg_segment_ptr(); asm volatile("" : "+s"(p)); return p; }
__device__ __forceinline__ int fresh_tid() { int t = threadIdx.x; asm volatile("" : "+v"(t)); return t; }
__device__ __forceinline__ void refresh(Frame& F) { F.tid = fresh_tid(); F.lane = F.tid & 63; F.wave = __builtin_amdgcn_readfirstlane(F.tid >> 6); int g = gridDim.x, b = blockIdx.x; asm volatile("" : "+s"(g), "+s"(b)); F.G = g; F.bx = b; }

__device__ __forceinline__ void tr_item(const float* W, int N, bf16_t* WT, int ldt, int koff, LAS float* scr, int item, int lane) {
    const int nblk = N / 32, kb = item / nblk, nb = item % nblk, k0 = 64 * kb, n0 = 32 * nb;
#pragma unroll 8
    for (int i = 0; i < 32; ++i) { const int kk = 2 * i + (lane >> 5); scr[kk * 33 + (lane & 31)] = W[(size_t)(k0 + kk) * N + n0 + (lane & 31)]; }
    LDS_WAIT(); asm volatile("" ::: "memory");
    const int c = lane & 7;
#pragma unroll
    for (int j = 0; j < 4; ++j) { const int n = (lane >> 3) + 8 * j; const LAS float* s = scr + (8 * c) * 33 + n;
        u32x4 o; o.x = cvt_pk_bf16(s[0 * 33], s[1 * 33]); o.y = cvt_pk_bf16(s[2 * 33], s[3 * 33]); o.z = cvt_pk_bf16(s[4 * 33], s[5 * 33]); o.w = cvt_pk_bf16(s[6 * 33], s[7 * 33]);
        *(u32x4*)(WT + (size_t)(n0 + n) * ldt + koff + k0 + 8 * c) = o; }
    LDS_WAIT(); asm volatile("" ::: "memory");
}
__device__ __forceinline__ bf16_t f2bf(float v) { return (bf16_t)(cvt_pk_bf16(v, 0.f) & 0xffffu); }

__device__ __forceinline__ void p0_weights(Frame& F) {
    refresh(F); KArgs A = kargs(); unsigned char* ws = A->ws;
    LAS float* scr = (LAS float*)(F.lds + F.wave * 16384);
    const int gw = F.bx * 8 + F.wave, NGW = F.G * 8;
    constexpr int I_IN = 32 * 336, I_BA = 16 * 64, I_BF = 8 * 64, I_BC = 8 * 64, I_OUT = 32 * 64, I_1 = 32 * 256, I_2 = 128 * 64, NPL = I_IN + I_BA + I_BF + I_BC + I_OUT + I_1 + I_2;
    for (int it = gw; it < DEPTH * NPL; it += NGW) {
        const int l = it / NPL; int r = it % NPL;
        const float* W; int N; bf16_t* WT; int ldt = D, koff = 0;
        if (r < I_IN) { W = A->in[I_WIN] + (size_t)l * D * IN_W; N = IN_W; WT = (bf16_t*)(ws + WS_WIN + l * SZ_WIN); }
        else if ((r -= I_IN) < I_BA) { W = A->in[I_WBRA] + (size_t)l * 1024 * D; N = D; WT = (bf16_t*)(ws + WS_WBR + l * SZ_WSQ); }
        else if ((r -= I_BA) < I_BF) { W = A->in[I_WBRF] + (size_t)l * 512 * D; N = D; WT = (bf16_t*)(ws + WS_WBR + l * SZ_WSQ); koff = 1024; }
        else if ((r -= I_BF) < I_BC) { W = A->in[I_WBRC] + (size_t)l * 512 * D; N = D; WT = (bf16_t*)(ws + WS_WBR + l * SZ_WSQ); koff = 1536; }
        else if ((r -= I_BC) < I_OUT) { W = A->in[I_WOUT] + (size_t)l * D * D; N = D; WT = (bf16_t*)(ws + WS_WOUT + l * SZ_WSQ); }
        else if ((r -= I_OUT) < I_1) { W = A->in[I_W1] + (size_t)l * D * D_FF; N = D_FF; WT = (bf16_t*)(ws + WS_W1 + l * SZ_W1); }
        else { r -= I_1; W = A->in[I_W2] + (size_t)l * D_FF * D; N = D; WT = (bf16_t*)(ws + WS_W2 + l * SZ_W1); ldt = D_FF; }
        tr_item(W, N, WT, ldt, koff, scr, r, F.lane);
    }
}
__device__ __forceinline__ void p0_tables(Frame& F) {
    refresh(F); KArgs A = kargs(); unsigned char* ws = A->ws;
    const int gt = F.bx * 512 + F.tid, GT = F.G * 512;
    bf16_t* tw256 = (bf16_t*)(ws + WS_TW256); bf16_t* tw1024 = (bf16_t*)(ws + WS_TW1024); bf16_t* wf = (bf16_t*)(ws + WS_WF);
    for (int i = gt; i < 256 * 512; i += GT) { const int k1 = i >> 9, cc = i & 511, n = cc & 255, ph = (k1 * n) & 255; const float a = (float)ph * (1.0f / 256.0f);
        tw256[i] = f2bf(cc < 256 ? __builtin_amdgcn_cosf(a) : -__builtin_amdgcn_sinf(a)); }
    for (int i = gt; i < 1024 * 2048; i += GT) { const int k1 = i >> 11, cc = i & 2047, n = cc & 1023, ph = (k1 * n) & 1023; const float a = (float)ph * (1.0f / 1024.0f);
        tw1024[i] = f2bf(cc < 1024 ? __builtin_amdgcn_cosf(a) : -__builtin_amdgcn_sinf(a)); }
    for (int i = gt; i < 1024 * 512; i += GT) { const int m = i >> 9, cc = i & 511, g = m >> 8, j = (m >> 7) & 1, k2 = m & 127, g2 = cc >> 7, n2 = cc & 127, ph = (k2 * n2) & 127; const float a = (float)ph * (1.0f / 128.0f);
        wf[i] = f2bf((g == g2) ? (j ? __builtin_amdgcn_sinf(a) : __builtin_amdgcn_cosf(a)) : 0.f); }
    { const f32x4* s = (const f32x4*)A->in[I_WSP]; u32x4* d = (u32x4*)(ws + WS_WSP);
      for (int i = gt; i < 4 * 4 * 128 * 128 / 8; i += GT) d[i] = pg8::pack8(s[2 * i], s[2 * i + 1]); }
    { const f32x4* s = (const f32x4*)A->in[I_CK]; u32x4* d = (u32x4*)(ws + WS_CK);
      for (int i = gt; i < 2 * 4 * 512 * 1024 / 8; i += GT) d[i] = pg8::pack8(s[2 * i], s[2 * i + 1]); }
    { const f32x4* s = (const f32x4*)A->in[I_CV]; u32x4* d = (u32x4*)(ws + WS_CV);
      for (int i = gt; i < 2 * 4 * 512 * 1024 / 8; i += GT) d[i] = pg8::pack8(s[2 * i], s[2 * i + 1]); }
}
__device__ __forceinline__ void p0_mod(Frame& F) {
    refresh(F); KArgs A = kargs();
    __syncthreads();
    LAS float* sv = (LAS float*)F.lds;
    LAS float* red = (LAS float*)(F.lds + 32768);
    { const float* cc = A->in[I_CCTX]; const float* c = A->in[I_C];
      for (int i = F.tid; i < 3 * D; i += 512) { const int v = i >> 11, k = i & 2047; const float x = v == 0 ? cc[k] : c[(v - 1) * D + k]; sv[i] = x * __builtin_amdgcn_rcpf(1.0f + __expf(-x)); } }
    __syncthreads();
    float* MOD = (float*)(A->ws + WS_MOD); const float* wada = A->in[I_WADA]; const float* bada = A->in[I_BADA];
    for (int item = F.bx; item < DEPTH * 192; item += F.G) {
        const int l = item / 192, j0 = (item % 192) * 64;
        const float* W = wada + (size_t)l * D * 12288 + j0 + (F.lane & 15) * 4;
        const int kbase = F.wave * 256 + (F.lane >> 4);
        f32x4 a0 = {0.f, 0.f, 0.f, 0.f}, a1 = a0, a2 = a0;
#pragma unroll 8
        for (int i = 0; i < 64; ++i) { const int k = kbase + 4 * i; const f32x4 w = *(const f32x4*)(W + (size_t)k * 12288);
            a0 += w * sv[k]; a1 += w * sv[D + k]; a2 += w * sv[2 * D + k]; }
#pragma unroll
        for (int e = 0; e < 4; ++e) { a0[e] += shx(a0[e], 16, F.lane); a0[e] += shx(a0[e], 32, F.lane); a1[e] += shx(a1[e], 16, F.lane); a1[e] += shx(a1[e], 32, F.lane); a2[e] += shx(a2[e], 16, F.lane); a2[e] += shx(a2[e], 32, F.lane); }
        if (F.lane < 16) { *(LAS f32x4*)(red + (F.wave * 3 + 0) * 64 + F.lane * 4) = a0; *(LAS f32x4*)(red + (F.wave * 3 + 1) * 64 + F.lane * 4) = a1; *(LAS f32x4*)(red + (F.wave * 3 + 2) * 64 + F.lane * 4) = a2; }
        __syncthreads();
        if (F.tid < 192) { const int v = F.tid >> 6, jj = F.tid & 63; float s = bada[l * 12288 + j0 + jj];
#pragma unroll
            for (int w = 0; w < 8; ++w) s += red[(w * 3 + v) * 64 + jj];
            MOD[(size_t)(l * 3 + v) * 12288 + j0 + jj] = s; }
        __syncthreads();
    }
}

__device__ __forceinline__ int mod_index(int m) { return m < M_CTX ? 0 : 1 + ((m - M_CTX) >> 10); }
__device__ __forceinline__ void norm_mod_store(const f32x4 (&v)[8], float rstd, const float* g, const float* sc, const float* sh, bf16_t* hrow, int lane) {
#pragma unroll
    for (int j = 0; j < 8; ++j) { const int c4 = lane + 64 * j; const f32x4 gg = ((const f32x4*)g)[c4], s1 = ((const f32x4*)sc)[c4], s0 = ((const f32x4*)sh)[c4];
        const f32x4 h = v[j] * rstd * gg * (1.0f + s1) + s0;
        u32x2 w; w.x = cvt_pk_bf16(h[0], h[1]); w.y = cvt_pk_bf16(h[2], h[3]); ((u32x2*)hrow)[c4] = w; }
}
__device__ __forceinline__ float sumsq8(const f32x4 (&v)[8], int lane) {
    float s = 0.f;
#pragma unroll
    for (int j = 0; j < 8; ++j) s += (v[j][0] * v[j][0] + v[j][1] * v[j][1]) + (v[j][2] * v[j][2] + v[j][3] * v[j][3]);
    return wave_sum(s, lane);
}
__device__ __forceinline__ void p1_norm0(Frame& F) {
    refresh(F); KArgs A = kargs();
    const int gw = F.bx * 8 + F.wave, NGW = F.G * 8;
    const float* MOD = (const float*)(A->ws + WS_MOD); bf16_t* H = (bf16_t*)(A->ws + WS_H);
    const float* xp = A->in[I_XP]; const float* xs = A->in[I_XS]; const float* gpm = A->in[I_GPREMIX]; float* out = A->out;
    for (int m = gw; m < M; m += NGW) {
        const float* src = m < M_CTX ? xp + (size_t)m * D : xs + (size_t)(m - M_CTX) * D;
        f32x4 v[8];
#pragma unroll
        for (int j = 0; j < 8; ++j) v[j] = ((const f32x4*)src)[F.lane + 64 * j];
        const float rstd = __builtin_amdgcn_rsqf(sumsq8(v, F.lane) * (1.0f / D) + RMS_EPS);
        float* xo = out + (size_t)m * D;
#pragma unroll
        for (int j = 0; j < 8; ++j) ((f32x4*)xo)[F.lane + 64 * j] = v[j];
        const float* mv = MOD + (size_t)mod_index(m) * 12288;
        norm_mod_store(v, rstd, gpm, mv + 1 * D, mv + 0 * D, H + (size_t)m * D, F.lane);
    }
}
__device__ __forceinline__ void thin_phase(Frame& F, int i_gpost, int l, int gate_off, int i_gnext, int ln, int sc_off, int sh_off) {
    refresh(F); KArgs A = kargs();
    const int gw = F.bx * 8 + F.wave, NGW = F.G * 8;
    bf16_t* H = (bf16_t*)(A->ws + WS_H); const float* Y = (const float*)(A->ws + WS_MIX); float* out = A->out;
    const float* g_post = A->in[i_gpost] + l * D; const float* modc = (const float*)(A->ws + WS_MOD) + (size_t)l * 3 * 12288;
    const float* g_next = i_gnext >= 0 ? A->in[i_gnext] + ln * D : nullptr; const float* modn = (const float*)(A->ws + WS_MOD) + (size_t)ln * 3 * 12288;
    for (int m = gw; m < M; m += NGW) {
        const int mi = mod_index(m);
        const float* yr = Y + (size_t)m * D; float* xr = out + (size_t)m * D;
        f32x4 y[8], x[8];
#pragma unroll
        for (int j = 0; j < 8; ++j) { y[j] = ((const f32x4*)yr)[F.lane + 64 * j]; x[j] = ((const f32x4*)xr)[F.lane + 64 * j]; }
        const float r1 = __builtin_amdgcn_rsqf(sumsq8(y, F.lane) * (1.0f / D) + RMS_EPS);
        const float* gt = modc + (size_t)mi * 12288 + gate_off;
#pragma unroll
        for (int j = 0; j < 8; ++j) { const int c4 = F.lane + 64 * j; x[j] = x[j] + ((const f32x4*)gt)[c4] * (y[j] * r1 * ((const f32x4*)g_post)[c4]); ((f32x4*)xr)[c4] = x[j]; }
        if (g_next) {
            const float r2 = __builtin_amdgcn_rsqf(sumsq8(x, F.lane) * (1.0f / D) + RMS_EPS);
            const float* mv = modn + (size_t)mi * 12288;
            norm_mod_store(x, r2, g_next, mv + sc_off, mv + sh_off, H + (size_t)m * D, F.lane);
        }
    }
}

__device__ __forceinline__ void sg_unit(Frame& F, KArgs A, int l, int unit) {
    const int c = unit >> 2, g = unit & 3, row0 = c * 128;
    const bf16_t* P2 = (const bf16_t*)(A->ws + WS_P2); bf16_t* OBR = (bf16_t*)(A->ws + WS_OBR);
    LAS bf16_t* vT = (LAS bf16_t*)F.lds;
    {
        const int pos = F.tid >> 2, d0 = (F.tid & 3) * 32;
        const bf16_t* vp = P2 + (size_t)(row0 + pos) * P2W + P2_V + g * 128 + d0;
        u32x4 w[4];
#pragma unroll
        for (int i = 0; i < 4; ++i) w[i] = ((const u32x4*)vp)[i];
        float v[32];
#pragma unroll
        for (int i = 0; i < 4; ++i)
#pragma unroll
            for (int e = 0; e < 4; ++e) { v[i * 8 + e * 2] = bflo(w[i][e]); v[i * 8 + e * 2 + 1] = bfhi(w[i][e]); }
        float ss = 0.f;
#pragma unroll
        for (int i = 0; i < 32; ++i) ss += v[i] * v[i];
        ss += shx(ss, 1, F.lane); ss += shx(ss, 2, F.lane);
        const float rstd = __builtin_amdgcn_rsqf(ss * (1.0f / 128.0f) + RMS_EPS);
        const float* gs = A->in[I_GSGU] + (l * 4 + g) * 128 + d0;
#pragma unroll
        for (int i = 0; i < 32; ++i) vT[(d0 + i) * 136 + pos] = f2bf(v[i] * rstd * gs[i]);
    }
    __syncthreads();
    {
        const int fr = F.lane & 15, quad = F.lane >> 4, pcol = F.wave * 16 + fr;
        const bf16_t* wp = (const bf16_t*)(A->ws + WS_WSP) + ((size_t)(l * 4 + g) * 128 + pcol) * 128 + quad * 8;
        bf16x8 bfr[4];
#pragma unroll
        for (int kk = 0; kk < 4; ++kk) bfr[kk] = *(const bf16x8*)(wp + kk * 32);
        f32x4 acc[8];
#pragma unroll
        for (int dt = 0; dt < 8; ++dt) { acc[dt] = (f32x4){0.f, 0.f, 0.f, 0.f};
#pragma unroll
            for (int kk = 0; kk < 4; ++kk) { const bf16x8 afr = *(const LAS bf16x8*)(vT + (dt * 16 + fr) * 136 + kk * 32 + quad * 8);
                acc[dt] = __builtin_amdgcn_mfma_f32_16x16x32_bf16(afr, bfr[kk], acc[dt], 0, 0, 0); } }
        const float bias = A->in[I_BSP][(l * 4 + g) * 128 + pcol];
        const bf16_t* up = P2 + (size_t)(row0 + pcol) * P2W + P2_U + g * 128 + quad * 4;
        bf16_t* op = OBR + (size_t)(row0 + pcol) * D + OB_C + g * 128 + quad * 4;
#pragma unroll
        for (int dt = 0; dt < 8; ++dt) { const u32x2 uw = *(const u32x2*)(up + dt * 16);
            u32x2 o; o.x = cvt_pk_bf16(bflo(uw.x) * (acc[dt][0] + bias), bfhi(uw.x) * (acc[dt][1] + bias)); o.y = cvt_pk_bf16(bflo(uw.y) * (acc[dt][2] + bias), bfhi(uw.y) * (acc[dt][3] + bias));
            *(u32x2*)(op + dt * 16) = o; }
    }
    __syncthreads();
}

__global__ void __launch_bounds__(512, 2) fwd(Args args) {
    extern __shared__ __attribute__((aligned(16))) unsigned char lds[];
    Frame F;
    F.lds = (LAS unsigned char*)lds; F.ldsg = (char*)lds;
    refresh(F);
    volatile LAS unsigned* MISC = (volatile LAS unsigned*)(F.lds + MISC_OFF);
    for (int u = F.tid; u < (LDS_BYTES - RING_BYTES) / 4; u += 512) ((LAS unsigned*)(F.lds + RING_BYTES))[u] = 0u;
    __syncthreads();
    const int lo = args.ph_lo, hi = args.ph_hi;
    XcdBarrier bar; bar.bar = (unsigned*)(args.ws + WS_CTL) + CW_BAR; bar.x = 0; bar.st = nullptr;
    if (hi - lo > 1) bar = xcd_barrier_post((unsigned*)(args.ws + WS_CTL) + CW_BAR, MISC + 8);
#define IN(p) (lo <= (p) && (p) < hi)
#define SEAM(p) do { if ((p) + 1 < hi) { XcdBarrier b_ = bar; asm volatile("" : "+s"(b_.bar)); xcd_barrier(b_); } } while (0)

    if (IN(0)) { p0_weights(F); p0_tables(F); p0_mod(F); SEAM(0); }
    if (IN(1)) { p1_norm0(F); SEAM(1); }

    for (int l = 0; l < DEPTH; ++l) {
        const int pb = NPRE + l * NLP;
        if (pb + NLP <= lo || pb >= hi) continue;
        if (IN(pb + 0)) {
            refresh(F); KArgs A = kargs(); unsigned char* ws = A->ws;
            pg8::Dims g{D, D, D}; pg8::TileOrder S; S.init(ws + WS_H, D, ws + WS_WIN + l * SZ_WIN, D, M, IN_W, F.G, F.bx);
            pg8::EpiProj E{(bf16_t*)(ws + WS_QKV), (bf16_t*)(ws + WS_P2), A->out + OUT_CK + (size_t)l * 256 * 1024, A->out + OUT_CV + (size_t)l * 256 * 1024};
            pg8::gemm_phase<pg8::EpiProj, pg8::TileOrder, true>(F.lds, g, S, E);
            SEAM(pb + 0);
        }
        if (IN(pb + 1)) {
            refresh(F); KArgs A = kargs(); unsigned char* ws = A->ws;
            pg8::Dims g{512, P2W, 512}; pg8::TileOrder S; S.init(ws + WS_WF, 512, (bf16_t*)(ws + WS_P2) + P2_F, P2W, 1024, M, F.G, F.bx);
            pg8::EpiTT E{(bf16_t*)(ws + WS_TT), (bf16_t*)(ws + WS_TTL)};
            pg8::gemm_phase<pg8::EpiTT, pg8::TileOrder, true>(F.lds, g, S, E);
            SEAM(pb + 1);
        }
        if (IN(pb + 2)) {
            {
                refresh(F); KArgs A = kargs(); unsigned char* ws = A->ws;
                pg8::Dims g{2048, 2048, 2048};
                pg8::BatchOrder S{(const char*)(ws + WS_TW1024), (const char*)(ws + WS_TTL), (size_t)256 * 2048 * 2, (size_t)256 * 2048 * 2, (size_t)512 * 2048 * 2, 4, 2, 2, F.G, F.bx, 32};
                pg8::EpiFour2 E{(bf16_t*)(ws + WS_OBR), 0.00276213586400995f};
                pg8::gemm_phase<pg8::EpiFour2, pg8::BatchOrder, false>(F.lds, g, S, E);
            }
            {
                refresh(F); KArgs A = kargs(); unsigned char* ws = A->ws;
                pg8::Dims g{512, 512, 512};
                pg8::BatchOrder S{(const char*)(ws + WS_TW256), (const char*)(ws + WS_TT), (size_t)256 * 512 * 2, (size_t)256 * 512 * 2, (size_t)512 * 512 * 2, 1, 2, 32, F.G, (F.bx + F.G - 16) % F.G, 0};
                pg8::EpiFour2 E{(bf16_t*)(ws + WS_OBR), 0.005524271728019903f};
                pg8::gemm_phase<pg8::EpiFour2, pg8::BatchOrder, false>(F.lds, g, S, E);
            }
            {
                refresh(F); KArgs A = kargs(); unsigned char* ws = A->ws;
                const bf16_t* QKV = (const bf16_t*)(ws + WS_QKV); bf16_t* OBR = (bf16_t*)(ws + WS_OBR);
                for (int u = F.bx; u < 256; u += F.G) {
                    const int b = u >> 3, h = u & 7;
                    const bf16_t* Qb = QKV + (size_t)(b * 256) * 1024 + h * 128;
                    __syncthreads();
                    att::body<false>(Qb, Qb + (size_t)M * 1024, Qb + (size_t)2 * M * 1024, 4, nullptr, nullptr, 4, OBR + (size_t)(b * 256) * D + OB_A + h * 128, F.ldsg, 0, 0);
                }
            }
            {
                refresh(F); KArgs A = kargs(); unsigned char* ws = A->ws;
                const bf16_t* QKV = (const bf16_t*)(ws + WS_QKV); bf16_t* OBR = (bf16_t*)(ws + WS_OBR);
                for (int u = (F.bx + F.G - 80) % F.G; u < 64; u += F.G) {
                    const int j = u & 3, h = (u >> 2) & 7, b = u >> 5;
                    const int kr0 = j == 0 ? 0 : (j == 1 ? 0 : (j == 2 ? 4 : 8)), nt0 = (j == 0 || j == 3) ? 8 : 12;
                    __syncthreads();
                    { const int t = fresh_tid(); if (t < 465) ((float*)(F.ldsg + att::OFF_RPB))[t] = A->in[I_RPB][(l * 8 + h) * 465 + t] * (1.0f / att::SCALE); }
                    __syncthreads();
                    const size_t r0 = (size_t)M_CTX + b * 1024;
                    const bf16_t* Qb = QKV + (r0 + 256 * j) * 1024 + h * 128;
                    const bf16_t* K0 = QKV + (size_t)M * 1024 + (r0 + kr0 * 64) * 1024 + h * 128;
                    const bf16_t* K1 = (const bf16_t*)(ws + WS_CK) + ((size_t)(b * 4 + l) * 512) * 1024 + h * 128;
                    const bf16_t* V1 = (const bf16_t*)(ws + WS_CV) + ((size_t)(b * 4 + l) * 512) * 1024 + h * 128;
                    att::body<true>(Qb, K0, K0 + (size_t)M * 1024, nt0, K1, V1, nt0 + 8, OBR + (r0 + 256 * j) * D + OB_A + h * 128, F.ldsg, kr0, 4 * j);
                }
                __syncthreads();
            }
            {
                refresh(F); KArgs A = kargs();
                for (int u = F.G - 1 - F.bx; u < 320; u += F.G) sg_unit(F, A, l, u);
            }
            SEAM(pb + 2);
        }
        if (IN(pb + 3)) {
            { refresh(F); KArgs A = kargs(); unsigned char* ws = A->ws; const bf16_t* wbr = (const bf16_t*)(ws + WS_WBR + l * SZ_WSQ); bf16_t* OBR = (bf16_t*)(ws + WS_OBR);
              pg8::Dims g{D, D, 1024}; pg8::TileOrder S; S.init(OBR + OB_A, D, wbr + OB_A, D, M, D, F.G, F.bx);
              pg8::EpiBranch<0> E{(const bf16_t*)(ws + WS_P2) + P2_GA, (float*)(ws + WS_MIX), (bf16_t*)(ws + WS_MRG)}; pg8::gemm_phase<pg8::EpiBranch<0>, pg8::TileOrder, false>(F.lds, g, S, E); }
            { refresh(F); KArgs A = kargs(); unsigned char* ws = A->ws; const bf16_t* wbr = (const bf16_t*)(ws + WS_WBR + l * SZ_WSQ); bf16_t* OBR = (bf16_t*)(ws + WS_OBR);
              pg8::Dims g{D, D, 512}; pg8::TileOrder S; S.init(OBR + OB_F, D, wbr + OB_F, D, M, D, F.G, F.bx);
              pg8::EpiBranch<1> E{(const bf16_t*)(ws + WS_P2) + P2_GF, (float*)(ws + WS_MIX), (bf16_t*)(ws + WS_MRG)}; pg8::gemm_phase<pg8::EpiBranch<1>, pg8::TileOrder, false>(F.lds, g, S, E); }
            { refresh(F); KArgs A = kargs(); unsigned char* ws = A->ws; const bf16_t* wbr = (const bf16_t*)(ws + WS_WBR + l * SZ_WSQ); bf16_t* OBR = (bf16_t*)(ws + WS_OBR);
              pg8::Dims g{D, D, 512}; pg8::TileOrder S; S.init(OBR + OB_C, D, wbr + OB_C, D, M, D, F.G, F.bx);
              pg8::EpiBranch<2> E{(const bf16_t*)(ws + WS_P2) + P2_GC, (float*)(ws + WS_MIX), (bf16_t*)(ws + WS_MRG)}; pg8::gemm_phase<pg8::EpiBranch<2>, pg8::TileOrder, false>(F.lds, g, S, E); }
            SEAM(pb + 3);
        }
        if (IN(pb + 4)) {
            refresh(F); KArgs A = kargs(); unsigned char* ws = A->ws;
            pg8::Dims g{D, D, D}; pg8::TileOrder S; S.init(ws + WS_MRG, D, ws + WS_WOUT + l * SZ_WSQ, D, M, D, F.G, F.bx);
            pg8::EpiF32 E{(float*)(ws + WS_MIX), D}; pg8::gemm_phase<pg8::EpiF32, pg8::TileOrder, false>(F.lds, g, S, E);
            SEAM(pb + 4);
        }
        if (IN(pb + 5)) {
            thin_phase(F, I_GPOSTMIX, l, 2 * D, I_GPREMLP, l, 4 * D, 3 * D);
            SEAM(pb + 5);
        }
        if (IN(pb + 6)) {
            refresh(F); KArgs A = kargs(); unsigned char* ws = A->ws;
            pg8::Dims g{D, D, D}; pg8::TileOrder S; S.init(ws + WS_H, D, ws + WS_W1 + l * SZ_W1, D, M, D_FF, F.G, F.bx);
            pg8::EpiRelu2 E{(bf16_t*)(ws + WS_FF1), D_FF}; pg8::gemm_phase<pg8::EpiRelu2, pg8::TileOrder, true>(F.lds, g, S, E);
            SEAM(pb + 6);
        }
        if (IN(pb + 7)) {
            refresh(F); KArgs A = kargs(); unsigned char* ws = A->ws;
            pg8::Dims g{D_FF, D_FF, D_FF}; pg8::TileOrder S; S.init(ws + WS_FF1, D_FF, ws + WS_W2 + l * SZ_W1, D_FF, M, D, F.G, F.bx);
            pg8::EpiF32 E{(float*)(ws + WS_MIX), D}; pg8::gemm_phase<pg8::EpiF32, pg8::TileOrder, false>(F.lds, g, S, E);
            SEAM(pb + 7);
        }
        if (IN(pb + 8)) {
            const bool nx = l + 1 < DEPTH;
            thin_phase(F, I_GPOSTMLP, l, 5 * D, nx ? I_GPREMIX : -1, nx ? l + 1 : l, 1 * D, 0);
            SEAM(pb + 8);
        }
    }
#undef IN
#undef SEAM
}

extern "C" void kernel_launch(void* const* d_in, const int* in_sizes, int n_in, void* d_out, int out_size, void* d_ws, size_t ws_size, hipStream_t stream) {
    static int grid = 0;
    if (grid == 0) {
        if (n_in != 23 || out_size != (int)(OUT_CV + (size_t)32 * 4 * 256 * 1024) || ws_size < WS_END) {
            fprintf(stderr, "kernel_launch: shape mismatch: n_in %d out %d ws %zu (need %zu); nothing launched\n", n_in, out_size, ws_size, (size_t)WS_END); grid = -1; return; }
        int dev = 0, cus = 0, per_cu = 0;
        if (hipGetDevice(&dev) != hipSuccess || hipDeviceGetAttribute(&cus, hipDeviceAttributeMultiprocessorCount, dev) != hipSuccess) { fprintf(stderr, "kernel_launch: device query failed\n"); grid = -1; return; }
        if (hipFuncSetAttribute((const void*)fwd, hipFuncAttributeMaxDynamicSharedMemorySize, LDS_BYTES) != hipSuccess) { fprintf(stderr, "kernel_launch: hipFuncSetAttribute failed\n"); grid = -1; return; }
        if (hipOccupancyMaxActiveBlocksPerMultiprocessor(&per_cu, (const void*)fwd, 512, LDS_BYTES) != hipSuccess || per_cu < 1)
            fprintf(stderr, "kernel_launch: note: occupancy query reports %d workgroups per CU\n", per_cu);
        (void)hipGetLastError();
        grid = cus;
    }
    if (grid < 0) return;
    if (hipMemsetAsync((char*)d_ws + WS_CTL, 0, CTL_BYTES, stream) != hipSuccess) { fprintf(stderr, "kernel_launch: memset failed\n"); return; }
    Args a{};
    for (int i = 0; i < 23; ++i) a.in[i] = (const float*)d_in[i];
    a.out = (float*)d_out; a.ws = (unsigned char*)d_ws;
#if MK_PER_PHASE
    for (int p = 0; p < NPH; ++p) { a.ph_lo = p; a.ph_hi = p + 1; hipLaunchKernelGGL(fwd, dim3(grid), dim3(512), LDS_BYTES, stream, a); }
#else
    a.ph_lo = 0; a.ph_hi = NPH; hipLaunchKernelGGL(fwd, dim3(grid), dim3(512), LDS_BYTES, stream, a);
#endif
    const hipError_t le = hipPeekAtLastError();
    if (le != hipSuccess) fprintf(stderr, "kernel_launch: launch failed: %s\n", hipGetErrorName(le));
}
```

```cpp
#include <hip/hip_runtime.h>
#include <cstdio>
#include <cstdint>

#ifndef MK_PER_PHASE
#define MK_PER_PHASE 0
#endif

#define LAS __attribute__((address_space(3)))
#define GAS __attribute__((address_space(1)))
typedef unsigned short bf16_t;
typedef short bf16x8 __attribute__((ext_vector_type(8)));
typedef short s16x4 __attribute__((ext_vector_type(4)));
typedef float f32x2 __attribute__((ext_vector_type(2)));
typedef float f32x4 __attribute__((ext_vector_type(4)));
typedef float f32x16 __attribute__((ext_vector_type(16)));
typedef unsigned u32x2 __attribute__((ext_vector_type(2)));
typedef unsigned u32x4 __attribute__((ext_vector_type(4)));

constexpr int D = 2048, M_CTX = 8192, M_LAT = 2048, M = M_CTX + M_LAT, DEPTH = 4;
constexpr int IN_W = 10752, D_FF = 8192, P2W = 7680;
constexpr int P2_F = 0, P2_U = 512, P2_V = 1024, P2_GA = 1536, P2_GF = 3584, P2_GC = 5632;
constexpr int OB_A = 0, OB_F = 1024, OB_C = 1536;
constexpr float RMS_EPS = 1e-6f;
constexpr size_t OUT_YS = (size_t)M_CTX * D, OUT_CK = (size_t)M * D, OUT_CV = OUT_CK + (size_t)32 * 4 * 256 * 1024;

constexpr size_t MiB = 1u << 20;
constexpr size_t WS_CTL = 0, CTL_BYTES = MiB;
constexpr size_t SZ_WIN = (size_t)IN_W * D * 2, SZ_WSQ = (size_t)D * D * 2, SZ_W1 = (size_t)D_FF * D * 2;
constexpr size_t WS_WIN = CTL_BYTES;
constexpr size_t WS_WBR = WS_WIN + 4 * SZ_WIN;
constexpr size_t WS_WOUT = WS_WBR + 4 * SZ_WSQ;
constexpr size_t WS_W1 = WS_WOUT + 4 * SZ_WSQ;
constexpr size_t WS_W2 = WS_W1 + 4 * SZ_W1;
constexpr size_t WS_TW256 = WS_W2 + 4 * SZ_W1;
constexpr size_t WS_TW1024 = WS_TW256 + 256 * 512 * 2;
constexpr size_t WS_WF = WS_TW1024 + 1024 * 2048 * 2;
constexpr size_t WS_WSP = WS_WF + 1024 * 512 * 2;
constexpr size_t WS_CK = WS_WSP + 4 * 4 * 128 * 128 * 2;
constexpr size_t WS_CV = WS_CK + (size_t)2 * 4 * 512 * 1024 * 2;
constexpr size_t WS_MOD = WS_CV + (size_t)2 * 4 * 512 * 1024 * 2;
constexpr size_t WS_H = ((WS_MOD + 4 * 3 * 12288 * 4) + 4095) & ~(size_t)4095;
constexpr size_t WS_QKV = WS_H + (size_t)M * D * 2;
constexpr size_t WS_P2 = WS_QKV + (size_t)3 * M * 1024 * 2;
constexpr size_t WS_FF1 = WS_QKV;
constexpr size_t WS_TT = WS_P2 + (size_t)M * P2W * 2;
constexpr size_t WS_TTL = WS_TT + (size_t)32 * 4 * 128 * 512 * 2;
constexpr size_t WS_OBR = WS_TT + (size_t)M * 1024 * 2;
constexpr size_t WS_MRG = WS_OBR + (size_t)M * D * 2;
constexpr size_t WS_T = WS_MRG + (size_t)M * D * 2;
constexpr size_t WS_SLAB = WS_T + (size_t)M_CTX * D * 4;
constexpr size_t WS_MIXB = WS_SLAB + (size_t)4 * M_LAT * D * 4;
constexpr size_t WS_END = WS_MIXB + (size_t)M_CTX * D * 2;
static_assert((size_t)M * D_FF * 2 <= (size_t)3 * M * 1024 * 2 + (size_t)M * P2W * 2, "FF1 overlay fits");
constexpr int CW_BAR = 4096;

constexpr int RING_BYTES = 131072, MISC_OFF = RING_BYTES + 320, LDS_BYTES = 147456;

#define LDS_WAIT() asm volatile("s_waitcnt lgkmcnt(0)" ::: "memory")
#define VM_WAIT() asm volatile("s_waitcnt vmcnt(0)" ::: "memory")

__device__ __forceinline__ unsigned cvt_pk_bf16(float lo, float hi) { unsigned r; asm volatile("v_cvt_pk_bf16_f32 %0, %1, %2" : "=v"(r) : "v"(lo), "v"(hi)); return r; }
__device__ __forceinline__ float bf2f(unsigned short h) { return __uint_as_float((unsigned)h << 16); }
__device__ __forceinline__ float bflo(unsigned w) { return __uint_as_float(w << 16); }
__device__ __forceinline__ float bfhi(unsigned w) { return __uint_as_float(w & 0xffff0000u); }
__device__ __forceinline__ float shx(float v, int o, int lane) { return __int_as_float(__builtin_amdgcn_ds_bpermute((lane ^ o) << 2, __float_as_int(v))); }
__device__ __forceinline__ float wave_sum(float v, int lane) {
#pragma unroll
    for (int o = 1; o < 64; o <<= 1) v += shx(v, o, lane);
    return v;
}

namespace pg8 {
constexpr int BM = 256, BK = 64, HALF = 128, HTB = HALF * BK * 2, STAGE_BYTES = 8 * HTB, NXCD = 8, WGM = 8;
__host__ __device__ __forceinline__ int lds_byte(int r, int c) { const int st = (r >> 4) * 2 + (c >> 5), rr = r & 15, cc = c & 31, ob = rr * 64 + cc * 2; return st * 1024 + (ob ^ (((ob >> 9) & 1) << 5)); }
__host__ __device__ __forceinline__ void stage_rc(int b, int& R, int& C) { const int st = b / 1024, sb = b % 1024, swz = sb ^ (((sb >> 9) & 1) << 5); R = (st >> 1) * 16 + swz / 64; C = (st & 1) * 32 + (swz % 64) / 2; }
__host__ __device__ __forceinline__ int perm32(int rho) { const int n = rho >> 4, i = rho & 15; return 8 * (i >> 2) + 4 * n + (i & 3); }

struct Unit { int pm, pn; const char* a; const char* b; int nt, aux; };
struct Dims { int lda, ldb, K; };

struct TileOrder {
    const char* A; const char* Bt; size_t tA, tB; int nM, nN, nwg, G, c, nt;
    __device__ __forceinline__ void init(const void* A_, size_t lda, const void* Bt_, size_t ldb, int M_, int N_, int K_, int G_, int c_) {
        A = (const char*)A_; Bt = (const char*)Bt_; tA = (size_t)BM * lda * 2; tB = (size_t)BM * ldb * 2; nM = M_ / BM; nN = N_ / BM; nwg = nM * nN; G = G_; c = c_; nt = K_ / BK; }
    __device__ __forceinline__ bool next(int i, Unit& u) const {
        const long L = (long)i * G + c; if (c < 0 || L >= nwg) return false;
        int wgid = (int)L; { const int q = nwg / NXCD, r = nwg % NXCD, xcd = wgid % NXCD, off = wgid / NXCD; wgid = (xcd < r ? xcd * (q + 1) : r * (q + 1) + (xcd - r) * q) + off; }
        const int nig = WGM * nN, gid = wgid / nig, fm = gid * WGM, gsz = (nM - fm) < WGM ? (nM - fm) : WGM;
        u.pm = fm + ((wgid % nig) % gsz); u.pn = (wgid % nig) / gsz; u.a = A + (size_t)u.pm * tA; u.b = Bt + (size_t)u.pn * tB; u.nt = nt; u.aux = 0; return true;
    }
};
struct BatchOrder {
    const char* A; const char* Bt; size_t tA, tB, bB; int nM, nN, nB, G, c, rt0, nt;
    __device__ __forceinline__ bool next(int i, Unit& u) const {
        const long L = (long)i * G + c; if (c < 0 || L >= (long)nB * nM * nN) return false;
        const int b = (int)L / (nM * nN), r = (int)L % (nM * nN), pm = r / nN, pn = r % nN;
        u.a = A + (size_t)pm * tA; u.b = Bt + (size_t)b * bB + (size_t)pn * tB; u.pm = rt0 + b * nM + pm; u.pn = pn; u.nt = nt; u.aux = 0; return true;
    }
};
template <int NSEG, int K1, int K2, int K3> struct BalOrder {
    const char* A; const char* Bt; size_t tA, tB; int c, ntq;
    __device__ __forceinline__ bool next(int i, Unit& u) const {
        const int x = c & 7, s = c >> 3;
        if (i < NSEG) { const int k0 = i == 0 ? 0 : (i == 1 ? K1 : K2), k1 = i == 0 ? K1 : (i == 1 ? K2 : K3);
            u.pm = 4 * x + (s >> 3); u.pn = s & 7; u.a = A + (size_t)u.pm * tA + (size_t)k0 * (BK * 2); u.b = Bt + (size_t)u.pn * tB + (size_t)k0 * (BK * 2); u.nt = k1 - k0; u.aux = i; return true; }
        if (i == NSEG) { const int q = s & 3; u.pm = 32 + x; u.pn = s >> 2; u.a = A + (size_t)u.pm * tA + (size_t)q * ntq * (BK * 2); u.b = Bt + (size_t)u.pn * tB + (size_t)q * ntq * (BK * 2); u.nt = ntq; u.aux = NSEG + q; return true; }
        return false;
    }
};

__device__ __forceinline__ f32x2 gelu_pk(f32x2 v) {
    const f32x2 av = __builtin_elementwise_abs(v), d = av * 0.2316418882f + 1.0f;
    f32x2 t; t.x = __builtin_amdgcn_rcpf(d.x); t.y = __builtin_amdgcn_rcpf(d.y);
    f32x2 q = t * 0.5307027145f + (-0.7265760135f); q = q * t + 0.7107068705f; q = q * t + (-0.142248368f); q = q * t + 0.127414796f; q = q * t;
    const f32x2 s = (v * v) * (-0.72134752044f);
    f32x2 e; e.x = __builtin_amdgcn_exp2f(s.x); e.y = __builtin_amdgcn_exp2f(s.y);
    const f32x2 m = v * (q * e), r = v - m;
    f32x2 o; o.x = v.x < 0.f ? m.x : r.x; o.y = v.y < 0.f ? m.y : r.y; return o;
}
__device__ __forceinline__ float sigmoidf_(float x) { return __builtin_amdgcn_rcpf(1.0f + __builtin_amdgcn_exp2f(-1.4426950408889634f * x)); }

typedef f32x4 Acc[2][2][4][2];
__device__ __forceinline__ u32x4 pack8(f32x4 v0, f32x4 v1) { u32x4 w; w.x = cvt_pk_bf16(v0[0], v0[1]); w.y = cvt_pk_bf16(v0[2], v0[3]); w.z = cvt_pk_bf16(v1[0], v1[1]); w.w = cvt_pk_bf16(v1[2], v1[3]); return w; }

struct EpiProj {
    static constexpr bool PERM = true;
    bf16_t* QKV; bf16_t* P2; float* ck; float* cv;
    __device__ __forceinline__ void operator()(const Acc& acc, const Unit& u, int wr, int wc, int fr, int fq) const {
        const int row0 = u.pm * BM + wr * 64 + fr, colw = wc * 32 + 8 * fq, pn = u.pn;
        if (pn < 12) {
            const int t = pn >> 2, cb = (pn & 3) * 256 + colw;
            bf16_t* base = QKV + (size_t)t * M * 1024 + cb;
            float* cbase = (t == 1 ? ck : cv) + cb;
            const bool wc_ = (t >= 1) && (u.pm < 32);
#pragma unroll
            for (int ai = 0; ai < 2; ++ai)
#pragma unroll
                for (int m = 0; m < 4; ++m) { const int row = row0 + ai * HALF + m * 16;
#pragma unroll
                    for (int bj = 0; bj < 2; ++bj) { const f32x4 v0 = acc[ai][bj][m][0], v1 = acc[ai][bj][m][1];
                        *(u32x4*)(base + (size_t)row * 1024 + bj * HALF) = pack8(v0, v1);
                        if (wc_) { float* cp = cbase + ((size_t)(row >> 8) * 1024 + (row & 255)) * 1024 + bj * HALF; *(f32x4*)cp = v0; *(f32x4*)(cp + 4) = v1; } } }
        } else {
            const int act = pn < 14 ? 0 : (pn < 18 ? 1 : 2);
            bf16_t* base = P2 + (pn - 12) * 256 + colw;
#pragma unroll
            for (int ai = 0; ai < 2; ++ai)
#pragma unroll
                for (int m = 0; m < 4; ++m) { const int row = row0 + ai * HALF + m * 16;
#pragma unroll
                    for (int bj = 0; bj < 2; ++bj) { f32x4 v0 = acc[ai][bj][m][0], v1 = acc[ai][bj][m][1];
                        if (act == 1) { f32x2 a = gelu_pk((f32x2){v0[0], v0[1]}), b = gelu_pk((f32x2){v0[2], v0[3]}), c = gelu_pk((f32x2){v1[0], v1[1]}), d = gelu_pk((f32x2){v1[2], v1[3]});
                            v0 = (f32x4){a.x, a.y, b.x, b.y}; v1 = (f32x4){c.x, c.y, d.x, d.y}; }
                        else if (act == 2) {
#pragma unroll
                            for (int e = 0; e < 4; ++e) { v0[e] = sigmoidf_(v0[e]); v1[e] = sigmoidf_(v1[e]); } }
                        *(u32x4*)(base + (size_t)row * P2W + bj * HALF) = pack8(v0, v1); } }
        }
    }
};
struct EpiTT {
    static constexpr bool PERM = true;
    bf16_t* TTC; bf16_t* TTL;
    __device__ __forceinline__ void operator()(const Acc& acc, const Unit& u, int wr, int wc, int fr, int fq) const {
        const int g = u.pm, tok0 = u.pn * BM + wc * 32 + 8 * fq;
#pragma unroll
        for (int bj = 0; bj < 2; ++bj) { const int tok = tok0 + bj * HALF;
            bf16_t* colp; int rs, js;
            if (tok < M_CTX) { const int b = tok >> 8, n1 = tok & 255; colp = TTC + ((size_t)(b * 4 + g) * 128) * 512 + n1; rs = 512; js = 256; }
            else { const int tl = tok - M_CTX, b = tl >> 10, n1 = tl & 1023; colp = TTL + ((size_t)(b * 4 + g) * 128) * 2048 + n1; rs = 2048; js = 1024; }
#pragma unroll
            for (int ai = 0; ai < 2; ++ai)
#pragma unroll
                for (int m = 0; m < 4; ++m) { const int k2 = wr * 64 + m * 16 + fr;
                    *(u32x4*)(colp + (size_t)k2 * rs + ai * js) = pack8(acc[ai][bj][m][0], acc[ai][bj][m][1]); } }
    }
};
struct EpiFour2 {
    static constexpr bool PERM = true;
    bf16_t* OBR; float scale;
    __device__ __forceinline__ void operator()(const Acc& acc, const Unit& u, int wr, int wc, int fr, int fq) const {
        const int row0 = u.pm * BM + wr * 64 + fr, col0 = OB_F + u.pn * BM + wc * 32 + 8 * fq;
#pragma unroll
        for (int ai = 0; ai < 2; ++ai)
#pragma unroll
            for (int m = 0; m < 4; ++m) { bf16_t* rowp = OBR + (size_t)(row0 + ai * HALF + m * 16) * D + col0;
#pragma unroll
                for (int bj = 0; bj < 2; ++bj) *(u32x4*)(rowp + bj * HALF) = pack8(acc[ai][bj][m][0] * scale, acc[ai][bj][m][1] * scale); }
    }
};
struct EpiBranch {
    static constexpr bool PERM = true;
    const bf16_t* P2; float* T; bf16_t* MRG; float* SLAB;
    __device__ __forceinline__ void operator()(const Acc& acc, const Unit& u, int wr, int wc, int fr, int fq) const {
        const int row0 = u.pm * BM + wr * 64 + fr, col0 = u.pn * BM + wc * 32 + 8 * fq, aux = u.aux;
        const int seg = aux < 3 ? aux : (aux < 5 ? 0 : aux - 4);
        const bf16_t* gate = P2 + (seg == 0 ? P2_GA : (seg == 1 ? P2_GF : P2_GC));
        float* dst = aux < 3 ? T : SLAB + (size_t)(aux - 3) * M_LAT * D - (size_t)M_CTX * D;
#pragma unroll
        for (int ai = 0; ai < 2; ++ai)
#pragma unroll
            for (int m = 0; m < 4; ++m) { const size_t row = (size_t)(row0 + ai * HALF + m * 16);
#pragma unroll
                for (int bj = 0; bj < 2; ++bj) { const int col = col0 + bj * HALF;
                    const u32x4 gw = *(const u32x4*)(gate + row * P2W + col);
                    f32x4 v0 = acc[ai][bj][m][0], v1 = acc[ai][bj][m][1];
                    v0 = v0 * (f32x4){bflo(gw.x), bfhi(gw.x), bflo(gw.y), bfhi(gw.y)}; v1 = v1 * (f32x4){bflo(gw.z), bfhi(gw.z), bflo(gw.w), bfhi(gw.w)};
                    float* tp = dst + row * D + col;
                    if (aux == 1 || aux == 2) { v0 = v0 + *(const f32x4*)tp; v1 = v1 + *(const f32x4*)(tp + 4); }
                    if (aux != 2) { *(f32x4*)tp = v0; *(f32x4*)(tp + 4) = v1; }
                    else *(u32x4*)(MRG + row * D + col) = pack8(v0, v1); } }
    }
};
struct EpiOut {
    static constexpr bool PERM = true;
    bf16_t* MIXB; float* SLAB;
    __device__ __forceinline__ void operator()(const Acc& acc, const Unit& u, int wr, int wc, int fr, int fq) const {
        const int row0 = u.pm * BM + wr * 64 + fr, col0 = u.pn * BM + wc * 32 + 8 * fq, aux = u.aux;
        float* dst = SLAB + (size_t)(aux - 1) * M_LAT * D - (size_t)M_CTX * D;
#pragma unroll
        for (int ai = 0; ai < 2; ++ai)
#pragma unroll
            for (int m = 0; m < 4; ++m) { const size_t row = (size_t)(row0 + ai * HALF + m * 16);
#pragma unroll
                for (int bj = 0; bj < 2; ++bj) { const int col = col0 + bj * HALF;
                    if (aux == 0) *(u32x4*)(MIXB + row * D + col) = pack8(acc[ai][bj][m][0], acc[ai][bj][m][1]);
                    else { float* tp = dst + row * D + col; *(f32x4*)tp = acc[ai][bj][m][0]; *(f32x4*)(tp + 4) = acc[ai][bj][m][1]; } } }
    }
};
struct EpiF32 {
    static constexpr bool PERM = false;
    float* O; int ldc;
    __device__ __forceinline__ void operator()(const Acc& acc, const Unit& u, int wr, int wc, int fr, int fq) const {
        const int row0 = u.pm * BM + wr * 64 + fr, col0 = u.pn * BM + wc * 32 + 4 * fq;
#pragma unroll
        for (int ai = 0; ai < 2; ++ai)
#pragma unroll
            for (int m = 0; m < 4; ++m) { float* rowp = O + (size_t)(row0 + ai * HALF + m * 16) * ldc + col0;
#pragma unroll
                for (int bj = 0; bj < 2; ++bj)
#pragma unroll
                    for (int n = 0; n < 2; ++n) *(f32x4*)(rowp + bj * HALF + n * 16) = acc[ai][bj][m][n]; }
    }
};
struct EpiRelu2 {
    static constexpr bool PERM = true;
    bf16_t* O; int ldc;
    __device__ __forceinline__ void operator()(const Acc& acc, const Unit& u, int wr, int wc, int fr, int fq) const {
        const int row0 = u.pm * BM + wr * 64 + fr, col0 = u.pn * BM + wc * 32 + 8 * fq;
#pragma unroll
        for (int ai = 0; ai < 2; ++ai)
#pragma unroll
            for (int m = 0; m < 4; ++m) { bf16_t* rowp = O + (size_t)(row0 + ai * HALF + m * 16) * ldc + col0;
#pragma unroll
                for (int bj = 0; bj < 2; ++bj) { f32x4 v0 = acc[ai][bj][m][0], v1 = acc[ai][bj][m][1];
#pragma unroll
                    for (int e = 0; e < 4; ++e) { const float a = fmaxf(v0[e], 0.f), b = fmaxf(v1[e], 0.f); v0[e] = a * a; v1[e] = b * b; }
                    *(u32x4*)(rowp + bj * HALF) = pack8(v0, v1); } }
    }
};

template <class Epi, class Sched, bool ALIGN_EPI>
__device__ __forceinline__ void gemm_phase(LAS unsigned char* lds, const Dims g, const Sched& S, const Epi& E) {
    int tid_ = threadIdx.x; asm volatile("" : "+v"(tid_));
    const int tid = tid_, wid = __builtin_amdgcn_readfirstlane(tid >> 6), lane = tid & 63, wr = wid >> 2, wc = wid & 3, fr = lane & 15, fq = lane >> 4;
    unsigned voffA[2], voffB[2];
#pragma unroll
    for (int i = 0; i < 2; ++i) { int R, C; stage_rc(tid * 16 + i * 8192, R, C); const int Rb = Epi::PERM ? ((R & ~31) + perm32(R & 31)) : R;
        voffA[i] = (unsigned)(R * g.lda + C) * 2u; voffB[i] = (unsigned)(Rb * g.ldb + C) * 2u; }
    const size_t kstep = (size_t)(BK * 2);
    const size_t hA = (size_t)HALF * g.lda * 2, hB = (size_t)HALF * g.ldb * 2;
    const unsigned ldsw = (unsigned)wid * 1024u;
    const int aoff = lds_byte(wr * 64 + fr, fq * 8), boff = lds_byte(wc * 32 + fr, fq * 8);
#define PG8_SA(b, h) (((b) * 2 + (h)) * HTB)
#define PG8_SB(b, h) ((4 + (b) * 2 + (h)) * HTB)
#define PG8_STAGE(bufoff, gbase, voff) do { _Pragma("unroll") for (int _i = 0; _i < 2; ++_i) \
        __builtin_amdgcn_global_load_lds((const unsigned*)((const char*)(gbase) + (voff)[_i]), (LAS unsigned*)(lds + (bufoff) + ldsw + _i * 8192), 16, 0, 0); } while (0)
#define PG8_LDA(dst, b, h) do { _Pragma("unroll") for (int m = 0; m < 4; ++m) _Pragma("unroll") for (int k = 0; k < 2; ++k) dst[m][k] = *(const LAS bf16x8*)(lds + PG8_SA(b, h) + aoff + m * 2048 + k * 1024); } while (0)
#define PG8_LDB(dst, b, h) do { _Pragma("unroll") for (int n = 0; n < 2; ++n) _Pragma("unroll") for (int k = 0; k < 2; ++k) dst[n][k] = *(const LAS bf16x8*)(lds + PG8_SB(b, h) + boff + n * 2048 + k * 1024); } while (0)
#define PG8_MMA(ai, bj, At, Bt) do { __builtin_amdgcn_s_setprio(1); _Pragma("unroll") for (int m = 0; m < 4; ++m) _Pragma("unroll") for (int n = 0; n < 2; ++n) _Pragma("unroll") for (int k = 0; k < 2; ++k) \
        acc[ai][bj][m][n] = __builtin_amdgcn_mfma_f32_16x16x32_bf16(Bt[n][k], At[m][k], acc[ai][bj][m][n], 0, 0, 0); __builtin_amdgcn_s_setprio(0); } while (0)
#define PG8_WAIT_V(n) asm volatile("s_waitcnt vmcnt(" #n ")" ::: "memory")
#define PG8_WAIT_L(n) asm volatile("s_waitcnt lgkmcnt(" #n ")" ::: "memory")
#define PG8_BAR __builtin_amdgcn_s_barrier()
#define PG8_SCHED __builtin_amdgcn_sched_barrier(0)
    Unit cur, nxt; int ui = 0;
    if (!S.next(0, cur)) return;
    Acc acc;
#pragma unroll
    for (int a = 0; a < 2; ++a)
#pragma unroll
        for (int b = 0; b < 2; ++b)
#pragma unroll
            for (int m = 0; m < 4; ++m)
#pragma unroll
                for (int n = 0; n < 2; ++n) acc[a][b][m][n] = (f32x4){0.f, 0.f, 0.f, 0.f};
    bf16x8 At[4][2], B0[2][2], B1[2][2];
    const char* cA = cur.a; const char* cB = cur.b;
    PG8_STAGE(PG8_SB(0, 0), cB, voffB); PG8_STAGE(PG8_SB(0, 1), cB + hB, voffB); PG8_STAGE(PG8_SA(0, 0), cA, voffA); PG8_STAGE(PG8_SA(0, 1), cA + hA, voffA);
    if (wr == 1) PG8_BAR;
    PG8_WAIT_V(2); PG8_BAR;
    PG8_STAGE(PG8_SB(1, 0), cB + kstep, voffB); PG8_STAGE(PG8_SA(1, 0), cA + kstep, voffA); PG8_STAGE(PG8_SB(1, 1), cB + hB + kstep, voffB);
    PG8_WAIT_V(6); PG8_BAR;
    for (;;) {
        const bool has_next = S.next(ui + 1, nxt);
        const char* nA = has_next ? nxt.a : cA; const char* nB = has_next ? nxt.b : cB;
        const int nt = cur.nt;
        for (int t = 0; t < nt; t += 2) {
            const bool last = (t == nt - 2);
            const char* a1 = cA + (size_t)(t + 1) * kstep;
            const char* a2 = last ? nA : cA + (size_t)(t + 2) * kstep; const char* b2 = last ? nB : cB + (size_t)(t + 2) * kstep;
            const char* a3 = a2 + kstep; const char* b3 = b2 + kstep;
            PG8_LDB(B0, 0, 0); PG8_LDB(B1, 0, 1); PG8_SCHED; PG8_LDA(At, 0, 0); PG8_STAGE(PG8_SA(1, 1), a1 + hA, voffA);
            PG8_WAIT_V(8); PG8_WAIT_L(0); PG8_BAR; PG8_MMA(0, 0, At, B0); PG8_MMA(0, 1, At, B1); PG8_BAR; PG8_SCHED;
            PG8_LDA(At, 0, 1); PG8_STAGE(PG8_SB(0, 0), b2, voffB); PG8_STAGE(PG8_SB(0, 1), b2 + hB, voffB); PG8_STAGE(PG8_SA(0, 0), a2, voffA);
            PG8_WAIT_V(8); PG8_WAIT_L(0); PG8_BAR; PG8_MMA(1, 0, At, B0); PG8_MMA(1, 1, At, B1); PG8_BAR; PG8_SCHED;
            PG8_LDB(B0, 1, 0); PG8_LDB(B1, 1, 1); PG8_SCHED; PG8_LDA(At, 1, 0); PG8_STAGE(PG8_SA(0, 1), a2 + hA, voffA);
            PG8_WAIT_V(8); PG8_WAIT_L(0); PG8_BAR; PG8_MMA(0, 0, At, B0); PG8_MMA(0, 1, At, B1); PG8_BAR; PG8_SCHED;
            PG8_LDA(At, 1, 1); PG8_STAGE(PG8_SB(1, 0), b3, voffB); PG8_STAGE(PG8_SB(1, 1), b3 + hB, voffB); PG8_STAGE(PG8_SA(1, 0), a3, voffA);
            PG8_WAIT_V(8); PG8_WAIT_L(0); PG8_BAR; PG8_MMA(1, 0, At, B0); PG8_MMA(1, 1, At, B1); PG8_BAR; PG8_SCHED;
        }
        if constexpr (ALIGN_EPI) { if (wr == 0) PG8_BAR; }
        E(acc, cur, wr, wc, fr, fq);
        if (!has_next) break;
#pragma unroll
        for (int a = 0; a < 2; ++a)
#pragma unroll
            for (int b = 0; b < 2; ++b)
#pragma unroll
                for (int m = 0; m < 4; ++m)
#pragma unroll
                    for (int n = 0; n < 2; ++n) acc[a][b][m][n] = (f32x4){0.f, 0.f, 0.f, 0.f};
        cur = nxt; cA = nA; cB = nB; ++ui;
        if constexpr (ALIGN_EPI) { if (wr == 1) PG8_BAR; }
    }
    PG8_WAIT_V(0);
    if constexpr (!ALIGN_EPI) { if (wr == 0) PG8_BAR; }
    PG8_BAR;
#undef PG8_SA
#undef PG8_SB
#undef PG8_STAGE
#undef PG8_LDA
#undef PG8_LDB
#undef PG8_MMA
#undef PG8_WAIT_V
#undef PG8_WAIT_L
#undef PG8_BAR
#undef PG8_SCHED
}
}

namespace att {
constexpr int NW = 8, QBLK = 32, KVBLK = 64, LD = 1024, LDO = D;
constexpr float SCALE = 0.088388347648318440f, THR = 8.f;
constexpr int SHM_V = KVBLK * 128 * 2, SHM_K = KVBLK * 128 * 2, OFF_WS = 2 * SHM_V + 2 * SHM_K, OFF_RPB = OFF_WS + NW * 64 * 4, ATT_LDS = OFF_RPB + 2048;
#define KSWZ(row, colB) ((row) * 256 + ((colB) ^ (((row) & 7) << 4)))
#define SBAR() __builtin_amdgcn_sched_barrier(0)
__device__ __forceinline__ int crow(int r, int hi) { return (r & 3) + 8 * (r >> 2) + 4 * hi; }
__device__ __forceinline__ bf16x8 ld8(const bf16_t* p) { return *reinterpret_cast<const bf16x8*>(p); }

__device__ __forceinline__ void partialSM(f32x16& p0, f32x16& p1, float& m_reg, float& mn, float& alpha) {
  constexpr float C = SCALE * 1.4426950408889634f;
  float pmax = p0[0];
#pragma unroll
  for (int r = 1; r < 16; ++r) pmax = fmaxf(pmax, p0[r]);
#pragma unroll
  for (int r = 0; r < 16; ++r) pmax = fmaxf(pmax, p1[r]);
  { auto rr = __builtin_amdgcn_permlane32_swap(__float_as_uint(pmax), __float_as_uint(pmax), false, false);
    pmax = fmaxf(__uint_as_float(rr[0]), __uint_as_float(rr[1])); }
  if (__builtin_expect(__all(pmax - m_reg <= THR / SCALE), 1)) { mn = m_reg; alpha = 1.f; }
  else { mn = fmaxf(m_reg, pmax); alpha = __builtin_amdgcn_exp2f((m_reg - mn) * C); m_reg = mn; }
  float mnC = -mn * C;
#pragma unroll
  for (int r = 0; r < 16; ++r) p0[r] = fmaf(p0[r], C, mnC);
#pragma unroll
  for (int r = 0; r < 16; ++r) p1[r] = fmaf(p1[r], C, mnC);
#pragma unroll
  for (int r = 0; r < 16; ++r) p0[r] = __builtin_amdgcn_exp2f(p0[r]);
}
__device__ __forceinline__ void finishSM(f32x16& p0, f32x16& p1, float alpha, float& l_reg, bf16x8& pa0, bf16x8& pa1, bf16x8& pa2, bf16x8& pa3) {
#pragma unroll
  for (int r = 0; r < 16; ++r) p1[r] = __builtin_amdgcn_exp2f(p1[r]);
  float ps = 0;
#pragma unroll
  for (int r = 0; r < 16; ++r) ps += p0[r];
#pragma unroll
  for (int r = 0; r < 16; ++r) ps += p1[r];
  { auto rr = __builtin_amdgcn_permlane32_swap(__float_as_uint(ps), __float_as_uint(ps), false, false);
    ps = __uint_as_float(rr[0]) + __uint_as_float(rr[1]); }
  l_reg = l_reg * alpha + ps;
#define PK4(P, BASE, OUT) do { unsigned a0 = cvt_pk_bf16(P[BASE + 0], P[BASE + 1]), a1 = cvt_pk_bf16(P[BASE + 2], P[BASE + 3]);   \
    unsigned b0 = cvt_pk_bf16(P[BASE + 4], P[BASE + 5]), b1 = cvt_pk_bf16(P[BASE + 6], P[BASE + 7]);                              \
    auto r0 = __builtin_amdgcn_permlane32_swap(a0, b0, false, false); auto r1 = __builtin_amdgcn_permlane32_swap(a1, b1, false, false); \
    u32x4 w = {r0[0], r1[0], r0[1], r1[1]}; OUT = *reinterpret_cast<bf16x8*>(&w); } while (0)
  PK4(p0, 0, pa0); PK4(p0, 8, pa1); PK4(p1, 0, pa2); PK4(p1, 8, pa3);
#undef PK4
}
__device__ __forceinline__ void qkt(f32x16& p0, f32x16& p1, const char* Ks, const bf16x8* qr, int r32, int hi) {
  p0 = f32x16{}; p1 = f32x16{};
#pragma unroll
  for (int d0 = 0; d0 < 8; ++d0) { int cb = (d0 * 16 + hi * 8) * 2;
    bf16x8 b0 = *reinterpret_cast<const bf16x8*>(Ks + KSWZ(r32, cb));
    bf16x8 b1 = *reinterpret_cast<const bf16x8*>(Ks + KSWZ(32 + r32, cb));
    p0 = __builtin_amdgcn_mfma_f32_32x32x16_bf16(b0, qr[d0], p0, 0, 0, 0);
    p1 = __builtin_amdgcn_mfma_f32_32x32x16_bf16(b1, qr[d0], p1, 0, 0, 0); }
}
__device__ __forceinline__ int v_st(int k, int c) { const int kk = (k & ~0xC) | ((k & 4) << 1) | ((k & 8) >> 1); return ((kk >> 3) * 4 + (c >> 5)) * 512 + ((kk & 7) * 32 + (c & 31)) * 2; }
__device__ __forceinline__ int v_rd_base(int lane) { return ((lane & 3) << 3) | (((lane >> 2) & 3) << 6) | (((lane >> 4) & 1) << 5) | (((lane >> 5) & 1) << 8); }
constexpr int v_rd_off(int d0, int ks, int half) { return d0 * 512 + ks * 4096 + half * 2048; }
template <int OFF> __device__ __forceinline__ s16x4 tr_read(int vb) {
  s16x4 r; asm volatile("ds_read_b64_tr_b16 %0, %1 offset:%2" : "=&v"(r) : "v"(vb), "i"(OFF) : "memory"); return r;
}
template <int D0> __device__ __forceinline__ void pv_one(f32x16& od, int vb, bf16x8 pa0, bf16x8 pa1, bf16x8 pa2, bf16x8 pa3) {
  const s16x4 l0 = tr_read<v_rd_off(D0, 0, 0)>(vb), h0 = tr_read<v_rd_off(D0, 0, 1)>(vb), l1 = tr_read<v_rd_off(D0, 1, 0)>(vb), h1 = tr_read<v_rd_off(D0, 1, 1)>(vb);
  const s16x4 l2 = tr_read<v_rd_off(D0, 2, 0)>(vb), h2 = tr_read<v_rd_off(D0, 2, 1)>(vb), l3 = tr_read<v_rd_off(D0, 3, 0)>(vb), h3 = tr_read<v_rd_off(D0, 3, 1)>(vb);
  asm volatile("s_waitcnt lgkmcnt(0)" ::: "memory"); SBAR();
#define PK(L, H) (bf16x8){L[0], L[1], L[2], L[3], H[0], H[1], H[2], H[3]}
  od = __builtin_amdgcn_mfma_f32_32x32x16_bf16(pa0, PK(l0, h0), od, 0, 0, 0);
  od = __builtin_amdgcn_mfma_f32_32x32x16_bf16(pa1, PK(l1, h1), od, 0, 0, 0);
  od = __builtin_amdgcn_mfma_f32_32x32x16_bf16(pa2, PK(l2, h2), od, 0, 0, 0);
  od = __builtin_amdgcn_mfma_f32_32x32x16_bf16(pa3, PK(l3, h3), od, 0, 0, 0);
#undef PK
}
__device__ __forceinline__ void pv_d0(f32x16* o, int vb, bf16x8 pa0, bf16x8 pa1, bf16x8 pa2, bf16x8 pa3) {
  pv_one<0>(o[0], vb, pa0, pa1, pa2, pa3); pv_one<1>(o[1], vb, pa0, pa1, pa2, pa3); pv_one<2>(o[2], vb, pa0, pa1, pa2, pa3); pv_one<3>(o[3], vb, pa0, pa1, pa2, pa3);
}
__device__ __forceinline__ void apply_bias(f32x16& p0, f32x16& p1, int kr, int qr, int rs, int qc, int cs, const float* rpbs, int hi) {
  const bool row_ok = (unsigned)(kr - rs) < 8u;
  const int base = (kr - qr + 7) * 31 + 15 - qc;
  const float ninf = -__builtin_inff();
#pragma unroll
  for (int r = 0; r < 16; ++r) {
    const int kc0 = crow(r, hi), kc1 = 32 + kc0;
    const bool ok0 = row_ok && ((unsigned)(kc0 - cs) < 16u), ok1 = row_ok && ((unsigned)(kc1 - cs) < 16u);
    const float b0 = rpbs[ok0 ? base + kc0 : 0], b1 = rpbs[ok1 ? base + kc1 : 0];
    p0[r] = ok0 ? p0[r] + b0 : ninf; p1[r] = ok1 ? p1[r] + b1 : ninf;
  }
}
template <bool LAT>
__device__ __forceinline__ void body(const bf16_t* __restrict__ Qb, const bf16_t* __restrict__ K0, const bf16_t* __restrict__ V0, int nt0,
                                     const bf16_t* __restrict__ K1, const bf16_t* __restrict__ V1, int NT, bf16_t* __restrict__ Ob, char* lds, int kr0, int qrb) {
  int tid_ = threadIdx.x; asm volatile("" : "+v"(tid_));
  const int tid = tid_, wid = tid >> 6, lane = tid & 63, r32 = lane & 31, hi = lane >> 5;
  char* V_lds = lds; char* K_lds = lds + 2 * SHM_V;
  float* ws = (float*)(lds + OFF_WS) + wid * 64; float* li_l = ws; float* al_l = ws + 32;
  const float* rpbs = (const float*)(lds + OFF_RPB);
  const int qr = qrb + (wid >> 1), qc = (wid & 1) * 32 + r32;
  const int rs = min(max(qr - 4, 0), 8), cs = min(max(qc - 8, 0), 48);
  float m_reg = -1e30f, l_reg = 0; f32x16 o[4] = {}; bf16x8 qreg[8];
  const bf16_t* Qw = Qb + (long)(wid * QBLK + r32) * LD + hi * 8;
#pragma unroll
  for (int d0 = 0; d0 < 8; ++d0) qreg[d0] = ld8(Qw + d0 * 16);
  const int sr = tid >> 4, sc = (tid & 15) * 8, vst0 = v_st(sr, sc), vst1 = v_st(32 + sr, sc);
  const int vb0 = (int)(uintptr_t)V_lds + v_rd_base(lane);
  struct { bf16x8 vs0, vs1, ks0, ks1; } sr_[2];
#define SLOAD(i, t) do { const int t_ = (t); const bf16_t* kp_ = (t_ < nt0) ? K0 + (long)t_ * KVBLK * LD : K1 + (long)(t_ - nt0) * KVBLK * LD; \
    const bf16_t* vp_ = (t_ < nt0) ? V0 + (long)t_ * KVBLK * LD : V1 + (long)(t_ - nt0) * KVBLK * LD; \
    sr_[i].vs0 = ld8(vp_ + (long)sr * LD + sc); sr_[i].vs1 = ld8(vp_ + (long)(32 + sr) * LD + sc); \
    sr_[i].ks0 = ld8(kp_ + (long)sr * LD + sc); sr_[i].ks1 = ld8(kp_ + (long)(32 + sr) * LD + sc); } while (0)
#define SWRITE(b, i) do { *(bf16x8*)(V_lds + (b) * SHM_V + vst0) = sr_[i].vs0;          \
    *(bf16x8*)(V_lds + (b) * SHM_V + vst1) = sr_[i].vs1; int kc = sc * 2;               \
    *(bf16x8*)(K_lds + (b) * SHM_K + KSWZ(sr, kc)) = sr_[i].ks0;                       \
    *(bf16x8*)(K_lds + (b) * SHM_K + KSWZ(32 + sr, kc)) = sr_[i].ks1; } while (0)
#define SWAIT() asm volatile("s_waitcnt vmcnt(4)" ::: "memory")
#define RESC(a) do { if (__any((a) < 1.f)) { if (hi == 0) al_l[r32] = (a); asm volatile("s_waitcnt lgkmcnt(0)" ::: "memory"); \
    _Pragma("unroll") for (int d = 0; d < 4; ++d) _Pragma("unroll") for (int r = 0; r < 16; ++r) o[d][r] *= al_l[crow(r, hi)]; } } while (0)
#define BIAS(P0, P1, t) do { if (LAT) { const int t_ = (t); if (t_ < nt0) apply_bias(P0, P1, kr0 + t_, qr, rs, qc, cs, rpbs, hi); } } while (0)
  f32x16 pA0, pA1, pB0, pB1; float mnA, mnB, alA, alB; bf16x8 pa0, pa1, pa2, pa3;
  constexpr int SE = 0, SO = 1;
  SLOAD(SE, 0); asm volatile("s_waitcnt vmcnt(0)" ::: "memory"); SWRITE(0, SE); __syncthreads();
  qkt(pA0, pA1, K_lds, qreg, r32, hi); BIAS(pA0, pA1, 0); partialSM(pA0, pA1, m_reg, mnA, alA);
  SLOAD(SO, 1); if (2 < NT) SLOAD(SE, 2);
  SWAIT(); SWRITE(1, SO); __syncthreads();
  for (int j = 1; j + 1 < NT; j += 2) {
    SBAR(); qkt(pB0, pB1, K_lds + SHM_K, qreg, r32, hi);
    finishSM(pA0, pA1, alA, l_reg, pa0, pa1, pa2, pa3); SBAR();
    SLOAD(SO, j + 2); SBAR();
    pv_d0(o, vb0, pa0, pa1, pa2, pa3); BIAS(pB0, pB1, j); partialSM(pB0, pB1, m_reg, mnB, alB);
    __syncthreads(); SWAIT(); SWRITE(0, SE);
    RESC(alB); __syncthreads();
    SBAR(); qkt(pA0, pA1, K_lds, qreg, r32, hi);
    finishSM(pB0, pB1, alB, l_reg, pa0, pa1, pa2, pa3); SBAR();
    if (j + 3 < NT) SLOAD(SE, j + 3); SBAR();
    pv_d0(o, vb0 + SHM_V, pa0, pa1, pa2, pa3); BIAS(pA0, pA1, j + 1); partialSM(pA0, pA1, m_reg, mnA, alA);
    __syncthreads(); SWAIT(); SWRITE(1, SO);
    RESC(alA); __syncthreads();
  }
  SBAR(); qkt(pB0, pB1, K_lds + SHM_K, qreg, r32, hi);
  finishSM(pA0, pA1, alA, l_reg, pa0, pa1, pa2, pa3); SBAR();
  pv_d0(o, vb0, pa0, pa1, pa2, pa3); BIAS(pB0, pB1, NT - 1); partialSM(pB0, pB1, m_reg, mnB, alB);
  __syncthreads(); RESC(alB);
  finishSM(pB0, pB1, alB, l_reg, pa0, pa1, pa2, pa3); SBAR();
  pv_d0(o, vb0 + SHM_V, pa0, pa1, pa2, pa3);
  if (hi == 0) li_l[r32] = l_reg; asm volatile("s_waitcnt lgkmcnt(0)" ::: "memory");
  float rli[16];
#pragma unroll
  for (int r = 0; r < 16; ++r) rli[r] = __builtin_amdgcn_rcpf(li_l[crow(r, hi)]);
  bf16_t* Ow = Ob + (long)(wid * QBLK) * LDO;
#pragma unroll
  for (int r = 0; r < 16; ++r) { const int orow = crow(r, hi);
#pragma unroll
    for (int d0 = 0; d0 < 4; ++d0) Ow[(long)orow * LDO + d0 * 32 + r32] = (bf16_t)(cvt_pk_bf16(o[d0][r] * rli[r], 0.f) & 0xffffu); }
#undef SLOAD
#undef SWRITE
#undef SWAIT
#undef RESC
#undef BIAS
}
}

#define XB_TMO      128
#define XB_XCNT(j)  (256  + 64 * (j))
#define XB_XSUB(j)  (1280 + 64 * (j))
#define XB_XGEN(j)  (2304 + 64 * (j))
#define XB_TOP      3328
#define XB_TOPGEN   3392
#define XCD_BAR_WORDS 3456
#define XB_SPIN_CAP (1u << 18)
__device__ __forceinline__ unsigned xb_ld(unsigned* p)              { return __hip_atomic_load(p, __ATOMIC_RELAXED, __HIP_MEMORY_SCOPE_AGENT); }
__device__ __forceinline__ unsigned xb_add(unsigned* p, unsigned v) { return __hip_atomic_fetch_add(p, v, __ATOMIC_RELAXED, __HIP_MEMORY_SCOPE_AGENT); }
__device__ __forceinline__ unsigned xb_xcc_id() { return (unsigned)__builtin_amdgcn_s_getreg((3 << 11) | 20) & 0xFu; }
#define XB_SPIN(cond, bar) do { unsigned _sp = 0; while (cond) { __builtin_amdgcn_s_sleep(1); \
    if ((++_sp & 255u) == 0u) { if (xb_ld(&(bar)[XB_TMO])) break; if (_sp > XB_SPIN_CAP) { atomicAdd(&(bar)[XB_TMO], 1u); break; } } } } while (0)
struct XcdBarrier { unsigned* bar; unsigned x; volatile LAS unsigned* st; };
__device__ __forceinline__ XcdBarrier xcd_barrier_post(unsigned* bar, volatile LAS unsigned* st) {
    XcdBarrier b; b.bar = bar; b.x = xb_xcc_id(); b.st = st;
    if (threadIdx.x == 0) (void)xb_add(&bar[XB_XCNT(b.x)], 1u);
    return b;
}
__device__ __forceinline__ void xcd_barrier_complete(unsigned* bar, unsigned x, unsigned& nloc, unsigned& nx) {
    const unsigned G = gridDim.x * gridDim.y * gridDim.z;
    unsigned sum, cnt, mine, sp = 0u;
    for (;;) {
        sum = 0u; cnt = 0u; mine = 0u;
#pragma unroll
        for (unsigned j = 0; j < 16; ++j) { const unsigned c = xb_ld(&bar[XB_XCNT(j)]); sum += c; cnt += (c > 0u) ? 1u : 0u; mine = (j == x) ? c : mine; }
        if (sum == G) break;
        __builtin_amdgcn_s_sleep(1);
        if ((++sp & 255u) == 0u) { if (xb_ld(&bar[XB_TMO])) break; if (sp > XB_SPIN_CAP) { atomicAdd(&bar[XB_TMO], 1u); break; } }
    }
    nloc = mine > 0u ? mine : 1u; nx = cnt > 0u ? cnt : 1u;
}
__device__ __forceinline__ void xcd_barrier(const XcdBarrier& b) {
    asm volatile("s_waitcnt vmcnt(0)" ::: "memory");
    __syncthreads();
    if (threadIdx.x == 0) {
        unsigned* bar = b.bar;
        __builtin_amdgcn_s_waitcnt(0);
        unsigned nloc = b.st[0], nx = b.st[1];
        if (nloc == 0u) { xcd_barrier_complete(bar, b.x, nloc, nx); b.st[0] = nloc; b.st[1] = nx; }
        const unsigned old = xb_add(&bar[XB_XSUB(b.x)], 1u);
        const unsigned gen = old / nloc;
        if (old + 1u == (gen + 1u) * nloc) {
            __builtin_amdgcn_fence(__ATOMIC_RELEASE, "agent");
            asm volatile("s_waitcnt vmcnt(0)" ::: "memory");
            const unsigned og = xb_add(&bar[XB_TOP], 1u);
            const unsigned tg = og / nx;
            if (og + 1u == (tg + 1u) * nx) xb_add(&bar[XB_TOPGEN], 1u);
            else XB_SPIN(xb_ld(&bar[XB_TOPGEN]) == tg, bar);
            __builtin_amdgcn_fence(__ATOMIC_ACQUIRE, "agent");
            xb_add(&bar[XB_XGEN(b.x)], 1u);
            asm volatile("s_waitcnt vmcnt(0)" ::: "memory");
        } else {
            XB_SPIN(xb_ld(&bar[XB_XGEN(b.x)]) == gen, bar);
            __builtin_amdgcn_fence(__ATOMIC_ACQUIRE, "agent");
            asm volatile("s_waitcnt vmcnt(0)" ::: "memory");
        }
    }
    __syncthreads();
}

struct Args { const float* in[23]; float* out; unsigned char* ws; int ph_lo, ph_hi; };
enum { I_XP = 0, I_XS, I_CK, I_CV, I_C, I_CCTX, I_WADA, I_BADA, I_GPREMIX, I_GPOSTMIX, I_GPREMLP, I_GPOSTMLP, I_WIN, I_RPB, I_GSGU, I_WSP, I_BSP, I_WBRA, I_WBRF, I_WBRC, I_WOUT, I_W1, I_W2 };
constexpr int NPRE = 2, NLP = 10, NPH = NPRE + DEPTH * NLP;

struct Frame {
    LAS unsigned char* lds; char* ldsg;
    int tid, lane, wave, G, bx;
};
typedef const __attribute__((address_space(4))) Args* KArgs;
__device__ __forceinline__ KArgs kargs() { KArgs p = (KArgs)__builtin_amdgcn_kernarg_segment_ptr(); asm volatile("" : "+s"(p)); return p; }
__device__ __forceinline__ int fresh_tid() { int t = threadIdx.x; asm volatile("" : "+v"(t)); return t; }
__device__ __forceinline__ void refresh(Frame& F) { F.tid = fresh_tid(); F.lane = F.tid & 63; F.wave = __builtin_amdgcn_readfirstlane(F.tid >> 6); int g = gridDim.x, b = blockIdx.x; asm volatile("" : "+s"(g), "+s"(b)); F.G = g; F.bx = b; }

__device__ __forceinline__ void tr_item(const float* W, int N, bf16_t* WT, int ldt, int koff, LAS float* scr, int item, int lane) {
    const int nblk = N / 32, kb = item / nblk, nb = item % nblk, k0 = 64 * kb, n0 = 32 * nb;
#pragma unroll 8
    for (int i = 0; i < 32; ++i) { const int kk = 2 * i + (lane >> 5); scr[kk * 33 + (lane & 31)] = W[(size_t)(k0 + kk) * N + n0 + (lane & 31)]; }
    LDS_WAIT(); asm volatile("" ::: "memory");
    const int c = lane & 7;
#pragma unroll
    for (int j = 0; j < 4; ++j) { const int n = (lane >> 3) + 8 * j; const LAS float* s = scr + (8 * c) * 33 + n;
        u32x4 o; o.x = cvt_pk_bf16(s[0 * 33], s[1 * 33]); o.y = cvt_pk_bf16(s[2 * 33], s[3 * 33]); o.z = cvt_pk_bf16(s[4 * 33], s[5 * 33]); o.w = cvt_pk_bf16(s[6 * 33], s[7 * 33]);
        *(u32x4*)(WT + (size_t)(n0 + n) * ldt + koff + k0 + 8 * c) = o; }
    LDS_WAIT(); asm volatile("" ::: "memory");
}
__device__ __forceinline__ bf16_t f2bf(float v) { return (bf16_t)(cvt_pk_bf16(v, 0.f) & 0xffffu); }

__device__ __forceinline__ void p0_weights(Frame& F) {
    refresh(F); KArgs A = kargs(); unsigned char* ws = A->ws;
    LAS float* scr = (LAS float*)(F.lds + F.wave * 16384);
    const int gw = F.bx * 8 + F.wave, NGW = F.G * 8;
    constexpr int I_IN = 32 * 336, I_BA = 16 * 64, I_BF = 8 * 64, I_BC = 8 * 64, I_OUT = 32 * 64, I_1 = 32 * 256, I_2 = 128 * 64, NPL = I_IN + I_BA + I_BF + I_BC + I_OUT + I_1 + I_2;
    for (int it = gw; it < DEPTH * NPL; it += NGW) {
        const int l = it / NPL; int r = it % NPL;
        const float* W; int N; bf16_t* WT; int ldt = D, koff = 0;
        if (r < I_IN) { W = A->in[I_WIN] + (size_t)l * D * IN_W; N = IN_W; WT = (bf16_t*)(ws + WS_WIN + l * SZ_WIN); }
        else if ((r -= I_IN) < I_BA) { W = A->in[I_WBRA] + (size_t)l * 1024 * D; N = D; WT = (bf16_t*)(ws + WS_WBR + l * SZ_WSQ); }
        else if ((r -= I_BA) < I_BF) { W = A->in[I_WBRF] + (size_t)l * 512 * D; N = D; WT = (bf16_t*)(ws + WS_WBR + l * SZ_WSQ); koff = 1024; }
        else if ((r -= I_BF) < I_BC) { W = A->in[I_WBRC] + (size_t)l * 512 * D; N = D; WT = (bf16_t*)(ws + WS_WBR + l * SZ_WSQ); koff = 1536; }
        else if ((r -= I_BC) < I_OUT) { W = A->in[I_WOUT] + (size_t)l * D * D; N = D; WT = (bf16_t*)(ws + WS_WOUT + l * SZ_WSQ); }
        else if ((r -= I_OUT) < I_1) { W = A->in[I_W1] + (size_t)l * D * D_FF; N = D_FF; WT = (bf16_t*)(ws + WS_W1 + l * SZ_W1); }
        else { r -= I_1; W = A->in[I_W2] + (size_t)l * D_FF * D; N = D; WT = (bf16_t*)(ws + WS_W2 + l * SZ_W1); ldt = D_FF; }
        tr_item(W, N, WT, ldt, koff, scr, r, F.lane);
    }
}
__device__ __forceinline__ void p0_tables(Frame& F) {
    refresh(F); KArgs A = kargs(); unsigned char* ws = A->ws;
    const int gt = F.bx * 512 + F.tid, GT = F.G * 512;
    bf16_t* tw256 = (bf16_t*)(ws + WS_TW256); bf16_t* tw1024 = (bf16_t*)(ws + WS_TW1024); bf16_t* wf = (bf16_t*)(ws + WS_WF);
    for (int i = gt; i < 256 * 512; i += GT) { const int k1 = i >> 9, cc = i & 511, n = cc & 255, ph = (k1 * n) & 255; const float a = (float)ph * (1.0f / 256.0f);
        tw256[i] = f2bf(cc < 256 ? __builtin_amdgcn_cosf(a) : -__builtin_amdgcn_sinf(a)); }
    for (int i = gt; i < 1024 * 2048; i += GT) { const int k1 = i >> 11, cc = i & 2047, n = cc & 1023, ph = (k1 * n) & 1023; const float a = (float)ph * (1.0f / 1024.0f);
        tw1024[i] = f2bf(cc < 1024 ? __builtin_amdgcn_cosf(a) : -__builtin_amdgcn_sinf(a)); }
    for (int i = gt; i < 1024 * 512; i += GT) { const int m = i >> 9, cc = i & 511, g = m >> 8, j = (m >> 7) & 1, k2 = m & 127, g2 = cc >> 7, n2 = cc & 127, ph = (k2 * n2) & 127; const float a = (float)ph * (1.0f / 128.0f);
        wf[i] = f2bf((g == g2) ? (j ? __builtin_amdgcn_sinf(a) : __builtin_amdgcn_cosf(a)) : 0.f); }
    { const f32x4* s = (const f32x4*)A->in[I_WSP]; u32x4* d = (u32x4*)(ws + WS_WSP);
      for (int i = gt; i < 4 * 4 * 128 * 128 / 8; i += GT) d[i] = pg8::pack8(s[2 * i], s[2 * i + 1]); }
    { const f32x4* s = (const f32x4*)A->in[I_CK]; u32x4* d = (u32x4*)(ws + WS_CK);
      for (int i = gt; i < 2 * 4 * 512 * 1024 / 8; i += GT) d[i] = pg8::pack8(s[2 * i], s[2 * i + 1]); }
    { const f32x4* s = (const f32x4*)A->in[I_CV]; u32x4* d = (u32x4*)(ws + WS_CV);
      for (int i = gt; i < 2 * 4 * 512 * 1024 / 8; i += GT) d[i] = pg8::pack8(s[2 * i], s[2 * i + 1]); }
}
__device__ __forceinline__ void p0_mod(Frame& F) {
    refresh(F); KArgs A = kargs();
    __syncthreads();
    LAS float* sv = (LAS float*)F.lds;
    LAS float* red = (LAS float*)(F.lds + 32768);
    { const float* cc = A->in[I_CCTX]; const float* c = A->in[I_C];
      for (int i = F.tid; i < 3 * D; i += 512) { const int v = i >> 11, k = i & 2047; const float x = v == 0 ? cc[k] : c[(v - 1) * D + k]; sv[i] = x * __builtin_amdgcn_rcpf(1.0f + __expf(-x)); } }
    __syncthreads();
    float* MOD = (float*)(A->ws + WS_MOD); const float* wada = A->in[I_WADA]; const float* bada = A->in[I_BADA];
    for (int item = F.bx; item < DEPTH * 192; item += F.G) {
        const int l = item / 192, j0 = (item % 192) * 64;
        const float* W = wada + (size_t)l * D * 12288 + j0 + (F.lane & 15) * 4;
        const int kbase = F.wave * 256 + (F.lane >> 4);
        f32x4 a0 = {0.f, 0.f, 0.f, 0.f}, a1 = a0, a2 = a0;
#pragma unroll 8
        for (int i = 0; i < 64; ++i) { const int k = kbase + 4 * i; const f32x4 w = *(const f32x4*)(W + (size_t)k * 12288);
            a0 += w * sv[k]; a1 += w * sv[D + k]; a2 += w * sv[2 * D + k]; }
#pragma unroll
        for (int e = 0; e < 4; ++e) { a0[e] += shx(a0[e], 16, F.lane); a0[e] += shx(a0[e], 32, F.lane); a1[e] += shx(a1[e], 16, F.lane); a1[e] += shx(a1[e], 32, F.lane); a2[e] += shx(a2[e], 16, F.lane); a2[e] += shx(a2[e], 32, F.lane); }
        if (F.lane < 16) { *(LAS f32x4*)(red + (F.wave * 3 + 0) * 64 + F.lane * 4) = a0; *(LAS f32x4*)(red + (F.wave * 3 + 1) * 64 + F.lane * 4) = a1; *(LAS f32x4*)(red + (F.wave * 3 + 2) * 64 + F.lane * 4) = a2; }
        __syncthreads();
        if (F.tid < 192) { const int v = F.tid >> 6, jj = F.tid & 63; float s = bada[l * 12288 + j0 + jj];
#pragma unroll
            for (int w = 0; w < 8; ++w) s += red[(w * 3 + v) * 64 + jj];
            MOD[(size_t)(l * 3 + v) * 12288 + j0 + jj] = s; }
        __syncthreads();
    }
}

__device__ __forceinline__ int mod_index(int m) { return m < M_CTX ? 0 : 1 + ((m - M_CTX) >> 10); }
__device__ __forceinline__ void load_row_f32(f32x4 (&v)[8], const float* row, int lane) {
#pragma unroll
    for (int j = 0; j < 4; ++j) { const f32x4* p = (const f32x4*)(row + 8 * (lane + 64 * j)); v[2 * j] = p[0]; v[2 * j + 1] = p[1]; }
}
__device__ __forceinline__ void store_row_f32(float* row, const f32x4 (&v)[8], int lane) {
#pragma unroll
    for (int j = 0; j < 4; ++j) { f32x4* p = (f32x4*)(row + 8 * (lane + 64 * j)); p[0] = v[2 * j]; p[1] = v[2 * j + 1]; }
}
__device__ __forceinline__ void norm_mod_store(const f32x4 (&v)[8], float rstd, const float* g, const float* sc, const float* sh, bf16_t* hrow, int lane) {
#pragma unroll
    for (int j = 0; j < 4; ++j) { const int c = 8 * (lane + 64 * j);
        f32x4 h[2];
#pragma unroll
        for (int e = 0; e < 2; ++e) { const f32x4 gg = *(const f32x4*)(g + c + 4 * e), s1 = *(const f32x4*)(sc + c + 4 * e), s0 = *(const f32x4*)(sh + c + 4 * e); h[e] = v[2 * j + e] * rstd * gg * (1.0f + s1) + s0; }
        *(u32x4*)(hrow + c) = pg8::pack8(h[0], h[1]); }
}
__device__ __forceinline__ float sumsq8(const f32x4 (&v)[8], int lane) {
    float s = 0.f;
#pragma unroll
    for (int j = 0; j < 8; ++j) s += (v[j][0] * v[j][0] + v[j][1] * v[j][1]) + (v[j][2] * v[j][2] + v[j][3] * v[j][3]);
    return wave_sum(s, lane);
}
__device__ __forceinline__ void p1_norm0(Frame& F) {
    refresh(F); KArgs A = kargs();
    const int gw = F.bx * 8 + F.wave, NGW = F.G * 8;
    const float* MOD = (const float*)(A->ws + WS_MOD); bf16_t* H = (bf16_t*)(A->ws + WS_H);
    const float* xp = A->in[I_XP]; const float* xs = A->in[I_XS]; const float* gpm = A->in[I_GPREMIX]; float* out = A->out;
    for (int m = gw; m < M; m += NGW) {
        const float* src = m < M_CTX ? xp + (size_t)m * D : xs + (size_t)(m - M_CTX) * D;
        f32x4 v[8]; load_row_f32(v, src, F.lane);
        const float rstd = __builtin_amdgcn_rsqf(sumsq8(v, F.lane) * (1.0f / D) + RMS_EPS);
        store_row_f32(out + (size_t)m * D, v, F.lane);
        const float* mv = MOD + (size_t)mod_index(m) * 12288;
        norm_mod_store(v, rstd, gpm, mv + 1 * D, mv + 0 * D, H + (size_t)m * D, F.lane);
    }
}
__device__ __forceinline__ void load_y(f32x4 (&y)[8], int m, const bf16_t* MIXB, const float* SLAB, int lane) {
    if (m < M_CTX) {
        const bf16_t* r = MIXB + (size_t)m * D;
#pragma unroll
        for (int j = 0; j < 4; ++j) { const u32x4 w = *(const u32x4*)(r + 8 * (lane + 64 * j));
            y[2 * j] = (f32x4){bflo(w.x), bfhi(w.x), bflo(w.y), bfhi(w.y)}; y[2 * j + 1] = (f32x4){bflo(w.z), bfhi(w.z), bflo(w.w), bfhi(w.w)}; }
    } else {
        const float* r = SLAB + (size_t)(m - M_CTX) * D;
        load_row_f32(y, r, lane);
#pragma unroll
        for (int q = 1; q < 4; ++q) { f32x4 t[8]; load_row_f32(t, r + (size_t)q * M_LAT * D, lane);
#pragma unroll
            for (int j = 0; j < 8; ++j) y[j] = y[j] + t[j]; }
    }
}
__device__ __forceinline__ void thin_phase(Frame& F, int i_gpost, int l, int gate_off, int i_gnext, int ln, int sc_off, int sh_off) {
    refresh(F); KArgs A = kargs();
    const int gw = F.bx * 8 + F.wave, NGW = F.G * 8;
    bf16_t* H = (bf16_t*)(A->ws + WS_H); const bf16_t* MIXB = (const bf16_t*)(A->ws + WS_MIXB); const float* SLAB = (const float*)(A->ws + WS_SLAB); float* out = A->out;
    const float* g_post = A->in[i_gpost] + l * D; const float* modc = (const float*)(A->ws + WS_MOD) + (size_t)l * 3 * 12288;
    const float* g_next = i_gnext >= 0 ? A->in[i_gnext] + ln * D : nullptr; const float* modn = (const float*)(A->ws + WS_MOD) + (size_t)ln * 3 * 12288;
    f32x4 xa[8], ya[8], xb[8], yb[8];
    int m = gw;
    if (m < M) { load_row_f32(xa, out + (size_t)m * D, F.lane); load_y(ya, m, MIXB, SLAB, F.lane); }
#define THIN_ROW(X, Y, mm) do { const int mi = mod_index(mm); float* xr = out + (size_t)(mm) * D; \
        const float r1 = __builtin_amdgcn_rsqf(sumsq8(Y, F.lane) * (1.0f / D) + RMS_EPS); \
        const float* gt = modc + (size_t)mi * 12288 + gate_off; \
        _Pragma("unroll") for (int j = 0; j < 4; ++j) _Pragma("unroll") for (int e = 0; e < 2; ++e) { const int c = 8 * (F.lane + 64 * j) + 4 * e; \
            X[2 * j + e] = X[2 * j + e] + *(const f32x4*)(gt + c) * (Y[2 * j + e] * r1 * *(const f32x4*)(g_post + c)); } \
        store_row_f32(xr, X, F.lane); \
        if (g_next) { const float r2 = __builtin_amdgcn_rsqf(sumsq8(X, F.lane) * (1.0f / D) + RMS_EPS); const float* mv = modn + (size_t)mi * 12288; \
            norm_mod_store(X, r2, g_next, mv + sc_off, mv + sh_off, H + (size_t)(mm) * D, F.lane); } } while (0)
    while (m < M) {
        const int m1 = m + NGW;
        if (m1 < M) { load_row_f32(xb, out + (size_t)m1 * D, F.lane); load_y(yb, m1, MIXB, SLAB, F.lane); }
        THIN_ROW(xa, ya, m);
        if (m1 >= M) break;
        const int m2 = m1 + NGW;
        if (m2 < M) { load_row_f32(xa, out + (size_t)m2 * D, F.lane); load_y(ya, m2, MIXB, SLAB, F.lane); }
        THIN_ROW(xb, yb, m1);
        m = m2;
    }
#undef THIN_ROW
}
__device__ __forceinline__ void merge_latent(Frame& F) {
    refresh(F); KArgs A = kargs();
    const float* SLAB = (const float*)(A->ws + WS_SLAB); bf16_t* MRG = (bf16_t*)(A->ws + WS_MRG) + (size_t)M_CTX * D;
    for (int i = F.bx * 512 + F.tid; i < M_LAT * D / 8; i += F.G * 512) {
        f32x4 a = ((const f32x4*)SLAB)[2 * i], b = ((const f32x4*)SLAB)[2 * i + 1];
#pragma unroll
        for (int q = 1; q < 4; ++q) { const f32x4* p = (const f32x4*)(SLAB + (size_t)q * M_LAT * D); a = a + p[2 * i]; b = b + p[2 * i + 1]; }
        ((u32x4*)MRG)[i] = pg8::pack8(a, b);
    }
}

__device__ __forceinline__ void sg_unit(Frame& F, KArgs A, int l, int unit) {
    const int c = unit >> 2, g = unit & 3, row0 = c * 128;
    const bf16_t* P2 = (const bf16_t*)(A->ws + WS_P2); bf16_t* OBR = (bf16_t*)(A->ws + WS_OBR);
    LAS bf16_t* vT = (LAS bf16_t*)F.lds;
    {
        const int pos = F.tid >> 2, d0 = (F.tid & 3) * 32;
        const bf16_t* vp = P2 + (size_t)(row0 + pos) * P2W + P2_V + g * 128 + d0;
        u32x4 w[4];
#pragma unroll
        for (int i = 0; i < 4; ++i) w[i] = ((const u32x4*)vp)[i];
        float v[32];
#pragma unroll
        for (int i = 0; i < 4; ++i)
#pragma unroll
            for (int e = 0; e < 4; ++e) { v[i * 8 + e * 2] = bflo(w[i][e]); v[i * 8 + e * 2 + 1] = bfhi(w[i][e]); }
        float ss = 0.f;
#pragma unroll
        for (int i = 0; i < 32; ++i) ss += v[i] * v[i];
        ss += shx(ss, 1, F.lane); ss += shx(ss, 2, F.lane);
        const float rstd = __builtin_amdgcn_rsqf(ss * (1.0f / 128.0f) + RMS_EPS);
        const float* gs = A->in[I_GSGU] + (l * 4 + g) * 128 + d0;
#pragma unroll
        for (int i = 0; i < 32; ++i) vT[(d0 + i) * 136 + pos] = f2bf(v[i] * rstd * gs[i]);
    }
    __syncthreads();
    {
        const int fr = F.lane & 15, quad = F.lane >> 4, pcol = F.wave * 16 + fr;
        const bf16_t* wp = (const bf16_t*)(A->ws + WS_WSP) + ((size_t)(l * 4 + g) * 128 + pcol) * 128 + quad * 8;
        bf16x8 bfr[4];
#pragma unroll
        for (int kk = 0; kk < 4; ++kk) bfr[kk] = *(const bf16x8*)(wp + kk * 32);
        f32x4 acc[8];
#pragma unroll
        for (int dt = 0; dt < 8; ++dt) { acc[dt] = (f32x4){0.f, 0.f, 0.f, 0.f};
#pragma unroll
            for (int kk = 0; kk < 4; ++kk) { const bf16x8 afr = *(const LAS bf16x8*)(vT + (dt * 16 + fr) * 136 + kk * 32 + quad * 8);
                acc[dt] = __builtin_amdgcn_mfma_f32_16x16x32_bf16(afr, bfr[kk], acc[dt], 0, 0, 0); } }
        const float bias = A->in[I_BSP][(l * 4 + g) * 128 + pcol];
        const bf16_t* up = P2 + (size_t)(row0 + pcol) * P2W + P2_U + g * 128 + quad * 4;
        bf16_t* op = OBR + (size_t)(row0 + pcol) * D + OB_C + g * 128 + quad * 4;
#pragma unroll
        for (int dt = 0; dt < 8; ++dt) { const u32x2 uw = *(const u32x2*)(up + dt * 16);
            u32x2 o; o.x = cvt_pk_bf16(bflo(uw.x) * (acc[dt][0] + bias), bfhi(uw.x) * (acc[dt][1] + bias)); o.y = cvt_pk_bf16(bflo(uw.y) * (acc[dt][2] + bias), bfhi(uw.y) * (acc[dt][3] + bias));
            *(u32x2*)(op + dt * 16) = o; }
    }
    __syncthreads();
}

__global__ void __launch_bounds__(512, 2) fwd(Args args) {
    extern __shared__ __attribute__((aligned(16))) unsigned char lds[];
    Frame F;
    F.lds = (LAS unsigned char*)lds; F.ldsg = (char*)lds;
    refresh(F);
    volatile LAS unsigned* MISC = (volatile LAS unsigned*)(F.lds + MISC_OFF);
    for (int u = F.tid; u < (LDS_BYTES - RING_BYTES) / 4; u += 512) ((LAS unsigned*)(F.lds + RING_BYTES))[u] = 0u;
    __syncthreads();
    const int lo = args.ph_lo, hi = args.ph_hi;
    XcdBarrier bar; bar.bar = (unsigned*)(args.ws + WS_CTL) + CW_BAR; bar.x = 0; bar.st = nullptr;
    if (hi - lo > 1) bar = xcd_barrier_post((unsigned*)(args.ws + WS_CTL) + CW_BAR, MISC + 8);
#define IN(p) (lo <= (p) && (p) < hi)
#define SEAM(p) do { if ((p) + 1 < hi) { XcdBarrier b_ = bar; asm volatile("" : "+s"(b_.bar)); xcd_barrier(b_); } } while (0)

    if (IN(0)) { p0_weights(F); p0_tables(F); p0_mod(F); SEAM(0); }
    if (IN(1)) { p1_norm0(F); SEAM(1); }

    for (int l = 0; l < DEPTH; ++l) {
        const int pb = NPRE + l * NLP;
        if (pb + NLP <= lo || pb >= hi) continue;
        if (IN(pb + 0)) {
            refresh(F); KArgs A = kargs(); unsigned char* ws = A->ws;
            pg8::Dims g{D, D, D}; pg8::TileOrder S; S.init(ws + WS_H, D, ws + WS_WIN + l * SZ_WIN, D, M, IN_W, D, F.G, F.bx);
            pg8::EpiProj E{(bf16_t*)(ws + WS_QKV), (bf16_t*)(ws + WS_P2), A->out + OUT_CK + (size_t)l * 256 * 1024, A->out + OUT_CV + (size_t)l * 256 * 1024};
            pg8::gemm_phase<pg8::EpiProj, pg8::TileOrder, true>(F.lds, g, S, E);
            SEAM(pb + 0);
        }
        if (IN(pb + 1)) {
            refresh(F); KArgs A = kargs(); unsigned char* ws = A->ws;
            pg8::Dims g{512, P2W, 512}; pg8::TileOrder S; S.init(ws + WS_WF, 512, (bf16_t*)(ws + WS_P2) + P2_F, P2W, 1024, M, 512, F.G, F.bx);
            pg8::EpiTT E{(bf16_t*)(ws + WS_TT), (bf16_t*)(ws + WS_TTL)};
            pg8::gemm_phase<pg8::EpiTT, pg8::TileOrder, true>(F.lds, g, S, E);
            SEAM(pb + 1);
        }
        if (IN(pb + 2)) {
            {
                refresh(F); KArgs A = kargs(); unsigned char* ws = A->ws;
                pg8::Dims g{2048, 2048, 2048};
                pg8::BatchOrder S{(const char*)(ws + WS_TW1024), (const char*)(ws + WS_TTL), (size_t)256 * 2048 * 2, (size_t)256 * 2048 * 2, (size_t)512 * 2048 * 2, 4, 2, 2, F.G, F.bx, 32, 32};
                pg8::EpiFour2 E{(bf16_t*)(ws + WS_OBR), 0.00276213586400995f};
                pg8::gemm_phase<pg8::EpiFour2, pg8::BatchOrder, false>(F.lds, g, S, E);
            }
            {
                refresh(F); KArgs A = kargs(); unsigned char* ws = A->ws;
                pg8::Dims g{512, 512, 512};
                pg8::BatchOrder S{(const char*)(ws + WS_TW256), (const char*)(ws + WS_TT), (size_t)256 * 512 * 2, (size_t)256 * 512 * 2, (size_t)512 * 512 * 2, 1, 2, 32, F.G, (F.bx + F.G - 16) % F.G, 0, 8};
                pg8::EpiFour2 E{(bf16_t*)(ws + WS_OBR), 0.005524271728019903f};
                pg8::gemm_phase<pg8::EpiFour2, pg8::BatchOrder, false>(F.lds, g, S, E);
            }
            {
                refresh(F); KArgs A = kargs(); unsigned char* ws = A->ws;
                const bf16_t* QKV = (const bf16_t*)(ws + WS_QKV); bf16_t* OBR = (bf16_t*)(ws + WS_OBR);
                for (int u = F.bx; u < 256; u += F.G) {
                    const int b = u >> 3, h = u & 7;
                    const bf16_t* Qb = QKV + (size_t)(b * 256) * 1024 + h * 128;
                    __syncthreads();
                    att::body<false>(Qb, Qb + (size_t)M * 1024, Qb + (size_t)2 * M * 1024, 4, nullptr, nullptr, 4, OBR + (size_t)(b * 256) * D + OB_A + h * 128, F.ldsg, 0, 0);
                }
            }
            {
                refresh(F); KArgs A = kargs(); unsigned char* ws = A->ws;
                const bf16_t* QKV = (const bf16_t*)(ws + WS_QKV); bf16_t* OBR = (bf16_t*)(ws + WS_OBR);
                for (int u = (F.bx + F.G - 80) % F.G; u < 64; u += F.G) {
                    const int j = u & 3, h = (u >> 2) & 7, b = u >> 5;
                    const int kr0 = j == 0 ? 0 : (j == 1 ? 0 : (j == 2 ? 4 : 8)), nt0 = (j == 0 || j == 3) ? 8 : 12;
                    __syncthreads();
                    { const int t = fresh_tid(); if (t < 465) ((float*)(F.ldsg + att::OFF_RPB))[t] = A->in[I_RPB][(l * 8 + h) * 465 + t] * (1.0f / att::SCALE); }
                    __syncthreads();
                    const size_t r0 = (size_t)M_CTX + b * 1024;
                    const bf16_t* Qb = QKV + (r0 + 256 * j) * 1024 + h * 128;
                    const bf16_t* K0 = QKV + (size_t)M * 1024 + (r0 + kr0 * 64) * 1024 + h * 128;
                    const bf16_t* K1 = (const bf16_t*)(ws + WS_CK) + ((size_t)(b * 4 + l) * 512) * 1024 + h * 128;
                    const bf16_t* V1 = (const bf16_t*)(ws + WS_CV) + ((size_t)(b * 4 + l) * 512) * 1024 + h * 128;
                    att::body<true>(Qb, K0, K0 + (size_t)M * 1024, nt0, K1, V1, nt0 + 8, OBR + (r0 + 256 * j) * D + OB_A + h * 128, F.ldsg, kr0, 4 * j);
                }
                __syncthreads();
            }
            {
                refresh(F); KArgs A = kargs();
                for (int u = F.G - 1 - F.bx; u < 320; u += F.G) sg_unit(F, A, l, u);
            }
            SEAM(pb + 2);
        }
        if (IN(pb + 3)) {
            refresh(F); KArgs A = kargs(); unsigned char* ws = A->ws;
            pg8::Dims g{D, D, D};
            typedef pg8::BalOrder<3, 16, 24, 32> BO3; BO3 S{(const char*)(ws + WS_OBR), (const char*)(ws + WS_WBR + l * SZ_WSQ), (size_t)256 * D * 2, (size_t)256 * D * 2, F.bx, 8};
            pg8::EpiBranch E{(const bf16_t*)(ws + WS_P2), (float*)(ws + WS_T), (bf16_t*)(ws + WS_MRG), (float*)(ws + WS_SLAB)};
            pg8::gemm_phase<pg8::EpiBranch, BO3, false>(F.lds, g, S, E);
            SEAM(pb + 3);
        }
        if (IN(pb + 4)) { merge_latent(F); SEAM(pb + 4); }
        if (IN(pb + 5)) {
            refresh(F); KArgs A = kargs(); unsigned char* ws = A->ws;
            pg8::Dims g{D, D, D};
            typedef pg8::BalOrder<1, 32, 0, 0> BO1; BO1 S{(const char*)(ws + WS_MRG), (const char*)(ws + WS_WOUT + l * SZ_WSQ), (size_t)256 * D * 2, (size_t)256 * D * 2, F.bx, 8};
            pg8::EpiOut E{(bf16_t*)(ws + WS_MIXB), (float*)(ws + WS_SLAB)};
            pg8::gemm_phase<pg8::EpiOut, BO1, false>(F.lds, g, S, E);
            SEAM(pb + 5);
        }
        if (IN(pb + 6)) {
            thin_phase(F, I_GPOSTMIX, l, 2 * D, I_GPREMLP, l, 4 * D, 3 * D);
            SEAM(pb + 6);
        }
        if (IN(pb + 7)) {
            refresh(F); KArgs A = kargs(); unsigned char* ws = A->ws;
            pg8::Dims g{D, D, D}; pg8::TileOrder S; S.init(ws + WS_H, D, ws + WS_W1 + l * SZ_W1, D, M, D_FF, D, F.G, F.bx);
            pg8::EpiRelu2 E{(bf16_t*)(ws + WS_FF1), D_FF}; pg8::gemm_phase<pg8::EpiRelu2, pg8::TileOrder, true>(F.lds, g, S, E);
            SEAM(pb + 7);
        }
        if (IN(pb + 8)) {
            refresh(F); KArgs A = kargs(); unsigned char* ws = A->ws;
            pg8::Dims g{D_FF, D_FF, D_FF};
            typedef pg8::BalOrder<1, 128, 0, 0> BO1; BO1 S{(const char*)(ws + WS_FF1), (const char*)(ws + WS_W2 + l * SZ_W1), (size_t)256 * D_FF * 2, (size_t)256 * D_FF * 2, F.bx, 32};
            pg8::EpiOut E{(bf16_t*)(ws + WS_MIXB), (float*)(ws + WS_SLAB)};
            pg8::gemm_phase<pg8::EpiOut, BO1, false>(F.lds, g, S, E);
            SEAM(pb + 8);
        }
        if (IN(pb + 9)) {
            const bool nx = l + 1 < DEPTH;
            thin_phase(F, I_GPOSTMLP, l, 5 * D, nx ? I_GPREMIX : -1, nx ? l + 1 : l, 1 * D, 0);
            SEAM(pb + 9);
        }
    }
#undef IN
#undef SEAM
}

extern "C" void kernel_launch(void* const* d_in, const int* in_sizes, int n_in, void* d_out, int out_size, void* d_ws, size_t ws_size, hipStream_t stream) {
    static int grid = 0;
    if (grid == 0) {
        if (n_in != 23 || out_size != (int)(OUT_CV + (size_t)32 * 4 * 256 * 1024) || ws_size < WS_END) {
            fprintf(stderr, "kernel_launch: shape mismatch: n_in %d out %d ws %zu (need %zu); nothing launched\n", n_in, out_size, ws_size, (size_t)WS_END); grid = -1; return; }
        int dev = 0, cus = 0, per_cu = 0;
        if (hipGetDevice(&dev) != hipSuccess || hipDeviceGetAttribute(&cus, hipDeviceAttributeMultiprocessorCount, dev) != hipSuccess) { fprintf(stderr, "kernel_launch: device query failed\n"); grid = -1; return; }
        if (hipFuncSetAttribute((const void*)fwd, hipFuncAttributeMaxDynamicSharedMemorySize, LDS_BYTES) != hipSuccess) { fprintf(stderr, "kernel_launch: hipFuncSetAttribute failed\n"); grid = -1; return; }
        if (hipOccupancyMaxActiveBlocksPerMultiprocessor(&per_cu, (const void*)fwd, 512, LDS_BYTES) != hipSuccess || per_cu < 1)
            fprintf(stderr, "kernel_launch: note: occupancy query reports %d workgroups per CU\n", per_cu);
        (void)hipGetLastError();
        if (cus != 256) { fprintf(stderr, "kernel_launch: built for a 256-CU device (got %d); nothing launched\n", cus); grid = -1; return; }
        grid = cus;
    }
    if (grid < 0) return;
    if (hipMemsetAsync((char*)d_ws + WS_CTL, 0, CTL_BYTES, stream) != hipSuccess) { fprintf(stderr, "kernel_launch: memset failed\n"); return; }
    Args a{};
    for (int i = 0; i < 23; ++i) a.in[i] = (const float*)d_in[i];
    a.out = (float*)d_out; a.ws = (unsigned char*)d_ws;
#if MK_PER_PHASE
    for (int p = 0; p < NPH; ++p) { a.ph_lo = p; a.ph_hi = p + 1; hipLaunchKernelGGL(fwd, dim3(grid), dim3(512), LDS_BYTES, stream, a); }
#else
    a.ph_lo = 0; a.ph_hi = NPH; hipLaunchKernelGGL(fwd, dim3(grid), dim3(512), LDS_BYTES, stream, a);
#endif
    const hipError_t le = hipPeekAtLastError();
    if (le != hipSuccess) fprintf(stderr, "kernel_launch: launch failed: %s\n", hipGetErrorName(le));
}
```

```cpp
#include <hip/hip_runtime.h>
#include <cstdio>
#include <cstdint>

#ifndef MK_PER_PHASE
#define MK_PER_PHASE 0
#endif

#define LAS __attribute__((address_space(3)))
#define GAS __attribute__((address_space(1)))
typedef unsigned short bf16_t;
typedef short bf16x8 __attribute__((ext_vector_type(8)));
typedef short s16x4 __attribute__((ext_vector_type(4)));
typedef float f32x2 __attribute__((ext_vector_type(2)));
typedef float f32x4 __attribute__((ext_vector_type(4)));
typedef float f32x16 __attribute__((ext_vector_type(16)));
typedef unsigned u32x2 __attribute__((ext_vector_type(2)));
typedef unsigned u32x4 __attribute__((ext_vector_type(4)));

constexpr int D = 2048, M_CTX = 8192, M_LAT = 2048, M = M_CTX + M_LAT, DEPTH = 4;
constexpr int IN_W = 10752, D_FF = 8192, P2W = 7680;
constexpr int P2_F = 0, P2_U = 512, P2_V = 1024, P2_GA = 1536, P2_GF = 3584, P2_GC = 5632;
constexpr int OB_A = 0, OB_F = 1024, OB_C = 1536;
constexpr float RMS_EPS = 1e-6f;
constexpr size_t OUT_YS = (size_t)M_CTX * D, OUT_CK = (size_t)M * D, OUT_CV = OUT_CK + (size_t)32 * 4 * 256 * 1024;

constexpr size_t MiB = 1u << 20;
constexpr size_t WS_CTL = 0, CTL_BYTES = MiB;
constexpr size_t SZ_WIN = (size_t)IN_W * D * 2, SZ_WSQ = (size_t)D * D * 2, SZ_W1 = (size_t)D_FF * D * 2;
constexpr size_t WS_WIN = CTL_BYTES;
constexpr size_t WS_WBR = WS_WIN + 4 * SZ_WIN;
constexpr size_t WS_WOUT = WS_WBR + 4 * SZ_WSQ;
constexpr size_t WS_W1 = WS_WOUT + 4 * SZ_WSQ;
constexpr size_t WS_W2 = WS_W1 + 4 * SZ_W1;
constexpr size_t WS_TW256 = WS_W2 + 4 * SZ_W1;
constexpr size_t WS_TW1024 = WS_TW256 + 256 * 512 * 2;
constexpr size_t WS_WF = WS_TW1024 + 1024 * 2048 * 2;
constexpr size_t WS_WSP = WS_WF + 1024 * 512 * 2;
constexpr size_t WS_CK = WS_WSP + 4 * 4 * 128 * 128 * 2;
constexpr size_t WS_CV = WS_CK + (size_t)2 * 4 * 512 * 1024 * 2;
constexpr size_t WS_MOD = WS_CV + (size_t)2 * 4 * 512 * 1024 * 2;
constexpr size_t WS_H = ((WS_MOD + 4 * 3 * 12288 * 4) + 4095) & ~(size_t)4095;
constexpr size_t WS_QKV = WS_H + (size_t)M * D * 2;
constexpr size_t WS_P2 = WS_QKV + (size_t)3 * M * 1024 * 2;
constexpr size_t WS_FF1 = WS_QKV;
constexpr size_t WS_TT = WS_P2 + (size_t)M * P2W * 2;
constexpr size_t WS_TTL = WS_TT + (size_t)32 * 4 * 128 * 512 * 2;
constexpr size_t WS_OBR = WS_TT + (size_t)M * 1024 * 2;
constexpr size_t WS_MRG = WS_OBR + (size_t)M * D * 2;
constexpr size_t WS_SLAB = WS_MRG + (size_t)M * D * 2;
constexpr size_t WS_MIXB = WS_SLAB + (size_t)4 * M_LAT * D * 4;
constexpr size_t WS_END = WS_MIXB + (size_t)M_CTX * D * 2;
static_assert((size_t)M * D_FF * 2 <= (size_t)3 * M * 1024 * 2 + (size_t)M * P2W * 2, "FF1 overlay fits");
constexpr int CW_BAR = 4096;

constexpr int RING_BYTES = 131072, MISC_OFF = RING_BYTES + 320, LDS_BYTES = 147456;

#define LDS_WAIT() asm volatile("s_waitcnt lgkmcnt(0)" ::: "memory")
#define VM_WAIT() asm volatile("s_waitcnt vmcnt(0)" ::: "memory")

__device__ __forceinline__ unsigned cvt_pk_bf16(float lo, float hi) { unsigned r; asm volatile("v_cvt_pk_bf16_f32 %0, %1, %2" : "=v"(r) : "v"(lo), "v"(hi)); return r; }
__device__ __forceinline__ float bf2f(unsigned short h) { return __uint_as_float((unsigned)h << 16); }
__device__ __forceinline__ float bflo(unsigned w) { return __uint_as_float(w << 16); }
__device__ __forceinline__ float bfhi(unsigned w) { return __uint_as_float(w & 0xffff0000u); }
__device__ __forceinline__ float shx(float v, int o, int lane) { return __int_as_float(__builtin_amdgcn_ds_bpermute((lane ^ o) << 2, __float_as_int(v))); }
__device__ __forceinline__ float wave_sum(float v, int lane) {
#pragma unroll
    for (int o = 1; o < 64; o <<= 1) v += shx(v, o, lane);
    return v;
}

namespace pg8 {
constexpr int BM = 256, BK = 64, HALF = 128, HTB = HALF * BK * 2, STAGE_BYTES = 8 * HTB, NXCD = 8, WGM = 8;
__host__ __device__ __forceinline__ int lds_byte(int r, int c) { const int st = (r >> 4) * 2 + (c >> 5), rr = r & 15, cc = c & 31, ob = rr * 64 + cc * 2; return st * 1024 + (ob ^ (((ob >> 9) & 1) << 5)); }
__host__ __device__ __forceinline__ void stage_rc(int b, int& R, int& C) { const int st = b / 1024, sb = b % 1024, swz = sb ^ (((sb >> 9) & 1) << 5); R = (st >> 1) * 16 + swz / 64; C = (st & 1) * 32 + (swz % 64) / 2; }
__host__ __device__ __forceinline__ int perm32(int rho) { const int n = rho >> 4, i = rho & 15; return 8 * (i >> 2) + 4 * n + (i & 3); }

struct Unit { int pm, pn; const char* a; const char* b; int nt, aux; };
struct Dims { int lda, ldb, K; };

struct TileOrder {
    const char* A; const char* Bt; size_t tA, tB; int nM, nN, nwg, G, c, nt;
    __device__ __forceinline__ void init(const void* A_, size_t lda, const void* Bt_, size_t ldb, int M_, int N_, int K_, int G_, int c_) {
        A = (const char*)A_; Bt = (const char*)Bt_; tA = (size_t)BM * lda * 2; tB = (size_t)BM * ldb * 2; nM = M_ / BM; nN = N_ / BM; nwg = nM * nN; G = G_; c = c_; nt = K_ / BK; }
    __device__ __forceinline__ bool next(int i, Unit& u) const {
        const long L = (long)i * G + c; if (c < 0 || L >= nwg) return false;
        int wgid = (int)L; { const int q = nwg / NXCD, r = nwg % NXCD, xcd = wgid % NXCD, off = wgid / NXCD; wgid = (xcd < r ? xcd * (q + 1) : r * (q + 1) + (xcd - r) * q) + off; }
        const int nig = WGM * nN, gid = wgid / nig, fm = gid * WGM, gsz = (nM - fm) < WGM ? (nM - fm) : WGM;
        u.pm = fm + ((wgid % nig) % gsz); u.pn = (wgid % nig) / gsz; u.a = A + (size_t)u.pm * tA; u.b = Bt + (size_t)u.pn * tB; u.nt = nt; u.aux = 0; return true;
    }
};
struct BatchOrder {
    const char* A; const char* Bt; size_t tA, tB, bB; int nM, nN, nB, G, c, rt0, nt;
    __device__ __forceinline__ bool next(int i, Unit& u) const {
        const long L = (long)i * G + c; if (c < 0 || L >= (long)nB * nM * nN) return false;
        const int b = (int)L / (nM * nN), r = (int)L % (nM * nN), pm = r / nN, pn = r % nN;
        u.a = A + (size_t)pm * tA; u.b = Bt + (size_t)b * bB + (size_t)pn * tB; u.pm = rt0 + b * nM + pm; u.pn = pn; u.nt = nt; u.aux = 0; return true;
    }
};
template <int NSEG, int K1, int K2, int K3> struct BalOrder {
    const char* A; const char* Bt; size_t tA, tB; int c, ntq;
    __device__ __forceinline__ bool next(int i, Unit& u) const {
        const int x = c & 7, s = c >> 3;
        if (i < NSEG) { const int k0 = i == 0 ? 0 : (i == 1 ? K1 : K2), k1 = i == 0 ? K1 : (i == 1 ? K2 : K3);
            u.pm = 4 * x + (s >> 3); u.pn = s & 7; u.a = A + (size_t)u.pm * tA + (size_t)k0 * (BK * 2); u.b = Bt + (size_t)u.pn * tB + (size_t)k0 * (BK * 2); u.nt = k1 - k0; u.aux = i; return true; }
        if (i == NSEG) { const int q = s & 3; u.pm = 32 + x; u.pn = s >> 2; u.a = A + (size_t)u.pm * tA + (size_t)q * ntq * (BK * 2); u.b = Bt + (size_t)u.pn * tB + (size_t)q * ntq * (BK * 2); u.nt = ntq; u.aux = NSEG + q; return true; }
        return false;
    }
};

__device__ __forceinline__ f32x2 gelu_pk(f32x2 v) {
    const f32x2 av = __builtin_elementwise_abs(v), d = av * 0.2316418882f + 1.0f;
    f32x2 t; t.x = __builtin_amdgcn_rcpf(d.x); t.y = __builtin_amdgcn_rcpf(d.y);
    f32x2 q = t * 0.5307027145f + (-0.7265760135f); q = q * t + 0.7107068705f; q = q * t + (-0.142248368f); q = q * t + 0.127414796f; q = q * t;
    const f32x2 s = (v * v) * (-0.72134752044f);
    f32x2 e; e.x = __builtin_amdgcn_exp2f(s.x); e.y = __builtin_amdgcn_exp2f(s.y);
    const f32x2 m = v * (q * e), r = v - m;
    f32x2 o; o.x = v.x < 0.f ? m.x : r.x; o.y = v.y < 0.f ? m.y : r.y; return o;
}
__device__ __forceinline__ float sigmoidf_(float x) { return __builtin_amdgcn_rcpf(1.0f + __builtin_amdgcn_exp2f(-1.4426950408889634f * x)); }

typedef f32x4 Acc[2][2][4][2];
__device__ __forceinline__ u32x4 pack8(f32x4 v0, f32x4 v1) { u32x4 w; w.x = cvt_pk_bf16(v0[0], v0[1]); w.y = cvt_pk_bf16(v0[2], v0[3]); w.z = cvt_pk_bf16(v1[0], v1[1]); w.w = cvt_pk_bf16(v1[2], v1[3]); return w; }

struct EpiProj {
    static constexpr bool PERM = true;
    bf16_t* QKV; bf16_t* P2; float* ck; float* cv;
    __device__ __forceinline__ void operator()(const Acc& acc, const Unit& u, int wr, int wc, int fr, int fq) const {
        const int row0 = u.pm * BM + wr * 64 + fr, colw = wc * 32 + 8 * fq, pn = u.pn;
        if (pn < 12) {
            const int t = pn >> 2, cb = (pn & 3) * 256 + colw;
            bf16_t* base = QKV + (size_t)t * M * 1024 + cb;
            float* cbase = (t == 1 ? ck : cv) + cb;
            const bool wc_ = (t >= 1) && (u.pm < 32);
#pragma unroll
            for (int ai = 0; ai < 2; ++ai)
#pragma unroll
                for (int m = 0; m < 4; ++m) { const int row = row0 + ai * HALF + m * 16;
#pragma unroll
                    for (int bj = 0; bj < 2; ++bj) { const f32x4 v0 = acc[ai][bj][m][0], v1 = acc[ai][bj][m][1];
                        *(u32x4*)(base + (size_t)row * 1024 + bj * HALF) = pack8(v0, v1);
                        if (wc_) { float* cp = cbase + ((size_t)(row >> 8) * 1024 + (row & 255)) * 1024 + bj * HALF; *(f32x4*)cp = v0; *(f32x4*)(cp + 4) = v1; } } }
        } else {
            const int act = (pn >= 14 && pn < 18) ? 1 : 0;
            bf16_t* base = P2 + (pn - 12) * 256 + colw;
#pragma unroll
            for (int ai = 0; ai < 2; ++ai)
#pragma unroll
                for (int m = 0; m < 4; ++m) { const int row = row0 + ai * HALF + m * 16;
#pragma unroll
                    for (int bj = 0; bj < 2; ++bj) { f32x4 v0 = acc[ai][bj][m][0], v1 = acc[ai][bj][m][1];
                        if (act == 1) { f32x2 a = gelu_pk((f32x2){v0[0], v0[1]}), b = gelu_pk((f32x2){v0[2], v0[3]}), c = gelu_pk((f32x2){v1[0], v1[1]}), d = gelu_pk((f32x2){v1[2], v1[3]});
                            v0 = (f32x4){a.x, a.y, b.x, b.y}; v1 = (f32x4){c.x, c.y, d.x, d.y}; }
                        *(u32x4*)(base + (size_t)row * P2W + bj * HALF) = pack8(v0, v1); } }
        }
    }
};
struct EpiTT {
    static constexpr bool PERM = true;
    bf16_t* TTC; bf16_t* TTL;
    __device__ __forceinline__ void operator()(const Acc& acc, const Unit& u, int wr, int wc, int fr, int fq) const {
        const int g = u.pm, tok0 = u.pn * BM + wc * 32 + 8 * fq;
#pragma unroll
        for (int bj = 0; bj < 2; ++bj) { const int tok = tok0 + bj * HALF;
            bf16_t* colp; int rs, js;
            if (tok < M_CTX) { const int b = tok >> 8, n1 = tok & 255; colp = TTC + ((size_t)(b * 4 + g) * 128) * 512 + n1; rs = 512; js = 256; }
            else { const int tl = tok - M_CTX, b = tl >> 10, n1 = tl & 1023; colp = TTL + ((size_t)(b * 4 + g) * 128) * 2048 + n1; rs = 2048; js = 1024; }
#pragma unroll
            for (int ai = 0; ai < 2; ++ai)
#pragma unroll
                for (int m = 0; m < 4; ++m) { const int k2 = wr * 64 + m * 16 + fr;
                    *(u32x4*)(colp + (size_t)k2 * rs + ai * js) = pack8(acc[ai][bj][m][0], acc[ai][bj][m][1]); } }
    }
};
struct EpiFour2 {
    static constexpr bool PERM = true;
    bf16_t* OBR; float scale;
    __device__ __forceinline__ void operator()(const Acc& acc, const Unit& u, int wr, int wc, int fr, int fq) const {
        const int row0 = u.pm * BM + wr * 64 + fr, col0 = OB_F + u.pn * BM + wc * 32 + 8 * fq;
#pragma unroll
        for (int ai = 0; ai < 2; ++ai)
#pragma unroll
            for (int m = 0; m < 4; ++m) { bf16_t* rowp = OBR + (size_t)(row0 + ai * HALF + m * 16) * D + col0;
#pragma unroll
                for (int bj = 0; bj < 2; ++bj) *(u32x4*)(rowp + bj * HALF) = pack8(acc[ai][bj][m][0] * scale, acc[ai][bj][m][1] * scale); }
    }
};
struct EpiBranch {
    static constexpr bool PERM = true;
    const bf16_t* P2; bf16_t* MRG; float* SLAB;
    __device__ __forceinline__ void operator()(const Acc& acc, const Unit& u, int wr, int wc, int fr, int fq) const {
        const int row0 = u.pm * BM + wr * 64 + fr, col0 = u.pn * BM + wc * 32 + 8 * fq, aux = u.aux;
        const int seg = aux < 3 ? aux : (aux < 5 ? 0 : aux - 4);
        const bf16_t* gate = P2 + (seg == 0 ? P2_GA : (seg == 1 ? P2_GF : P2_GC));
        float* dst = SLAB + (size_t)(aux - 3) * M_LAT * D - (size_t)M_CTX * D;
#pragma unroll
        for (int ai = 0; ai < 2; ++ai)
#pragma unroll
            for (int m = 0; m < 4; ++m) { const size_t row = (size_t)(row0 + ai * HALF + m * 16);
#pragma unroll
                for (int bj = 0; bj < 2; ++bj) { const int col = col0 + bj * HALF;
                    const u32x4 gw = *(const u32x4*)(gate + row * P2W + col);
                    bf16_t* mp = MRG + row * D + col;
                    u32x4 tw = {0u, 0u, 0u, 0u}; if (aux == 1 || aux == 2) tw = *(const u32x4*)mp;
                    f32x4 v0 = acc[ai][bj][m][0], v1 = acc[ai][bj][m][1];
                    v0 = v0 * (f32x4){sigmoidf_(bflo(gw.x)), sigmoidf_(bfhi(gw.x)), sigmoidf_(bflo(gw.y)), sigmoidf_(bfhi(gw.y))};
                    v1 = v1 * (f32x4){sigmoidf_(bflo(gw.z)), sigmoidf_(bfhi(gw.z)), sigmoidf_(bflo(gw.w)), sigmoidf_(bfhi(gw.w))};
                    if (aux < 3) { v0 = v0 + (f32x4){bflo(tw.x), bfhi(tw.x), bflo(tw.y), bfhi(tw.y)}; v1 = v1 + (f32x4){bflo(tw.z), bfhi(tw.z), bflo(tw.w), bfhi(tw.w)};
                        *(u32x4*)mp = pack8(v0, v1); }
                    else { float* tp = dst + row * D + col; *(f32x4*)tp = v0; *(f32x4*)(tp + 4) = v1; } } }
    }
};
struct EpiOut {
    static constexpr bool PERM = true;
    bf16_t* MIXB; float* SLAB;
    __device__ __forceinline__ void operator()(const Acc& acc, const Unit& u, int wr, int wc, int fr, int fq) const {
        const int row0 = u.pm * BM + wr * 64 + fr, col0 = u.pn * BM + wc * 32 + 8 * fq, aux = u.aux;
        float* dst = SLAB + (size_t)(aux - 1) * M_LAT * D - (size_t)M_CTX * D;
#pragma unroll
        for (int ai = 0; ai < 2; ++ai)
#pragma unroll
            for (int m = 0; m < 4; ++m) { const size_t row = (size_t)(row0 + ai * HALF + m * 16);
#pragma unroll
                for (int bj = 0; bj < 2; ++bj) { const int col = col0 + bj * HALF;
                    if (aux == 0) *(u32x4*)(MIXB + row * D + col) = pack8(acc[ai][bj][m][0], acc[ai][bj][m][1]);
                    else { float* tp = dst + row * D + col; *(f32x4*)tp = acc[ai][bj][m][0]; *(f32x4*)(tp + 4) = acc[ai][bj][m][1]; } } }
    }
};
struct EpiF32 {
    static constexpr bool PERM = false;
    float* O; int ldc;
    __device__ __forceinline__ void operator()(const Acc& acc, const Unit& u, int wr, int wc, int fr, int fq) const {
        const int row0 = u.pm * BM + wr * 64 + fr, col0 = u.pn * BM + wc * 32 + 4 * fq;
#pragma unroll
        for (int ai = 0; ai < 2; ++ai)
#pragma unroll
            for (int m = 0; m < 4; ++m) { float* rowp = O + (size_t)(row0 + ai * HALF + m * 16) * ldc + col0;
#pragma unroll
                for (int bj = 0; bj < 2; ++bj)
#pragma unroll
                    for (int n = 0; n < 2; ++n) *(f32x4*)(rowp + bj * HALF + n * 16) = acc[ai][bj][m][n]; }
    }
};
struct EpiRelu2 {
    static constexpr bool PERM = true;
    bf16_t* O; int ldc;
    __device__ __forceinline__ void operator()(const Acc& acc, const Unit& u, int wr, int wc, int fr, int fq) const {
        const int row0 = u.pm * BM + wr * 64 + fr, col0 = u.pn * BM + wc * 32 + 8 * fq;
#pragma unroll
        for (int ai = 0; ai < 2; ++ai)
#pragma unroll
            for (int m = 0; m < 4; ++m) { bf16_t* rowp = O + (size_t)(row0 + ai * HALF + m * 16) * ldc + col0;
#pragma unroll
                for (int bj = 0; bj < 2; ++bj) { f32x4 v0 = acc[ai][bj][m][0], v1 = acc[ai][bj][m][1];
#pragma unroll
                    for (int e = 0; e < 4; ++e) { const float a = fmaxf(v0[e], 0.f), b = fmaxf(v1[e], 0.f); v0[e] = a * a; v1[e] = b * b; }
                    *(u32x4*)(rowp + bj * HALF) = pack8(v0, v1); } }
    }
};

template <class Epi, class Sched, bool ALIGN_EPI>
__device__ __forceinline__ void gemm_phase(LAS unsigned char* lds, const Dims g, const Sched& S, const Epi& E) {
    int tid_ = threadIdx.x; asm volatile("" : "+v"(tid_));
    const int tid = tid_, wid = __builtin_amdgcn_readfirstlane(tid >> 6), lane = tid & 63, wr = wid >> 2, wc = wid & 3, fr = lane & 15, fq = lane >> 4;
    unsigned voffA[2], voffB[2];
#pragma unroll
    for (int i = 0; i < 2; ++i) { int R, C; stage_rc(tid * 16 + i * 8192, R, C); const int Rb = Epi::PERM ? ((R & ~31) + perm32(R & 31)) : R;
        voffA[i] = (unsigned)(R * g.lda + C) * 2u; voffB[i] = (unsigned)(Rb * g.ldb + C) * 2u; }
    const size_t kstep = (size_t)(BK * 2);
    const size_t hA = (size_t)HALF * g.lda * 2, hB = (size_t)HALF * g.ldb * 2;
    const unsigned ldsw = (unsigned)wid * 1024u;
    const int aoff = lds_byte(wr * 64 + fr, fq * 8), boff = lds_byte(wc * 32 + fr, fq * 8);
#define PG8_SA(b, h) (((b) * 2 + (h)) * HTB)
#define PG8_SB(b, h) ((4 + (b) * 2 + (h)) * HTB)
#define PG8_STAGE(bufoff, gbase, voff) do { _Pragma("unroll") for (int _i = 0; _i < 2; ++_i) \
        __builtin_amdgcn_global_load_lds((const unsigned*)((const char*)(gbase) + (voff)[_i]), (LAS unsigned*)(lds + (bufoff) + ldsw + _i * 8192), 16, 0, 0); } while (0)
#define PG8_LDA(dst, b, h) do { _Pragma("unroll") for (int m = 0; m < 4; ++m) _Pragma("unroll") for (int k = 0; k < 2; ++k) dst[m][k] = *(const LAS bf16x8*)(lds + PG8_SA(b, h) + aoff + m * 2048 + k * 1024); } while (0)
#define PG8_LDB(dst, b, h) do { _Pragma("unroll") for (int n = 0; n < 2; ++n) _Pragma("unroll") for (int k = 0; k < 2; ++k) dst[n][k] = *(const LAS bf16x8*)(lds + PG8_SB(b, h) + boff + n * 2048 + k * 1024); } while (0)
#define PG8_MMA(ai, bj, At, Bt) do { __builtin_amdgcn_s_setprio(1); _Pragma("unroll") for (int m = 0; m < 4; ++m) _Pragma("unroll") for (int n = 0; n < 2; ++n) _Pragma("unroll") for (int k = 0; k < 2; ++k) \
        acc[ai][bj][m][n] = __builtin_amdgcn_mfma_f32_16x16x32_bf16(Bt[n][k], At[m][k], acc[ai][bj][m][n], 0, 0, 0); __builtin_amdgcn_s_setprio(0); } while (0)
#define PG8_WAIT_V(n) asm volatile("s_waitcnt vmcnt(" #n ")" ::: "memory")
#define PG8_WAIT_L(n) asm volatile("s_waitcnt lgkmcnt(" #n ")" ::: "memory")
#define PG8_BAR __builtin_amdgcn_s_barrier()
#define PG8_SCHED __builtin_amdgcn_sched_barrier(0)
    Unit cur, nxt; int ui = 0;
    if (!S.next(0, cur)) return;
    Acc acc;
#pragma unroll
    for (int a = 0; a < 2; ++a)
#pragma unroll
        for (int b = 0; b < 2; ++b)
#pragma unroll
            for (int m = 0; m < 4; ++m)
#pragma unroll
                for (int n = 0; n < 2; ++n) acc[a][b][m][n] = (f32x4){0.f, 0.f, 0.f, 0.f};
    bf16x8 At[4][2], B0[2][2], B1[2][2];
    const char* cA = cur.a; const char* cB = cur.b;
    PG8_STAGE(PG8_SB(0, 0), cB, voffB); PG8_STAGE(PG8_SB(0, 1), cB + hB, voffB); PG8_STAGE(PG8_SA(0, 0), cA, voffA); PG8_STAGE(PG8_SA(0, 1), cA + hA, voffA);
    if (wr == 1) PG8_BAR;
    PG8_WAIT_V(2); PG8_BAR;
    PG8_STAGE(PG8_SB(1, 0), cB + kstep, voffB); PG8_STAGE(PG8_SA(1, 0), cA + kstep, voffA); PG8_STAGE(PG8_SB(1, 1), cB + hB + kstep, voffB);
    PG8_WAIT_V(6); PG8_BAR;
    for (;;) {
        const bool has_next = S.next(ui + 1, nxt);
        const char* nA = has_next ? nxt.a : cA; const char* nB = has_next ? nxt.b : cB;
        const int nt = cur.nt;
        for (int t = 0; t < nt; t += 2) {
            const bool last = (t == nt - 2);
            const char* a1 = cA + (size_t)(t + 1) * kstep;
            const char* a2 = last ? nA : cA + (size_t)(t + 2) * kstep; const char* b2 = last ? nB : cB + (size_t)(t + 2) * kstep;
            const char* a3 = a2 + kstep; const char* b3 = b2 + kstep;
            PG8_LDB(B0, 0, 0); PG8_LDB(B1, 0, 1); PG8_SCHED; PG8_LDA(At, 0, 0); PG8_STAGE(PG8_SA(1, 1), a1 + hA, voffA);
            PG8_WAIT_V(8); PG8_WAIT_L(0); PG8_BAR; PG8_MMA(0, 0, At, B0); PG8_MMA(0, 1, At, B1); PG8_BAR; PG8_SCHED;
            PG8_LDA(At, 0, 1); PG8_STAGE(PG8_SB(0, 0), b2, voffB); PG8_STAGE(PG8_SB(0, 1), b2 + hB, voffB); PG8_STAGE(PG8_SA(0, 0), a2, voffA);
            PG8_WAIT_V(8); PG8_WAIT_L(0); PG8_BAR; PG8_MMA(1, 0, At, B0); PG8_MMA(1, 1, At, B1); PG8_BAR; PG8_SCHED;
            PG8_LDB(B0, 1, 0); PG8_LDB(B1, 1, 1); PG8_SCHED; PG8_LDA(At, 1, 0); PG8_STAGE(PG8_SA(0, 1), a2 + hA, voffA);
            PG8_WAIT_V(8); PG8_WAIT_L(0); PG8_BAR; PG8_MMA(0, 0, At, B0); PG8_MMA(0, 1, At, B1); PG8_BAR; PG8_SCHED;
            PG8_LDA(At, 1, 1); PG8_STAGE(PG8_SB(1, 0), b3, voffB); PG8_STAGE(PG8_SB(1, 1), b3 + hB, voffB); PG8_STAGE(PG8_SA(1, 0), a3, voffA);
            PG8_WAIT_V(8); PG8_WAIT_L(0); PG8_BAR; PG8_MMA(1, 0, At, B0); PG8_MMA(1, 1, At, B1); PG8_BAR; PG8_SCHED;
        }
        if constexpr (ALIGN_EPI) { if (wr == 0) PG8_BAR; }
        E(acc, cur, wr, wc, fr, fq);
        if (!has_next) break;
#pragma unroll
        for (int a = 0; a < 2; ++a)
#pragma unroll
            for (int b = 0; b < 2; ++b)
#pragma unroll
                for (int m = 0; m < 4; ++m)
#pragma unroll
                    for (int n = 0; n < 2; ++n) acc[a][b][m][n] = (f32x4){0.f, 0.f, 0.f, 0.f};
        cur = nxt; cA = nA; cB = nB; ++ui;
        if constexpr (ALIGN_EPI) { if (wr == 1) PG8_BAR; }
    }
    PG8_WAIT_V(0);
    if constexpr (!ALIGN_EPI) { if (wr == 0) PG8_BAR; }
    PG8_BAR;
#undef PG8_SA
#undef PG8_SB
#undef PG8_STAGE
#undef PG8_LDA
#undef PG8_LDB
#undef PG8_MMA
#undef PG8_WAIT_V
#undef PG8_WAIT_L
#undef PG8_BAR
#undef PG8_SCHED
}
}

namespace att {
constexpr int NW = 8, QBLK = 32, KVBLK = 64, LD = 1024, LDO = D;
constexpr float SCALE = 0.088388347648318440f, THR = 8.f;
constexpr int SHM_V = KVBLK * 128 * 2, SHM_K = KVBLK * 128 * 2, OFF_WS = 2 * SHM_V + 2 * SHM_K, OFF_RPB = OFF_WS + NW * 64 * 4, ATT_LDS = OFF_RPB + 2048;
#define KSWZ(row, colB) ((row) * 256 + ((colB) ^ (((row) & 7) << 4)))
#define SBAR() __builtin_amdgcn_sched_barrier(0)
__device__ __forceinline__ int crow(int r, int hi) { return (r & 3) + 8 * (r >> 2) + 4 * hi; }
__device__ __forceinline__ bf16x8 ld8(const bf16_t* p) { return *reinterpret_cast<const bf16x8*>(p); }

__device__ __forceinline__ void partialSM(f32x16& p0, f32x16& p1, float& m_reg, float& mn, float& alpha) {
  constexpr float C = SCALE * 1.4426950408889634f;
  float pmax = p0[0];
#pragma unroll
  for (int r = 1; r < 16; ++r) pmax = fmaxf(pmax, p0[r]);
#pragma unroll
  for (int r = 0; r < 16; ++r) pmax = fmaxf(pmax, p1[r]);
  { auto rr = __builtin_amdgcn_permlane32_swap(__float_as_uint(pmax), __float_as_uint(pmax), false, false);
    pmax = fmaxf(__uint_as_float(rr[0]), __uint_as_float(rr[1])); }
  if (__builtin_expect(__all(pmax - m_reg <= THR / SCALE), 1)) { mn = m_reg; alpha = 1.f; }
  else { mn = fmaxf(m_reg, pmax); alpha = __builtin_amdgcn_exp2f((m_reg - mn) * C); m_reg = mn; }
  float mnC = -mn * C;
#pragma unroll
  for (int r = 0; r < 16; ++r) p0[r] = fmaf(p0[r], C, mnC);
#pragma unroll
  for (int r = 0; r < 16; ++r) p1[r] = fmaf(p1[r], C, mnC);
#pragma unroll
  for (int r = 0; r < 16; ++r) p0[r] = __builtin_amdgcn_exp2f(p0[r]);
}
__device__ __forceinline__ void finishSM(f32x16& p0, f32x16& p1, float alpha, float& l_reg, bf16x8& pa0, bf16x8& pa1, bf16x8& pa2, bf16x8& pa3) {
#pragma unroll
  for (int r = 0; r < 16; ++r) p1[r] = __builtin_amdgcn_exp2f(p1[r]);
  float ps = 0;
#pragma unroll
  for (int r = 0; r < 16; ++r) ps += p0[r];
#pragma unroll
  for (int r = 0; r < 16; ++r) ps += p1[r];
  { auto rr = __builtin_amdgcn_permlane32_swap(__float_as_uint(ps), __float_as_uint(ps), false, false);
    ps = __uint_as_float(rr[0]) + __uint_as_float(rr[1]); }
  l_reg = l_reg * alpha + ps;
#define PK4(P, BASE, OUT) do { unsigned a0 = cvt_pk_bf16(P[BASE + 0], P[BASE + 1]), a1 = cvt_pk_bf16(P[BASE + 2], P[BASE + 3]);   \
    unsigned b0 = cvt_pk_bf16(P[BASE + 4], P[BASE + 5]), b1 = cvt_pk_bf16(P[BASE + 6], P[BASE + 7]);                              \
    auto r0 = __builtin_amdgcn_permlane32_swap(a0, b0, false, false); auto r1 = __builtin_amdgcn_permlane32_swap(a1, b1, false, false); \
    u32x4 w = {r0[0], r1[0], r0[1], r1[1]}; OUT = *reinterpret_cast<bf16x8*>(&w); } while (0)
  PK4(p0, 0, pa0); PK4(p0, 8, pa1); PK4(p1, 0, pa2); PK4(p1, 8, pa3);
#undef PK4
}
__device__ __forceinline__ void qkt(f32x16& p0, f32x16& p1, const char* Ks, const bf16x8* qr, int r32, int hi) {
  p0 = f32x16{}; p1 = f32x16{};
#pragma unroll
  for (int d0 = 0; d0 < 8; ++d0) { int cb = (d0 * 16 + hi * 8) * 2;
    bf16x8 b0 = *reinterpret_cast<const bf16x8*>(Ks + KSWZ(r32, cb));
    bf16x8 b1 = *reinterpret_cast<const bf16x8*>(Ks + KSWZ(32 + r32, cb));
    p0 = __builtin_amdgcn_mfma_f32_32x32x16_bf16(b0, qr[d0], p0, 0, 0, 0);
    p1 = __builtin_amdgcn_mfma_f32_32x32x16_bf16(b1, qr[d0], p1, 0, 0, 0); }
}
__device__ __forceinline__ int v_st(int k, int c) { const int kk = (k & ~0xC) | ((k & 4) << 1) | ((k & 8) >> 1); return ((kk >> 3) * 4 + (c >> 5)) * 512 + ((kk & 7) * 32 + (c & 31)) * 2; }
__device__ __forceinline__ int v_rd_base(int lane) { return ((lane & 3) << 3) | (((lane >> 2) & 3) << 6) | (((lane >> 4) & 1) << 5) | (((lane >> 5) & 1) << 8); }
constexpr int v_rd_off(int d0, int ks, int half) { return d0 * 512 + ks * 4096 + half * 2048; }
template <int OFF> __device__ __forceinline__ s16x4 tr_read(int vb) {
  s16x4 r; asm volatile("ds_read_b64_tr_b16 %0, %1 offset:%2" : "=&v"(r) : "v"(vb), "i"(OFF) : "memory"); return r;
}
template <int D0> __device__ __forceinline__ void pv_one(f32x16& od, int vb, bf16x8 pa0, bf16x8 pa1, bf16x8 pa2, bf16x8 pa3) {
  const s16x4 l0 = tr_read<v_rd_off(D0, 0, 0)>(vb), h0 = tr_read<v_rd_off(D0, 0, 1)>(vb), l1 = tr_read<v_rd_off(D0, 1, 0)>(vb), h1 = tr_read<v_rd_off(D0, 1, 1)>(vb);
  const s16x4 l2 = tr_read<v_rd_off(D0, 2, 0)>(vb), h2 = tr_read<v_rd_off(D0, 2, 1)>(vb), l3 = tr_read<v_rd_off(D0, 3, 0)>(vb), h3 = tr_read<v_rd_off(D0, 3, 1)>(vb);
  asm volatile("s_waitcnt lgkmcnt(0)" ::: "memory"); SBAR();
#define PK(L, H) (bf16x8){L[0], L[1], L[2], L[3], H[0], H[1], H[2], H[3]}
  od = __builtin_amdgcn_mfma_f32_32x32x16_bf16(pa0, PK(l0, h0), od, 0, 0, 0);
  od = __builtin_amdgcn_mfma_f32_32x32x16_bf16(pa1, PK(l1, h1), od, 0, 0, 0);
  od = __builtin_amdgcn_mfma_f32_32x32x16_bf16(pa2, PK(l2, h2), od, 0, 0, 0);
  od = __builtin_amdgcn_mfma_f32_32x32x16_bf16(pa3, PK(l3, h3), od, 0, 0, 0);
#undef PK
}
__device__ __forceinline__ void pv_d0(f32x16* o, int vb, bf16x8 pa0, bf16x8 pa1, bf16x8 pa2, bf16x8 pa3) {
  pv_one<0>(o[0], vb, pa0, pa1, pa2, pa3); pv_one<1>(o[1], vb, pa0, pa1, pa2, pa3); pv_one<2>(o[2], vb, pa0, pa1, pa2, pa3); pv_one<3>(o[3], vb, pa0, pa1, pa2, pa3);
}
__device__ __forceinline__ void apply_bias(f32x16& p0, f32x16& p1, int kr, int qr, int rs, int qc, int cs, const float* rpbs, int hi) {
  const bool row_ok = (unsigned)(kr - rs) < 8u;
  const int base = (kr - qr + 7) * 31 + 15 - qc;
  const float ninf = -__builtin_inff();
#pragma unroll
  for (int r = 0; r < 16; ++r) {
    const int kc0 = crow(r, hi), kc1 = 32 + kc0;
    const bool ok0 = row_ok && ((unsigned)(kc0 - cs) < 16u), ok1 = row_ok && ((unsigned)(kc1 - cs) < 16u);
    const float b0 = rpbs[ok0 ? base + kc0 : 0], b1 = rpbs[ok1 ? base + kc1 : 0];
    p0[r] = ok0 ? p0[r] + b0 : ninf; p1[r] = ok1 ? p1[r] + b1 : ninf;
  }
}
template <bool LAT>
__device__ __forceinline__ void body(const bf16_t* __restrict__ Qb, const bf16_t* __restrict__ K0, const bf16_t* __restrict__ V0, int nt0,
                                     const bf16_t* __restrict__ K1, const bf16_t* __restrict__ V1, int NT, bf16_t* __restrict__ Ob, char* lds, int kr0, int qrb) {
  int tid_ = threadIdx.x; asm volatile("" : "+v"(tid_));
  const int tid = tid_, wid = tid >> 6, lane = tid & 63, r32 = lane & 31, hi = lane >> 5;
  char* V_lds = lds; char* K_lds = lds + 2 * SHM_V;
  float* ws = (float*)(lds + OFF_WS) + wid * 64; float* li_l = ws; float* al_l = ws + 32;
  const float* rpbs = (const float*)(lds + OFF_RPB);
  const int qr = qrb + (wid >> 1), qc = (wid & 1) * 32 + r32;
  const int rs = min(max(qr - 4, 0), 8), cs = min(max(qc - 8, 0), 48);
  float m_reg = -1e30f, l_reg = 0; f32x16 o[4] = {}; bf16x8 qreg[8];
  const bf16_t* Qw = Qb + (long)(wid * QBLK + r32) * LD + hi * 8;
#pragma unroll
  for (int d0 = 0; d0 < 8; ++d0) qreg[d0] = ld8(Qw + d0 * 16);
  const int sr = tid >> 4, sc = (tid & 15) * 8, vst0 = v_st(sr, sc), vst1 = v_st(32 + sr, sc);
  const int vb0 = (int)(uintptr_t)V_lds + v_rd_base(lane);
  struct { bf16x8 vs0, vs1, ks0, ks1; } sr_[2];
#define SLOAD(i, t) do { const int t_ = (t); const bf16_t* kp_ = (t_ < nt0) ? K0 + (long)t_ * KVBLK * LD : K1 + (long)(t_ - nt0) * KVBLK * LD; \
    const bf16_t* vp_ = (t_ < nt0) ? V0 + (long)t_ * KVBLK * LD : V1 + (long)(t_ - nt0) * KVBLK * LD; \
    sr_[i].vs0 = ld8(vp_ + (long)sr * LD + sc); sr_[i].vs1 = ld8(vp_ + (long)(32 + sr) * LD + sc); \
    sr_[i].ks0 = ld8(kp_ + (long)sr * LD + sc); sr_[i].ks1 = ld8(kp_ + (long)(32 + sr) * LD + sc); } while (0)
#define SWRITE(b, i) do { *(bf16x8*)(V_lds + (b) * SHM_V + vst0) = sr_[i].vs0;          \
    *(bf16x8*)(V_lds + (b) * SHM_V + vst1) = sr_[i].vs1; int kc = sc * 2;               \
    *(bf16x8*)(K_lds + (b) * SHM_K + KSWZ(sr, kc)) = sr_[i].ks0;                       \
    *(bf16x8*)(K_lds + (b) * SHM_K + KSWZ(32 + sr, kc)) = sr_[i].ks1; } while (0)
#define SWAIT() asm volatile("s_waitcnt vmcnt(4)" ::: "memory")
#define RESC(a) do { if (__any((a) < 1.f)) { if (hi == 0) al_l[r32] = (a); asm volatile("s_waitcnt lgkmcnt(0)" ::: "memory"); \
    _Pragma("unroll") for (int d = 0; d < 4; ++d) _Pragma("unroll") for (int r = 0; r < 16; ++r) o[d][r] *= al_l[crow(r, hi)]; } } while (0)
#define BIAS(P0, P1, t) do { if (LAT) { const int t_ = (t); if (t_ < nt0) apply_bias(P0, P1, kr0 + t_, qr, rs, qc, cs, rpbs, hi); } } while (0)
  f32x16 pA0, pA1, pB0, pB1; float mnA, mnB, alA, alB; bf16x8 pa0, pa1, pa2, pa3;
  constexpr int SE = 0, SO = 1;
  SLOAD(SE, 0); asm volatile("s_waitcnt vmcnt(0)" ::: "memory"); SWRITE(0, SE); __syncthreads();
  qkt(pA0, pA1, K_lds, qreg, r32, hi); BIAS(pA0, pA1, 0); partialSM(pA0, pA1, m_reg, mnA, alA);
  SLOAD(SO, 1); if (2 < NT) SLOAD(SE, 2);
  SWAIT(); SWRITE(1, SO); __syncthreads();
  for (int j = 1; j + 1 < NT; j += 2) {
    SBAR(); qkt(pB0, pB1, K_lds + SHM_K, qreg, r32, hi);
    finishSM(pA0, pA1, alA, l_reg, pa0, pa1, pa2, pa3); SBAR();
    SLOAD(SO, j + 2); SBAR();
    pv_d0(o, vb0, pa0, pa1, pa2, pa3); BIAS(pB0, pB1, j); partialSM(pB0, pB1, m_reg, mnB, alB);
    __syncthreads(); SWAIT(); SWRITE(0, SE);
    RESC(alB); __syncthreads();
    SBAR(); qkt(pA0, pA1, K_lds, qreg, r32, hi);
    finishSM(pB0, pB1, alB, l_reg, pa0, pa1, pa2, pa3); SBAR();
    if (j + 3 < NT) SLOAD(SE, j + 3); SBAR();
    pv_d0(o, vb0 + SHM_V, pa0, pa1, pa2, pa3); BIAS(pA0, pA1, j + 1); partialSM(pA0, pA1, m_reg, mnA, alA);
    __syncthreads(); SWAIT(); SWRITE(1, SO);
    RESC(alA); __syncthreads();
  }
  SBAR(); qkt(pB0, pB1, K_lds + SHM_K, qreg, r32, hi);
  finishSM(pA0, pA1, alA, l_reg, pa0, pa1, pa2, pa3); SBAR();
  pv_d0(o, vb0, pa0, pa1, pa2, pa3); BIAS(pB0, pB1, NT - 1); partialSM(pB0, pB1, m_reg, mnB, alB);
  __syncthreads(); RESC(alB);
  finishSM(pB0, pB1, alB, l_reg, pa0, pa1, pa2, pa3); SBAR();
  pv_d0(o, vb0 + SHM_V, pa0, pa1, pa2, pa3);
  if (hi == 0) li_l[r32] = l_reg; asm volatile("s_waitcnt lgkmcnt(0)" ::: "memory");
  float rli[16];
#pragma unroll
  for (int r = 0; r < 16; ++r) rli[r] = __builtin_amdgcn_rcpf(li_l[crow(r, hi)]);
  bf16_t* Ow = Ob + (long)(wid * QBLK) * LDO;
#pragma unroll
  for (int r = 0; r < 16; ++r) { const int orow = crow(r, hi);
#pragma unroll
    for (int d0 = 0; d0 < 4; ++d0) Ow[(long)orow * LDO + d0 * 32 + r32] = (bf16_t)(cvt_pk_bf16(o[d0][r] * rli[r], 0.f) & 0xffffu); }
#undef SLOAD
#undef SWRITE
#undef SWAIT
#undef RESC
#undef BIAS
}
}

#define XB_TMO      128
#define XB_XCNT(j)  (256  + 64 * (j))
#define XB_XSUB(j)  (1280 + 64 * (j))
#define XB_XGEN(j)  (2304 + 64 * (j))
#define XB_TOP      3328
#define XB_TOPGEN   3392
#define XCD_BAR_WORDS 3456
#define XB_SPIN_CAP (1u << 18)
__device__ __forceinline__ unsigned xb_ld(unsigned* p)              { return __hip_atomic_load(p, __ATOMIC_RELAXED, __HIP_MEMORY_SCOPE_AGENT); }
__device__ __forceinline__ unsigned xb_add(unsigned* p, unsigned v) { return __hip_atomic_fetch_add(p, v, __ATOMIC_RELAXED, __HIP_MEMORY_SCOPE_AGENT); }
__device__ __forceinline__ unsigned xb_xcc_id() { return (unsigned)__builtin_amdgcn_s_getreg((3 << 11) | 20) & 0xFu; }
#define XB_SPIN(cond, bar) do { unsigned _sp = 0; while (cond) { __builtin_amdgcn_s_sleep(1); \
    if ((++_sp & 255u) == 0u) { if (xb_ld(&(bar)[XB_TMO])) break; if (_sp > XB_SPIN_CAP) { atomicAdd(&(bar)[XB_TMO], 1u); break; } } } } while (0)
struct XcdBarrier { unsigned* bar; unsigned x; volatile LAS unsigned* st; };
__device__ __forceinline__ XcdBarrier xcd_barrier_post(unsigned* bar, volatile LAS unsigned* st) {
    XcdBarrier b; b.bar = bar; b.x = xb_xcc_id(); b.st = st;
    if (threadIdx.x == 0) (void)xb_add(&bar[XB_XCNT(b.x)], 1u);
    return b;
}
__device__ __forceinline__ void xcd_barrier_complete(unsigned* bar, unsigned x, unsigned& nloc, unsigned& nx) {
    const unsigned G = gridDim.x * gridDim.y * gridDim.z;
    unsigned sum, cnt, mine, sp = 0u;
    for (;;) {
        sum = 0u; cnt = 0u; mine = 0u;
#pragma unroll
        for (unsigned j = 0; j < 16; ++j) { const unsigned c = xb_ld(&bar[XB_XCNT(j)]); sum += c; cnt += (c > 0u) ? 1u : 0u; mine = (j == x) ? c : mine; }
        if (sum == G) break;
        __builtin_amdgcn_s_sleep(1);
        if ((++sp & 255u) == 0u) { if (xb_ld(&bar[XB_TMO])) break; if (sp > XB_SPIN_CAP) { atomicAdd(&bar[XB_TMO], 1u); break; } }
    }
    nloc = mine > 0u ? mine : 1u; nx = cnt > 0u ? cnt : 1u;
}
__device__ __forceinline__ void xcd_barrier(const XcdBarrier& b) {
    asm volatile("s_waitcnt vmcnt(0)" ::: "memory");
    __syncthreads();
    if (threadIdx.x == 0) {
        unsigned* bar = b.bar;
        __builtin_amdgcn_s_waitcnt(0);
        unsigned nloc = b.st[0], nx = b.st[1];
        if (nloc == 0u) { xcd_barrier_complete(bar, b.x, nloc, nx); b.st[0] = nloc; b.st[1] = nx; }
        const unsigned old = xb_add(&bar[XB_XSUB(b.x)], 1u);
        const unsigned gen = old / nloc;
        if (old + 1u == (gen + 1u) * nloc) {
            __builtin_amdgcn_fence(__ATOMIC_RELEASE, "agent");
            asm volatile("s_waitcnt vmcnt(0)" ::: "memory");
            const unsigned og = xb_add(&bar[XB_TOP], 1u);
            const unsigned tg = og / nx;
            if (og + 1u == (tg + 1u) * nx) xb_add(&bar[XB_TOPGEN], 1u);
            else XB_SPIN(xb_ld(&bar[XB_TOPGEN]) == tg, bar);
            __builtin_amdgcn_fence(__ATOMIC_ACQUIRE, "agent");
            xb_add(&bar[XB_XGEN(b.x)], 1u);
            asm volatile("s_waitcnt vmcnt(0)" ::: "memory");
        } else {
            XB_SPIN(xb_ld(&bar[XB_XGEN(b.x)]) == gen, bar);
            __builtin_amdgcn_fence(__ATOMIC_ACQUIRE, "agent");
            asm volatile("s_waitcnt vmcnt(0)" ::: "memory");
        }
    }
    __syncthreads();
}

struct Args { const float* in[23]; float* out; unsigned char* ws; int ph_lo, ph_hi; };
enum { I_XP = 0, I_XS, I_CK, I_CV, I_C, I_CCTX, I_WADA, I_BADA, I_GPREMIX, I_GPOSTMIX, I_GPREMLP, I_GPOSTMLP, I_WIN, I_RPB, I_GSGU, I_WSP, I_BSP, I_WBRA, I_WBRF, I_WBRC, I_WOUT, I_W1, I_W2 };
constexpr int NPRE = 2, NLP = 10, NPH = NPRE + DEPTH * NLP;

struct Frame {
    LAS unsigned char* lds; char* ldsg;
    int tid, lane, wave, G, bx;
};
typedef const __attribute__((address_space(4))) Args* KArgs;
__device__ __forceinline__ KArgs kargs() { KArgs p = (KArgs)__builtin_amdgcn_kernarg_segment_ptr(); asm volatile("" : "+s"(p)); return p; }
__device__ __forceinline__ int fresh_tid() { int t = threadIdx.x; asm volatile("" : "+v"(t)); return t; }
__device__ __forceinline__ void refresh(Frame& F) { F.tid = fresh_tid(); F.lane = F.tid & 63; F.wave = __builtin_amdgcn_readfirstlane(F.tid >> 6); int g = gridDim.x, b = blockIdx.x; asm volatile("" : "+s"(g), "+s"(b)); F.G = g; F.bx = b; }

__device__ __forceinline__ void tr_item(const float* W, int N, bf16_t* WT, int ldt, int koff, LAS float* scr, int item, int lane) {
    const int nblk = N / 32, kb = item / nblk, nb = item % nblk, k0 = 64 * kb, n0 = 32 * nb;
#pragma unroll 8
    for (int i = 0; i < 32; ++i) { const int kk = 2 * i + (lane >> 5); scr[kk * 33 + (lane & 31)] = W[(size_t)(k0 + kk) * N + n0 + (lane & 31)]; }
    LDS_WAIT(); asm volatile("" ::: "memory");
    const int c = lane & 7;
#pragma unroll
    for (int j = 0; j < 4; ++j) { const int n = (lane >> 3) + 8 * j; const LAS float* s = scr + (8 * c) * 33 + n;
        u32x4 o; o.x = cvt_pk_bf16(s[0 * 33], s[1 * 33]); o.y = cvt_pk_bf16(s[2 * 33], s[3 * 33]); o.z = cvt_pk_bf16(s[4 * 33], s[5 * 33]); o.w = cvt_pk_bf16(s[6 * 33], s[7 * 33]);
        *(u32x4*)(WT + (size_t)(n0 + n) * ldt + koff + k0 + 8 * c) = o; }
    LDS_WAIT(); asm volatile("" ::: "memory");
}
__device__ __forceinline__ bf16_t f2bf(float v) { return (bf16_t)(cvt_pk_bf16(v, 0.f) & 0xffffu); }

__device__ __forceinline__ void p0_weights(Frame& F) {
    refresh(F); KArgs A = kargs(); unsigned char* ws = A->ws;
    LAS float* scr = (LAS float*)(F.lds + F.wave * 16384);
    const int gw = F.bx * 8 + F.wave, NGW = F.G * 8;
    constexpr int I_IN = 32 * 336, I_BA = 16 * 64, I_BF = 8 * 64, I_BC = 8 * 64, I_OUT = 32 * 64, I_1 = 32 * 256, I_2 = 128 * 64, NPL = I_IN + I_BA + I_BF + I_BC + I_OUT + I_1 + I_2;
    for (int it = gw; it < DEPTH * NPL; it += NGW) {
        const int l = it / NPL; int r = it % NPL;
        const float* W; int N; bf16_t* WT; int ldt = D, koff = 0;
        if (r < I_IN) { W = A->in[I_WIN] + (size_t)l * D * IN_W; N = IN_W; WT = (bf16_t*)(ws + WS_WIN + l * SZ_WIN); }
        else if ((r -= I_IN) < I_BA) { W = A->in[I_WBRA] + (size_t)l * 1024 * D; N = D; WT = (bf16_t*)(ws + WS_WBR + l * SZ_WSQ); }
        else if ((r -= I_BA) < I_BF) { W = A->in[I_WBRF] + (size_t)l * 512 * D; N = D; WT = (bf16_t*)(ws + WS_WBR + l * SZ_WSQ); koff = 1024; }
        else if ((r -= I_BF) < I_BC) { W = A->in[I_WBRC] + (size_t)l * 512 * D; N = D; WT = (bf16_t*)(ws + WS_WBR + l * SZ_WSQ); koff = 1536; }
        else if ((r -= I_BC) < I_OUT) { W = A->in[I_WOUT] + (size_t)l * D * D; N = D; WT = (bf16_t*)(ws + WS_WOUT + l * SZ_WSQ); }
        else if ((r -= I_OUT) < I_1) { W = A->in[I_W1] + (size_t)l * D * D_FF; N = D_FF; WT = (bf16_t*)(ws + WS_W1 + l * SZ_W1); }
        else { r -= I_1; W = A->in[I_W2] + (size_t)l * D_FF * D; N = D; WT = (bf16_t*)(ws + WS_W2 + l * SZ_W1); ldt = D_FF; }
        tr_item(W, N, WT, ldt, koff, scr, r, F.lane);
    }
}
__device__ __forceinline__ void p0_tables(Frame& F) {
    refresh(F); KArgs A = kargs(); unsigned char* ws = A->ws;
    const int gt = F.bx * 512 + F.tid, GT = F.G * 512;
    bf16_t* tw256 = (bf16_t*)(ws + WS_TW256); bf16_t* tw1024 = (bf16_t*)(ws + WS_TW1024); bf16_t* wf = (bf16_t*)(ws + WS_WF);
    for (int i = gt; i < 256 * 512; i += GT) { const int k1 = i >> 9, cc = i & 511, n = cc & 255, ph = (k1 * n) & 255; const float a = (float)ph * (1.0f / 256.0f);
        tw256[i] = f2bf(cc < 256 ? __builtin_amdgcn_cosf(a) : -__builtin_amdgcn_sinf(a)); }
    for (int i = gt; i < 1024 * 2048; i += GT) { const int k1 = i >> 11, cc = i & 2047, n = cc & 1023, ph = (k1 * n) & 1023; const float a = (float)ph * (1.0f / 1024.0f);
        tw1024[i] = f2bf(cc < 1024 ? __builtin_amdgcn_cosf(a) : -__builtin_amdgcn_sinf(a)); }
    for (int i = gt; i < 1024 * 512; i += GT) { const int m = i >> 9, cc = i & 511, g = m >> 8, j = (m >> 7) & 1, k2 = m & 127, g2 = cc >> 7, n2 = cc & 127, ph = (k2 * n2) & 127; const float a = (float)ph * (1.0f / 128.0f);
        wf[i] = f2bf((g == g2) ? (j ? __builtin_amdgcn_sinf(a) : __builtin_amdgcn_cosf(a)) : 0.f); }
    { const f32x4* s = (const f32x4*)A->in[I_WSP]; u32x4* d = (u32x4*)(ws + WS_WSP);
      for (int i = gt; i < 4 * 4 * 128 * 128 / 8; i += GT) d[i] = pg8::pack8(s[2 * i], s[2 * i + 1]); }
    { const f32x4* s = (const f32x4*)A->in[I_CK]; u32x4* d = (u32x4*)(ws + WS_CK);
      for (int i = gt; i < 2 * 4 * 512 * 1024 / 8; i += GT) d[i] = pg8::pack8(s[2 * i], s[2 * i + 1]); }
    { const f32x4* s = (const f32x4*)A->in[I_CV]; u32x4* d = (u32x4*)(ws + WS_CV);
      for (int i = gt; i < 2 * 4 * 512 * 1024 / 8; i += GT) d[i] = pg8::pack8(s[2 * i], s[2 * i + 1]); }
}
__device__ __forceinline__ void p0_mod(Frame& F) {
    refresh(F); KArgs A = kargs();
    __syncthreads();
    LAS float* sv = (LAS float*)F.lds;
    LAS float* red = (LAS float*)(F.lds + 32768);
    { const float* cc = A->in[I_CCTX]; const float* c = A->in[I_C];
      for (int i = F.tid; i < 3 * D; i += 512) { const int v = i >> 11, k = i & 2047; const float x = v == 0 ? cc[k] : c[(v - 1) * D + k]; sv[i] = x * __builtin_amdgcn_rcpf(1.0f + __expf(-x)); } }
    __syncthreads();
    float* MOD = (float*)(A->ws + WS_MOD); const float* wada = A->in[I_WADA]; const float* bada = A->in[I_BADA];
    for (int item = F.bx; item < DEPTH * 192; item += F.G) {
        const int l = item / 192, j0 = (item % 192) * 64;
        const float* W = wada + (size_t)l * D * 12288 + j0 + (F.lane & 15) * 4;
        const int kbase = F.wave * 256 + (F.lane >> 4);
        f32x4 a0 = {0.f, 0.f, 0.f, 0.f}, a1 = a0, a2 = a0;
#pragma unroll 8
        for (int i = 0; i < 64; ++i) { const int k = kbase + 4 * i; const f32x4 w = *(const f32x4*)(W + (size_t)k * 12288);
            a0 += w * sv[k]; a1 += w * sv[D + k]; a2 += w * sv[2 * D + k]; }
#pragma unroll
        for (int e = 0; e < 4; ++e) { a0[e] += shx(a0[e], 16, F.lane); a0[e] += shx(a0[e], 32, F.lane); a1[e] += shx(a1[e], 16, F.lane); a1[e] += shx(a1[e], 32, F.lane); a2[e] += shx(a2[e], 16, F.lane); a2[e] += shx(a2[e], 32, F.lane); }
        if (F.lane < 16) { *(LAS f32x4*)(red + (F.wave * 3 + 0) * 64 + F.lane * 4) = a0; *(LAS f32x4*)(red + (F.wave * 3 + 1) * 64 + F.lane * 4) = a1; *(LAS f32x4*)(red + (F.wave * 3 + 2) * 64 + F.lane * 4) = a2; }
        __syncthreads();
        if (F.tid < 192) { const int v = F.tid >> 6, jj = F.tid & 63; float s = bada[l * 12288 + j0 + jj];
#pragma unroll
            for (int w = 0; w < 8; ++w) s += red[(w * 3 + v) * 64 + jj];
            MOD[(size_t)(l * 3 + v) * 12288 + j0 + jj] = s; }
        __syncthreads();
    }
}

__device__ __forceinline__ int mod_index(int m) { return m < M_CTX ? 0 : 1 + ((m - M_CTX) >> 10); }
__device__ __forceinline__ void load_row_f32(f32x4 (&v)[8], const float* row, int lane) {
#pragma unroll
    for (int j = 0; j < 4; ++j) { const f32x4* p = (const f32x4*)(row + 8 * (lane + 64 * j)); v[2 * j] = p[0]; v[2 * j + 1] = p[1]; }
}
__device__ __forceinline__ void store_row_f32(float* row, const f32x4 (&v)[8], int lane) {
#pragma unroll
    for (int j = 0; j < 4; ++j) { f32x4* p = (f32x4*)(row + 8 * (lane + 64 * j)); p[0] = v[2 * j]; p[1] = v[2 * j + 1]; }
}
__device__ __forceinline__ void norm_mod_store(const f32x4 (&v)[8], float rstd, const float* g, const float* sc, const float* sh, bf16_t* hrow, int lane) {
#pragma unroll
    for (int j = 0; j < 4; ++j) { const int c = 8 * (lane + 64 * j);
        f32x4 h[2];
#pragma unroll
        for (int e = 0; e < 2; ++e) { const f32x4 gg = *(const f32x4*)(g + c + 4 * e), s1 = *(const f32x4*)(sc + c + 4 * e), s0 = *(const f32x4*)(sh + c + 4 * e); h[e] = v[2 * j + e] * rstd * gg * (1.0f + s1) + s0; }
        *(u32x4*)(hrow + c) = pg8::pack8(h[0], h[1]); }
}
__device__ __forceinline__ float sumsq8(const f32x4 (&v)[8], int lane) {
    float s = 0.f;
#pragma unroll
    for (int j = 0; j < 8; ++j) s += (v[j][0] * v[j][0] + v[j][1] * v[j][1]) + (v[j][2] * v[j][2] + v[j][3] * v[j][3]);
    return wave_sum(s, lane);
}
__device__ __forceinline__ void p1_norm0(Frame& F) {
    refresh(F); KArgs A = kargs();
    const int gw = F.bx * 8 + F.wave, NGW = F.G * 8;
    const float* MOD = (const float*)(A->ws + WS_MOD); bf16_t* H = (bf16_t*)(A->ws + WS_H);
    const float* xp = A->in[I_XP]; const float* xs = A->in[I_XS]; const float* gpm = A->in[I_GPREMIX]; float* out = A->out;
    for (int m = gw; m < M; m += NGW) {
        const float* src = m < M_CTX ? xp + (size_t)m * D : xs + (size_t)(m - M_CTX) * D;
        f32x4 v[8]; load_row_f32(v, src, F.lane);
        const float rstd = __builtin_amdgcn_rsqf(sumsq8(v, F.lane) * (1.0f / D) + RMS_EPS);
        store_row_f32(out + (size_t)m * D, v, F.lane);
        const float* mv = MOD + (size_t)mod_index(m) * 12288;
        norm_mod_store(v, rstd, gpm, mv + 1 * D, mv + 0 * D, H + (size_t)m * D, F.lane);
    }
}
__device__ __forceinline__ void load_y(f32x4 (&y)[8], int m, const bf16_t* MIXB, const float* SLAB, int lane) {
    if (m < M_CTX) {
        const bf16_t* r = MIXB + (size_t)m * D;
#pragma unroll
        for (int j = 0; j < 4; ++j) { const u32x4 w = *(const u32x4*)(r + 8 * (lane + 64 * j));
            y[2 * j] = (f32x4){bflo(w.x), bfhi(w.x), bflo(w.y), bfhi(w.y)}; y[2 * j + 1] = (f32x4){bflo(w.z), bfhi(w.z), bflo(w.w), bfhi(w.w)}; }
    } else {
        const float* r = SLAB + (size_t)(m - M_CTX) * D;
        load_row_f32(y, r, lane);
#pragma unroll
        for (int q = 1; q < 4; ++q) { f32x4 t[8]; load_row_f32(t, r + (size_t)q * M_LAT * D, lane);
#pragma unroll
            for (int j = 0; j < 8; ++j) y[j] = y[j] + t[j]; }
    }
}
__device__ __forceinline__ void thin_phase(Frame& F, int i_gpost, int l, int gate_off, int i_gnext, int ln, int sc_off, int sh_off) {
    refresh(F); KArgs A = kargs();
    const int gw = F.bx * 8 + F.wave, NGW = F.G * 8;
    bf16_t* H = (bf16_t*)(A->ws + WS_H); const bf16_t* MIXB = (const bf16_t*)(A->ws + WS_MIXB); const float* SLAB = (const float*)(A->ws + WS_SLAB); float* out = A->out;
    const float* g_post = A->in[i_gpost] + l * D; const float* modc = (const float*)(A->ws + WS_MOD) + (size_t)l * 3 * 12288;
    const float* g_next = i_gnext >= 0 ? A->in[i_gnext] + ln * D : nullptr; const float* modn = (const float*)(A->ws + WS_MOD) + (size_t)ln * 3 * 12288;
    f32x4 xa[8], ya[8], xb[8], yb[8];
    int m = gw;
    if (m < M) { load_row_f32(xa, out + (size_t)m * D, F.lane); load_y(ya, m, MIXB, SLAB, F.lane); }
#define THIN_ROW(X, Y, mm) do { const int mi = mod_index(mm); float* xr = out + (size_t)(mm) * D; \
        const float r1 = __builtin_amdgcn_rsqf(sumsq8(Y, F.lane) * (1.0f / D) + RMS_EPS); \
        const float* gt = modc + (size_t)mi * 12288 + gate_off; \
        _Pragma("unroll") for (int j = 0; j < 4; ++j) _Pragma("unroll") for (int e = 0; e < 2; ++e) { const int c = 8 * (F.lane + 64 * j) + 4 * e; \
            X[2 * j + e] = X[2 * j + e] + *(const f32x4*)(gt + c) * (Y[2 * j + e] * r1 * *(const f32x4*)(g_post + c)); } \
        store_row_f32(xr, X, F.lane); \
        if (g_next) { const float r2 = __builtin_amdgcn_rsqf(sumsq8(X, F.lane) * (1.0f / D) + RMS_EPS); const float* mv = modn + (size_t)mi * 12288; \
            norm_mod_store(X, r2, g_next, mv + sc_off, mv + sh_off, H + (size_t)(mm) * D, F.lane); } } while (0)
    while (m < M) {
        const int m1 = m + NGW;
        if (m1 < M) { load_row_f32(xb, out + (size_t)m1 * D, F.lane); load_y(yb, m1, MIXB, SLAB, F.lane); }
        THIN_ROW(xa, ya, m);
        if (m1 >= M) break;
        const int m2 = m1 + NGW;
        if (m2 < M) { load_row_f32(xa, out + (size_t)m2 * D, F.lane); load_y(ya, m2, MIXB, SLAB, F.lane); }
        THIN_ROW(xb, yb, m1);
        m = m2;
    }
#undef THIN_ROW
}
__device__ __forceinline__ void merge_latent(Frame& F) {
    refresh(F); KArgs A = kargs();
    const float* SLAB = (const float*)(A->ws + WS_SLAB); bf16_t* MRG = (bf16_t*)(A->ws + WS_MRG) + (size_t)M_CTX * D;
    for (int i = F.bx * 512 + F.tid; i < M_LAT * D / 8; i += F.G * 512) {
        f32x4 a = ((const f32x4*)SLAB)[2 * i], b = ((const f32x4*)SLAB)[2 * i + 1];
#pragma unroll
        for (int q = 1; q < 4; ++q) { const f32x4* p = (const f32x4*)(SLAB + (size_t)q * M_LAT * D); a = a + p[2 * i]; b = b + p[2 * i + 1]; }
        ((u32x4*)MRG)[i] = pg8::pack8(a, b);
    }
}

__device__ __forceinline__ void sg_unit(Frame& F, KArgs A, int l, int unit) {
    const int c = unit >> 2, g = unit & 3, row0 = c * 128;
    const bf16_t* P2 = (const bf16_t*)(A->ws + WS_P2); bf16_t* OBR = (bf16_t*)(A->ws + WS_OBR);
    LAS bf16_t* vT = (LAS bf16_t*)F.lds;
    {
        const int pos = F.tid >> 2, d0 = (F.tid & 3) * 32;
        const bf16_t* vp = P2 + (size_t)(row0 + pos) * P2W + P2_V + g * 128 + d0;
        u32x4 w[4];
#pragma unroll
        for (int i = 0; i < 4; ++i) w[i] = ((const u32x4*)vp)[i];
        float v[32];
#pragma unroll
        for (int i = 0; i < 4; ++i)
#pragma unroll
            for (int e = 0; e < 4; ++e) { v[i * 8 + e * 2] = bflo(w[i][e]); v[i * 8 + e * 2 + 1] = bfhi(w[i][e]); }
        float ss = 0.f;
#pragma unroll
        for (int i = 0; i < 32; ++i) ss += v[i] * v[i];
        ss += shx(ss, 1, F.lane); ss += shx(ss, 2, F.lane);
        const float rstd = __builtin_amdgcn_rsqf(ss * (1.0f / 128.0f) + RMS_EPS);
        const float* gs = A->in[I_GSGU] + (l * 4 + g) * 128 + d0;
#pragma unroll
        for (int i = 0; i < 32; ++i) vT[(d0 + i) * 136 + pos] = f2bf(v[i] * rstd * gs[i]);
    }
    __syncthreads();
    {
        const int fr = F.lane & 15, quad = F.lane >> 4, pcol = F.wave * 16 + fr;
        const bf16_t* wp = (const bf16_t*)(A->ws + WS_WSP) + ((size_t)(l * 4 + g) * 128 + pcol) * 128 + quad * 8;
        bf16x8 bfr[4];
#pragma unroll
        for (int kk = 0; kk < 4; ++kk) bfr[kk] = *(const bf16x8*)(wp + kk * 32);
        f32x4 acc[8];
#pragma unroll
        for (int dt = 0; dt < 8; ++dt) { acc[dt] = (f32x4){0.f, 0.f, 0.f, 0.f};
#pragma unroll
            for (int kk = 0; kk < 4; ++kk) { const bf16x8 afr = *(const LAS bf16x8*)(vT + (dt * 16 + fr) * 136 + kk * 32 + quad * 8);
                acc[dt] = __builtin_amdgcn_mfma_f32_16x16x32_bf16(afr, bfr[kk], acc[dt], 0, 0, 0); } }
        const float bias = A->in[I_BSP][(l * 4 + g) * 128 + pcol];
        const bf16_t* up = P2 + (size_t)(row0 + pcol) * P2W + P2_U + g * 128 + quad * 4;
        bf16_t* op = OBR + (size_t)(row0 + pcol) * D + OB_C + g * 128 + quad * 4;
#pragma unroll
        for (int dt = 0; dt < 8; ++dt) { const u32x2 uw = *(const u32x2*)(up + dt * 16);
            u32x2 o; o.x = cvt_pk_bf16(bflo(uw.x) * (acc[dt][0] + bias), bfhi(uw.x) * (acc[dt][1] + bias)); o.y = cvt_pk_bf16(bflo(uw.y) * (acc[dt][2] + bias), bfhi(uw.y) * (acc[dt][3] + bias));
            *(u32x2*)(op + dt * 16) = o; }
    }
    __syncthreads();
}

__global__ void __launch_bounds__(512, 2) fwd(Args args) {
    extern __shared__ __attribute__((aligned(16))) unsigned char lds[];
    Frame F;
    F.lds = (LAS unsigned char*)lds; F.ldsg = (char*)lds;
    refresh(F);
    volatile LAS unsigned* MISC = (volatile LAS unsigned*)(F.lds + MISC_OFF);
    for (int u = F.tid; u < (LDS_BYTES - RING_BYTES) / 4; u += 512) ((LAS unsigned*)(F.lds + RING_BYTES))[u] = 0u;
    __syncthreads();
    const int lo = args.ph_lo, hi = args.ph_hi;
    XcdBarrier bar; bar.bar = (unsigned*)(args.ws + WS_CTL) + CW_BAR; bar.x = 0; bar.st = nullptr;
    if (hi - lo > 1) bar = xcd_barrier_post((unsigned*)(args.ws + WS_CTL) + CW_BAR, MISC + 8);
#define IN(p) (lo <= (p) && (p) < hi)
#define SEAM(p) do { if ((p) + 1 < hi) { XcdBarrier b_ = bar; asm volatile("" : "+s"(b_.bar)); xcd_barrier(b_); } } while (0)

    if (IN(0)) { p0_weights(F); p0_tables(F); p0_mod(F); SEAM(0); }
    if (IN(1)) { p1_norm0(F); SEAM(1); }

    for (int l = 0; l < DEPTH; ++l) {
        const int pb = NPRE + l * NLP;
        if (pb + NLP <= lo || pb >= hi) continue;
        if (IN(pb + 0)) {
            refresh(F); KArgs A = kargs(); unsigned char* ws = A->ws;
            pg8::Dims g{D, D, D}; pg8::TileOrder S; S.init(ws + WS_H, D, ws + WS_WIN + l * SZ_WIN, D, M, IN_W, D, F.G, F.bx);
            pg8::EpiProj E{(bf16_t*)(ws + WS_QKV), (bf16_t*)(ws + WS_P2), A->out + OUT_CK + (size_t)l * 256 * 1024, A->out + OUT_CV + (size_t)l * 256 * 1024};
            pg8::gemm_phase<pg8::EpiProj, pg8::TileOrder, true>(F.lds, g, S, E);
            SEAM(pb + 0);
        }
        if (IN(pb + 1)) {
            refresh(F); KArgs A = kargs(); unsigned char* ws = A->ws;
            pg8::Dims g{512, P2W, 512}; pg8::TileOrder S; S.init(ws + WS_WF, 512, (bf16_t*)(ws + WS_P2) + P2_F, P2W, 1024, M, 512, F.G, F.bx);
            pg8::EpiTT E{(bf16_t*)(ws + WS_TT), (bf16_t*)(ws + WS_TTL)};
            pg8::gemm_phase<pg8::EpiTT, pg8::TileOrder, true>(F.lds, g, S, E);
            SEAM(pb + 1);
        }
        if (IN(pb + 2)) {
            {
                refresh(F); KArgs A = kargs(); unsigned char* ws = A->ws;
                pg8::Dims g{2048, 2048, 2048};
                pg8::BatchOrder S{(const char*)(ws + WS_TW1024), (const char*)(ws + WS_TTL), (size_t)256 * 2048 * 2, (size_t)256 * 2048 * 2, (size_t)512 * 2048 * 2, 4, 2, 2, F.G, F.bx < 16 ? F.bx : -1, 32, 32};
                pg8::EpiFour2 E{(bf16_t*)(ws + WS_OBR), 0.00276213586400995f};
                pg8::gemm_phase<pg8::EpiFour2, pg8::BatchOrder, true>(F.lds, g, S, E);
            }
            {
                refresh(F); KArgs A = kargs(); unsigned char* ws = A->ws;
                pg8::Dims g{512, 512, 512};
                pg8::BatchOrder S{(const char*)(ws + WS_TW256), (const char*)(ws + WS_TT), (size_t)256 * 512 * 2, (size_t)256 * 512 * 2, (size_t)512 * 512 * 2, 1, 2, 32, F.G, F.bx >= 192 ? F.bx - 192 : -1, 0, 8};
                pg8::EpiFour2 E{(bf16_t*)(ws + WS_OBR), 0.005524271728019903f};
                pg8::gemm_phase<pg8::EpiFour2, pg8::BatchOrder, true>(F.lds, g, S, E);
            }
            {
                refresh(F); KArgs A = kargs(); unsigned char* ws = A->ws;
                const bf16_t* QKV = (const bf16_t*)(ws + WS_QKV); bf16_t* OBR = (bf16_t*)(ws + WS_OBR);
                const int u0 = F.bx < 160 ? 2 * (F.bx - 80) : F.bx, nu = F.bx < 80 ? 0 : (F.bx < 160 ? 2 : 1);
                for (int k = 0; k < nu; ++k) {
                    const int u = u0 + k, b = u >> 3, h = u & 7;
                    const bf16_t* Qb = QKV + (size_t)(b * 256) * 1024 + h * 128;
                    __syncthreads();
                    att::body<false>(Qb, Qb + (size_t)M * 1024, Qb + (size_t)2 * M * 1024, 4, nullptr, nullptr, 4, OBR + (size_t)(b * 256) * D + OB_A + h * 128, F.ldsg, 0, 0);
                }
            }
            {
                refresh(F); KArgs A = kargs(); unsigned char* ws = A->ws;
                const bf16_t* QKV = (const bf16_t*)(ws + WS_QKV); bf16_t* OBR = (bf16_t*)(ws + WS_OBR);
                if (F.bx >= 16 && F.bx < 80) {
                    const int u = F.bx - 16, j = u & 3, h = (u >> 2) & 7, b = u >> 5;
                    const int kr0 = j == 0 ? 0 : (j == 1 ? 0 : (j == 2 ? 4 : 8)), nt0 = (j == 0 || j == 3) ? 8 : 12;
                    __syncthreads();
                    { const int t = fresh_tid(); if (t < 465) ((float*)(F.ldsg + att::OFF_RPB))[t] = A->in[I_RPB][(l * 8 + h) * 465 + t] * (1.0f / att::SCALE); }
                    __syncthreads();
                    const size_t r0 = (size_t)M_CTX + b * 1024;
                    const bf16_t* Qb = QKV + (r0 + 256 * j) * 1024 + h * 128;
                    const bf16_t* K0 = QKV + (size_t)M * 1024 + (r0 + kr0 * 64) * 1024 + h * 128;
                    const bf16_t* K1 = (const bf16_t*)(ws + WS_CK) + ((size_t)(b * 4 + l) * 512) * 1024 + h * 128;
                    const bf16_t* V1 = (const bf16_t*)(ws + WS_CV) + ((size_t)(b * 4 + l) * 512) * 1024 + h * 128;
                    att::body<true>(Qb, K0, K0 + (size_t)M * 1024, nt0, K1, V1, nt0 + 8, OBR + (r0 + 256 * j) * D + OB_A + h * 128, F.ldsg, kr0, 4 * j);
                }
                __syncthreads();
            }
            {
                refresh(F); KArgs A = kargs();
                const int u0 = F.bx < 160 ? 2 * (F.bx - 80) : 160 + 5 * (F.bx - 160), nu = F.bx < 80 ? 0 : (F.bx < 160 ? 2 : (F.bx < 192 ? 5 : 0));
                for (int k = 0; k < nu; ++k) sg_unit(F, A, l, u0 + k);
            }
            SEAM(pb + 2);
        }
        if (IN(pb + 3)) {
            refresh(F); KArgs A = kargs(); unsigned char* ws = A->ws;
            pg8::Dims g{D, D, D};
            typedef pg8::BalOrder<3, 16, 24, 32> BO3; BO3 S{(const char*)(ws + WS_OBR), (const char*)(ws + WS_WBR + l * SZ_WSQ), (size_t)256 * D * 2, (size_t)256 * D * 2, F.bx, 8};
            pg8::EpiBranch E{(const bf16_t*)(ws + WS_P2), (bf16_t*)(ws + WS_MRG), (float*)(ws + WS_SLAB)};
            pg8::gemm_phase<pg8::EpiBranch, BO3, true>(F.lds, g, S, E);
            SEAM(pb + 3);
        }
        if (IN(pb + 4)) { merge_latent(F); SEAM(pb + 4); }
        if (IN(pb + 5)) {
            refresh(F); KArgs A = kargs(); unsigned char* ws = A->ws;
            pg8::Dims g{D, D, D};
            typedef pg8::BalOrder<1, 32, 0, 0> BO1; BO1 S{(const char*)(ws + WS_MRG), (const char*)(ws + WS_WOUT + l * SZ_WSQ), (size_t)256 * D * 2, (size_t)256 * D * 2, F.bx, 8};
            pg8::EpiOut E{(bf16_t*)(ws + WS_MIXB), (float*)(ws + WS_SLAB)};
            pg8::gemm_phase<pg8::EpiOut, BO1, true>(F.lds, g, S, E);
            SEAM(pb + 5);
        }
        if (IN(pb + 6)) {
            thin_phase(F, I_GPOSTMIX, l, 2 * D, I_GPREMLP, l, 4 * D, 3 * D);
            SEAM(pb + 6);
        }
        if (IN(pb + 7)) {
            refresh(F); KArgs A = kargs(); unsigned char* ws = A->ws;
            pg8::Dims g{D, D, D}; pg8::TileOrder S; S.init(ws + WS_H, D, ws + WS_W1 + l * SZ_W1, D, M, D_FF, D, F.G, F.bx);
            pg8::EpiRelu2 E{(bf16_t*)(ws + WS_FF1), D_FF}; pg8::gemm_phase<pg8::EpiRelu2, pg8::TileOrder, true>(F.lds, g, S, E);
            SEAM(pb + 7);
        }
        if (IN(pb + 8)) {
            refresh(F); KArgs A = kargs(); unsigned char* ws = A->ws;
            pg8::Dims g{D_FF, D_FF, D_FF};
            typedef pg8::BalOrder<1, 128, 0, 0> BO1; BO1 S{(const char*)(ws + WS_FF1), (const char*)(ws + WS_W2 + l * SZ_W1), (size_t)256 * D_FF * 2, (size_t)256 * D_FF * 2, F.bx, 32};
            pg8::EpiOut E{(bf16_t*)(ws + WS_MIXB), (float*)(ws + WS_SLAB)};
            pg8::gemm_phase<pg8::EpiOut, BO1, true>(F.lds, g, S, E);
            SEAM(pb + 8);
        }
        if (IN(pb + 9)) {
            const bool nx = l + 1 < DEPTH;
            thin_phase(F, I_GPOSTMLP, l, 5 * D, nx ? I_GPREMIX : -1, nx ? l + 1 : l, 1 * D, 0);
            SEAM(pb + 9);
        }
    }
#undef IN
#undef SEAM
}

extern "C" void kernel_launch(void* const* d_in, const int* in_sizes, int n_in, void* d_out, int out_size, void* d_ws, size_t ws_size, hipStream_t stream) {
    static int grid = 0;
    if (grid == 0) {
        if (n_in != 23 || out_size != (int)(OUT_CV + (size_t)32 * 4 * 256 * 1024) || ws_size < WS_END) {
            fprintf(stderr, "kernel_launch: shape mismatch: n_in %d out %d ws %zu (need %zu); nothing launched\n", n_in, out_size, ws_size, (size_t)WS_END); grid = -1; return; }
        int dev = 0, cus = 0, per_cu = 0;
        if (hipGetDevice(&dev) != hipSuccess || hipDeviceGetAttribute(&cus, hipDeviceAttributeMultiprocessorCount, dev) != hipSuccess) { fprintf(stderr, "kernel_launch: device query failed\n"); grid = -1; return; }
        if (hipFuncSetAttribute((const void*)fwd, hipFuncAttributeMaxDynamicSharedMemorySize, LDS_BYTES) != hipSuccess) { fprintf(stderr, "kernel_launch: hipFuncSetAttribute failed\n"); grid = -1; return; }
        if (hipOccupancyMaxActiveBlocksPerMultiprocessor(&per_cu, (const void*)fwd, 512, LDS_BYTES) != hipSuccess || per_cu < 1)
            fprintf(stderr, "kernel_launch: note: occupancy query reports %d workgroups per CU\n", per_cu);
        (void)hipGetLastError();
        if (cus != 256) { fprintf(stderr, "kernel_launch: built for a 256-CU device (got %d); nothing launched\n", cus); grid = -1; return; }
        grid = cus;
    }
    if (grid < 0) return;
    if (hipMemsetAsync((char*)d_ws + WS_CTL, 0, CTL_BYTES, stream) != hipSuccess) { fprintf(stderr, "kernel_launch: memset failed\n"); return; }
    Args a{};
    for (int i = 0; i < 23; ++i) a.in[i] = (const float*)d_in[i];
    a.out = (float*)d_out; a.ws = (unsigned char*)d_ws;
#if MK_PER_PHASE
    for (int p = 0; p < NPH; ++p) { a.ph_lo = p; a.ph_hi = p + 1; hipLaunchKernelGGL(fwd, dim3(grid), dim3(512), LDS_BYTES, stream, a); }
#else
    a.ph_lo = 0; a.ph_hi = NPH; hipLaunchKernelGGL(fwd, dim3(grid), dim3(512), LDS_BYTES, stream, a);
#endif
    const hipError_t le = hipPeekAtLastError();
    if (le != hipSuccess) fprintf(stderr, "kernel_launch: launch failed: %s\n", hipGetErrorName(le));
}
```

```cpp
#include <hip/hip_runtime.h>
#include <cstdio>
#include <cstdint>

#ifndef MK_PER_PHASE
#define MK_PER_PHASE 0
#endif

#define LAS __attribute__((address_space(3)))
#define GAS __attribute__((address_space(1)))
typedef unsigned short bf16_t;
typedef short bf16x8 __attribute__((ext_vector_type(8)));
typedef short s16x4 __attribute__((ext_vector_type(4)));
typedef float f32x2 __attribute__((ext_vector_type(2)));
typedef float f32x4 __attribute__((ext_vector_type(4)));
typedef float f32x16 __attribute__((ext_vector_type(16)));
typedef unsigned u32x2 __attribute__((ext_vector_type(2)));
typedef unsigned u32x4 __attribute__((ext_vector_type(4)));

constexpr int D = 2048, M_CTX = 8192, M_LAT = 2048, M = M_CTX + M_LAT, DEPTH = 4;
constexpr int IN_W = 10752, D_FF = 8192, LDF = D_FF + 0, P2W = 7680;
constexpr int P2_F = 0, P2_U = 512, P2_V = 1024, P2_GA = 1536, P2_GF = 3584, P2_GC = 5632;
constexpr int OB_A = 0, OB_F = 1024, OB_C = 1536;
constexpr float RMS_EPS = 1e-6f;
constexpr size_t OUT_YS = (size_t)M_CTX * D, OUT_CK = (size_t)M * D, OUT_CV = OUT_CK + (size_t)32 * 4 * 256 * 1024;

constexpr size_t MiB = 1u << 20;
constexpr size_t WS_CTL = 0, CTL_BYTES = MiB;
constexpr size_t SZ_WIN = (size_t)IN_W * D * 2, SZ_WSQ = (size_t)D * D * 2, SZ_W1 = (size_t)D_FF * D * 2, SZ_W2 = (size_t)D * LDF * 2;
constexpr size_t WS_WIN = CTL_BYTES;
constexpr size_t WS_WBR = WS_WIN + 4 * SZ_WIN;
constexpr size_t WS_WOUT = WS_WBR + 4 * SZ_WSQ;
constexpr size_t WS_W1 = WS_WOUT + 4 * SZ_WSQ;
constexpr size_t WS_W2 = WS_W1 + 4 * SZ_W1;
constexpr size_t WS_TW256 = WS_W2 + 4 * SZ_W2;
constexpr size_t WS_TW1024 = WS_TW256 + 256 * 512 * 2;
constexpr size_t WS_WF = WS_TW1024 + 1024 * 2048 * 2;
constexpr size_t WS_WSP = WS_WF + 1024 * 512 * 2;
constexpr size_t WS_CK = WS_WSP + 4 * 4 * 128 * 128 * 2;
constexpr size_t WS_CV = WS_CK + (size_t)2 * 4 * 512 * 1024 * 2;
constexpr size_t WS_MOD = WS_CV + (size_t)2 * 4 * 512 * 1024 * 2;
constexpr size_t WS_H = ((WS_MOD + 4 * 3 * 12288 * 4) + 4095) & ~(size_t)4095;
constexpr size_t WS_QKV = WS_H + (size_t)M * D * 2;
constexpr size_t WS_P2 = WS_QKV + (size_t)3 * M * 1024 * 2;
constexpr size_t WS_FF1 = WS_QKV;
constexpr size_t WS_TT = WS_P2 + (size_t)M * P2W * 2;
constexpr size_t WS_TTL = WS_TT + (size_t)32 * 4 * 128 * 512 * 2;
constexpr size_t WS_OBR = WS_TT + (size_t)M * 1024 * 2;
constexpr size_t WS_MRG = WS_OBR + (size_t)M * D * 2;
constexpr size_t WS_SLAB = WS_MRG + (size_t)M * D * 2;
constexpr size_t WS_MIXB = WS_SLAB + (size_t)4 * M_LAT * D * 4;
constexpr size_t WS_END = WS_MIXB + (size_t)M_CTX * D * 2;
static_assert((size_t)M * LDF * 2 <= (size_t)3 * M * 1024 * 2 + (size_t)M * P2W * 2, "FF1 overlay fits");
constexpr int CW_BAR = 4096;

constexpr int RING_BYTES = 131072, MISC_OFF = RING_BYTES + 320, LDS_BYTES = 147456;

#define LDS_WAIT() asm volatile("s_waitcnt lgkmcnt(0)" ::: "memory")
#define VM_WAIT() asm volatile("s_waitcnt vmcnt(0)" ::: "memory")

__device__ __forceinline__ unsigned cvt_pk_bf16(float lo, float hi) { unsigned r; asm volatile("v_cvt_pk_bf16_f32 %0, %1, %2" : "=v"(r) : "v"(lo), "v"(hi)); return r; }
__device__ __forceinline__ float bf2f(unsigned short h) { return __uint_as_float((unsigned)h << 16); }
__device__ __forceinline__ float bflo(unsigned w) { return __uint_as_float(w << 16); }
__device__ __forceinline__ float bfhi(unsigned w) { return __uint_as_float(w & 0xffff0000u); }
__device__ __forceinline__ float shx(float v, int o, int lane) { return __int_as_float(__builtin_amdgcn_ds_bpermute((lane ^ o) << 2, __float_as_int(v))); }
__device__ __forceinline__ float wave_sum(float v, int lane) {
#pragma unroll
    for (int o = 1; o < 64; o <<= 1) v += shx(v, o, lane);
    return v;
}

namespace pg8 {
constexpr int BM = 256, BK = 64, HALF = 128, HTB = HALF * BK * 2, STAGE_BYTES = 8 * HTB, NXCD = 8, WGM = 8;
__host__ __device__ __forceinline__ int lds_byte(int r, int c) { const int st = (r >> 4) * 2 + (c >> 5), rr = r & 15, cc = c & 31, ob = rr * 64 + cc * 2; return st * 1024 + (ob ^ (((ob >> 9) & 1) << 5)); }
__host__ __device__ __forceinline__ void stage_rc(int b, int& R, int& C) { const int st = b / 1024, sb = b % 1024, swz = sb ^ (((sb >> 9) & 1) << 5); R = (st >> 1) * 16 + swz / 64; C = (st & 1) * 32 + (swz % 64) / 2; }
__host__ __device__ __forceinline__ int perm32(int rho) { const int n = rho >> 4, i = rho & 15; return 8 * (i >> 2) + 4 * n + (i & 3); }

struct Unit { int pm, pn; const char* a; const char* b; int nt, aux; };
struct Dims { int lda, ldb, K; };

struct TileOrder {
    const char* A; const char* Bt; size_t tA, tB; int nM, nN, nwg, G, c, nt;
    __device__ __forceinline__ void init(const void* A_, size_t lda, const void* Bt_, size_t ldb, int M_, int N_, int K_, int G_, int c_) {
        A = (const char*)A_; Bt = (const char*)Bt_; tA = (size_t)BM * lda * 2; tB = (size_t)BM * ldb * 2; nM = M_ / BM; nN = N_ / BM; nwg = nM * nN; G = G_; c = c_; nt = K_ / BK; }
    __device__ __forceinline__ bool next(int i, Unit& u) const {
        const long L = (long)i * G + c; if (c < 0 || L >= nwg) return false;
        int wgid = (int)L; { const int q = nwg / NXCD, r = nwg % NXCD, xcd = wgid % NXCD, off = wgid / NXCD; wgid = (xcd < r ? xcd * (q + 1) : r * (q + 1) + (xcd - r) * q) + off; }
        const int nig = WGM * nN, gid = wgid / nig, fm = gid * WGM, gsz = (nM - fm) < WGM ? (nM - fm) : WGM;
        u.pm = fm + ((wgid % nig) % gsz); u.pn = (wgid % nig) / gsz; u.a = A + (size_t)u.pm * tA; u.b = Bt + (size_t)u.pn * tB; u.nt = nt; u.aux = 0; return true;
    }
};
struct BatchOrder {
    const char* A; const char* Bt; size_t tA, tB, bB; int nM, nN, nB, G, c, rt0, nt;
    __device__ __forceinline__ bool next(int i, Unit& u) const {
        const long L = (long)i * G + c; if (c < 0 || L >= (long)nB * nM * nN) return false;
        const int b = (int)L / (nM * nN), r = (int)L % (nM * nN), pm = r / nN, pn = r % nN;
        u.a = A + (size_t)pm * tA; u.b = Bt + (size_t)b * bB + (size_t)pn * tB; u.pm = rt0 + b * nM + pm; u.pn = pn; u.nt = nt; u.aux = 0; return true;
    }
};
template <int NSEG, int K1, int K2, int K3> struct BalOrder {
    const char* A; const char* Bt; size_t tA, tB; int c, ntq, rot;
    __device__ __forceinline__ bool next(int i, Unit& u) const {
        const int x = c & 7, s = c >> 3;
        if (i > NSEG) return false;
        int j = i + rot; if (j > NSEG) j -= NSEG + 1;
        if (j < NSEG) { const int k0 = j == 0 ? 0 : (j == 1 ? K1 : K2), k1 = j == 0 ? K1 : (j == 1 ? K2 : K3);
            const bool first = (rot == NSEG) ? (i == 1) : (i == 0);
            u.pm = 4 * x + (s >> 3); u.pn = s & 7; u.a = A + (size_t)u.pm * tA + (size_t)k0 * (BK * 2); u.b = Bt + (size_t)u.pn * tB + (size_t)k0 * (BK * 2); u.nt = k1 - k0; u.aux = j | (first ? 8 : 0); return true; }
        const int q = s & 3; u.pm = 32 + x; u.pn = s >> 2; u.a = A + (size_t)u.pm * tA + (size_t)q * ntq * (BK * 2); u.b = Bt + (size_t)u.pn * tB + (size_t)q * ntq * (BK * 2); u.nt = ntq; u.aux = 16 + q; return true;
    }
};

__device__ __forceinline__ f32x2 gelu_pk(f32x2 v) {
    const f32x2 av = __builtin_elementwise_abs(v), d = av * 0.2316418882f + 1.0f;
    f32x2 t; t.x = __builtin_amdgcn_rcpf(d.x); t.y = __builtin_amdgcn_rcpf(d.y);
    f32x2 q = t * 0.5307027145f + (-0.7265760135f); q = q * t + 0.7107068705f; q = q * t + (-0.142248368f); q = q * t + 0.127414796f; q = q * t;
    const f32x2 s = (v * v) * (-0.72134752044f);
    f32x2 e; e.x = __builtin_amdgcn_exp2f(s.x); e.y = __builtin_amdgcn_exp2f(s.y);
    const f32x2 m = v * (q * e), r = v - m;
    f32x2 o; o.x = v.x < 0.f ? m.x : r.x; o.y = v.y < 0.f ? m.y : r.y; return o;
}
__device__ __forceinline__ float sigmoidf_(float x) { return __builtin_amdgcn_rcpf(1.0f + __builtin_amdgcn_exp2f(-1.4426950408889634f * x)); }

typedef f32x4 Acc[2][2][4][2];
__device__ __forceinline__ u32x4 pack8(f32x4 v0, f32x4 v1) { u32x4 w; w.x = cvt_pk_bf16(v0[0], v0[1]); w.y = cvt_pk_bf16(v0[2], v0[3]); w.z = cvt_pk_bf16(v1[0], v1[1]); w.w = cvt_pk_bf16(v1[2], v1[3]); return w; }

struct EpiProj {
    static constexpr bool PERM = true;
    bf16_t* QKV; bf16_t* P2; float* ck; float* cv;
    __device__ __forceinline__ void operator()(const Acc& acc, const Unit& u, int wr, int wc, int fr, int fq) const {
        const int row0 = u.pm * BM + wr * 64 + fr, colw = wc * 32 + 8 * fq, pn = u.pn;
        if (pn < 12) {
            const int t = pn >> 2, cb = (pn & 3) * 256 + colw;
            bf16_t* base = QKV + (size_t)t * M * 1024 + cb;
            float* cbase = (t == 1 ? ck : cv) + cb;
            const bool wc_ = (t >= 1) && (u.pm < 32);
#pragma unroll
            for (int ai = 0; ai < 2; ++ai)
#pragma unroll
                for (int m = 0; m < 4; ++m) { const int row = row0 + ai * HALF + m * 16;
#pragma unroll
                    for (int bj = 0; bj < 2; ++bj) { const f32x4 v0 = acc[ai][bj][m][0], v1 = acc[ai][bj][m][1];
                        *(u32x4*)(base + (size_t)row * 1024 + bj * HALF) = pack8(v0, v1);
                        if (wc_) { float* cp = cbase + ((size_t)(row >> 8) * 1024 + (row & 255)) * 1024 + bj * HALF; *(f32x4*)cp = v0; *(f32x4*)(cp + 4) = v1; } } }
        } else {
            const int act = (pn >= 14 && pn < 18) ? 1 : 0;
            bf16_t* base = P2 + (pn - 12) * 256 + colw;
#pragma unroll
            for (int ai = 0; ai < 2; ++ai)
#pragma unroll
                for (int m = 0; m < 4; ++m) { const int row = row0 + ai * HALF + m * 16;
#pragma unroll
                    for (int bj = 0; bj < 2; ++bj) { f32x4 v0 = acc[ai][bj][m][0], v1 = acc[ai][bj][m][1];
                        if (act == 1) { f32x2 a = gelu_pk((f32x2){v0[0], v0[1]}), b = gelu_pk((f32x2){v0[2], v0[3]}), c = gelu_pk((f32x2){v1[0], v1[1]}), d = gelu_pk((f32x2){v1[2], v1[3]});
                            v0 = (f32x4){a.x, a.y, b.x, b.y}; v1 = (f32x4){c.x, c.y, d.x, d.y}; }
                        *(u32x4*)(base + (size_t)row * P2W + bj * HALF) = pack8(v0, v1); } }
        }
    }
};
struct EpiTT {
    static constexpr bool PERM = true;
    bf16_t* TTC; bf16_t* TTL;
    __device__ __forceinline__ void operator()(const Acc& acc, const Unit& u, int wr, int wc, int fr, int fq) const {
        const int g = u.pm, tok0 = u.pn * BM + wc * 32 + 8 * fq;
#pragma unroll
        for (int bj = 0; bj < 2; ++bj) { const int tok = tok0 + bj * HALF;
            bf16_t* colp; int rs, js;
            if (tok < M_CTX) { const int b = tok >> 8, n1 = tok & 255; colp = TTC + ((size_t)(b * 4 + g) * 128) * 512 + n1; rs = 512; js = 256; }
            else { const int tl = tok - M_CTX, b = tl >> 10, n1 = tl & 1023; colp = TTL + ((size_t)(b * 4 + g) * 128) * 2048 + n1; rs = 2048; js = 1024; }
#pragma unroll
            for (int ai = 0; ai < 2; ++ai)
#pragma unroll
                for (int m = 0; m < 4; ++m) { const int k2 = wr * 64 + m * 16 + fr;
                    *(u32x4*)(colp + (size_t)k2 * rs + ai * js) = pack8(acc[ai][bj][m][0], acc[ai][bj][m][1]); } }
    }
};
struct EpiFour2 {
    static constexpr bool PERM = true;
    bf16_t* OBR; float scale;
    __device__ __forceinline__ void operator()(const Acc& acc, const Unit& u, int wr, int wc, int fr, int fq) const {
        const int row0 = u.pm * BM + wr * 64 + fr, col0 = OB_F + u.pn * BM + wc * 32 + 8 * fq;
#pragma unroll
        for (int ai = 0; ai < 2; ++ai)
#pragma unroll
            for (int m = 0; m < 4; ++m) { bf16_t* rowp = OBR + (size_t)(row0 + ai * HALF + m * 16) * D + col0;
#pragma unroll
                for (int bj = 0; bj < 2; ++bj) *(u32x4*)(rowp + bj * HALF) = pack8(acc[ai][bj][m][0] * scale, acc[ai][bj][m][1] * scale); }
    }
};
struct EpiBranch {
    static constexpr bool PERM = true;
    const bf16_t* P2; bf16_t* MRG; bf16_t* SLAB;
    __device__ __forceinline__ void operator()(const Acc& acc, const Unit& u, int wr, int wc, int fr, int fq) const {
        const int row0 = u.pm * BM + wr * 64 + fr, col0 = u.pn * BM + wc * 32 + 8 * fq, aux = u.aux;
        const bool piece = aux >= 16, rmw = !piece && !(aux & 8);
        const int q = aux - 16, seg = piece ? (q < 2 ? 0 : q - 1) : (aux & 7);
        const bf16_t* gate = P2 + (seg == 0 ? P2_GA : (seg == 1 ? P2_GF : P2_GC));
        bf16_t* dst = piece ? SLAB + (size_t)q * M_LAT * D - (size_t)M_CTX * D : MRG;
#pragma unroll
        for (int ai = 0; ai < 2; ++ai) {
            u32x4 gw[4][2], tw[4][2];
#pragma unroll
            for (int m = 0; m < 4; ++m)
#pragma unroll
                for (int bj = 0; bj < 2; ++bj) { const size_t row = (size_t)(row0 + ai * HALF + m * 16); const int col = col0 + bj * HALF;
                    gw[m][bj] = *(const u32x4*)(gate + row * P2W + col);
                    tw[m][bj] = (u32x4){0u, 0u, 0u, 0u}; if (rmw) tw[m][bj] = *(const u32x4*)(MRG + row * D + col); }
            __builtin_amdgcn_sched_barrier(0);
#pragma unroll
            for (int m = 0; m < 4; ++m)
#pragma unroll
                for (int bj = 0; bj < 2; ++bj) { const size_t row = (size_t)(row0 + ai * HALF + m * 16); const int col = col0 + bj * HALF;
                    const u32x4 g4 = gw[m][bj], t4 = tw[m][bj];
                    f32x4 v0 = acc[ai][bj][m][0], v1 = acc[ai][bj][m][1];
                    v0 = v0 * (f32x4){sigmoidf_(bflo(g4.x)), sigmoidf_(bfhi(g4.x)), sigmoidf_(bflo(g4.y)), sigmoidf_(bfhi(g4.y))};
                    v1 = v1 * (f32x4){sigmoidf_(bflo(g4.z)), sigmoidf_(bfhi(g4.z)), sigmoidf_(bflo(g4.w)), sigmoidf_(bfhi(g4.w))};
                    v0 = v0 + (f32x4){bflo(t4.x), bfhi(t4.x), bflo(t4.y), bfhi(t4.y)}; v1 = v1 + (f32x4){bflo(t4.z), bfhi(t4.z), bflo(t4.w), bfhi(t4.w)};
                    *(u32x4*)(dst + row * D + col) = pack8(v0, v1); }
            __builtin_amdgcn_sched_barrier(0);
        }
    }
};
struct EpiOut {
    static constexpr bool PERM = true;
    bf16_t* MIXB; bf16_t* SLAB;
    __device__ __forceinline__ void operator()(const Acc& acc, const Unit& u, int wr, int wc, int fr, int fq) const {
        const int row0 = u.pm * BM + wr * 64 + fr, col0 = u.pn * BM + wc * 32 + 8 * fq, aux = u.aux;
        bf16_t* dst = aux >= 16 ? SLAB + (size_t)(aux - 16) * M_LAT * D - (size_t)M_CTX * D : MIXB;
#pragma unroll
        for (int ai = 0; ai < 2; ++ai)
#pragma unroll
            for (int m = 0; m < 4; ++m) { const size_t row = (size_t)(row0 + ai * HALF + m * 16);
#pragma unroll
                for (int bj = 0; bj < 2; ++bj) *(u32x4*)(dst + row * D + col0 + bj * HALF) = pack8(acc[ai][bj][m][0], acc[ai][bj][m][1]); }
    }
};
struct EpiF32 {
    static constexpr bool PERM = false;
    float* O; int ldc;
    __device__ __forceinline__ void operator()(const Acc& acc, const Unit& u, int wr, int wc, int fr, int fq) const {
        const int row0 = u.pm * BM + wr * 64 + fr, col0 = u.pn * BM + wc * 32 + 4 * fq;
#pragma unroll
        for (int ai = 0; ai < 2; ++ai)
#pragma unroll
            for (int m = 0; m < 4; ++m) { float* rowp = O + (size_t)(row0 + ai * HALF + m * 16) * ldc + col0;
#pragma unroll
                for (int bj = 0; bj < 2; ++bj)
#pragma unroll
                    for (int n = 0; n < 2; ++n) *(f32x4*)(rowp + bj * HALF + n * 16) = acc[ai][bj][m][n]; }
    }
};
struct EpiRelu2 {
    static constexpr bool PERM = true;
    bf16_t* O; int ldc;
    __device__ __forceinline__ void operator()(const Acc& acc, const Unit& u, int wr, int wc, int fr, int fq) const {
        const int row0 = u.pm * BM + wr * 64 + fr, col0 = u.pn * BM + wc * 32 + 8 * fq;
#pragma unroll
        for (int ai = 0; ai < 2; ++ai)
#pragma unroll
            for (int m = 0; m < 4; ++m) { bf16_t* rowp = O + (size_t)(row0 + ai * HALF + m * 16) * ldc + col0;
#pragma unroll
                for (int bj = 0; bj < 2; ++bj) { f32x4 v0 = acc[ai][bj][m][0], v1 = acc[ai][bj][m][1];
#pragma unroll
                    for (int e = 0; e < 4; ++e) { const float a = fmaxf(v0[e], 0.f), b = fmaxf(v1[e], 0.f); v0[e] = a * a; v1[e] = b * b; }
                    *(u32x4*)(rowp + bj * HALF) = pack8(v0, v1); } }
    }
};

template <class Epi, class Sched, bool ALIGN_EPI>
__device__ __forceinline__ void gemm_phase(LAS unsigned char* lds, const Dims g, const Sched& S, const Epi& E) {
    int tid_ = threadIdx.x; asm volatile("" : "+v"(tid_));
    const int tid = tid_, wid = __builtin_amdgcn_readfirstlane(tid >> 6), lane = tid & 63, wr = wid >> 2, wc = wid & 3, fr = lane & 15, fq = lane >> 4;
    unsigned voffA[2], voffB[2];
#pragma unroll
    for (int i = 0; i < 2; ++i) { int R, C; stage_rc(tid * 16 + i * 8192, R, C); const int Rb = Epi::PERM ? ((R & ~31) + perm32(R & 31)) : R;
        voffA[i] = (unsigned)(R * g.lda + C) * 2u; voffB[i] = (unsigned)(Rb * g.ldb + C) * 2u; }
    const size_t kstep = (size_t)(BK * 2);
    const size_t hA = (size_t)HALF * g.lda * 2, hB = (size_t)HALF * g.ldb * 2;
    const unsigned ldsw = (unsigned)wid * 1024u;
    const int aoff = lds_byte(wr * 64 + fr, fq * 8), boff = lds_byte(wc * 32 + fr, fq * 8);
#define PG8_SA(b, h) (((b) * 2 + (h)) * HTB)
#define PG8_SB(b, h) ((4 + (b) * 2 + (h)) * HTB)
#define PG8_STAGE(bufoff, gbase, voff) do { _Pragma("unroll") for (int _i = 0; _i < 2; ++_i) \
        __builtin_amdgcn_global_load_lds((const unsigned*)((const char*)(gbase) + (voff)[_i]), (LAS unsigned*)(lds + (bufoff) + ldsw + _i * 8192), 16, 0, 0); } while (0)
#define PG8_LDA(dst, b, h) do { _Pragma("unroll") for (int m = 0; m < 4; ++m) _Pragma("unroll") for (int k = 0; k < 2; ++k) dst[m][k] = *(const LAS bf16x8*)(lds + PG8_SA(b, h) + aoff + m * 2048 + k * 1024); } while (0)
#define PG8_LDB(dst, b, h) do { _Pragma("unroll") for (int n = 0; n < 2; ++n) _Pragma("unroll") for (int k = 0; k < 2; ++k) dst[n][k] = *(const LAS bf16x8*)(lds + PG8_SB(b, h) + boff + n * 2048 + k * 1024); } while (0)
#define PG8_MMA(ai, bj, At, Bt) do { __builtin_amdgcn_s_setprio(1); _Pragma("unroll") for (int m = 0; m < 4; ++m) _Pragma("unroll") for (int n = 0; n < 2; ++n) _Pragma("unroll") for (int k = 0; k < 2; ++k) \
        acc[ai][bj][m][n] = __builtin_amdgcn_mfma_f32_16x16x32_bf16(Bt[n][k], At[m][k], acc[ai][bj][m][n], 0, 0, 0); __builtin_amdgcn_s_setprio(0); } while (0)
#define PG8_WAIT_V(n) asm volatile("s_waitcnt vmcnt(" #n ")" ::: "memory")
#define PG8_WAIT_L(n) asm volatile("s_waitcnt lgkmcnt(" #n ")" ::: "memory")
#define PG8_BAR __builtin_amdgcn_s_barrier()
#define PG8_SCHED __builtin_amdgcn_sched_barrier(0)
    Unit cur, nxt; int ui = 0;
    if (!S.next(0, cur)) return;
    Acc acc;
#pragma unroll
    for (int a = 0; a < 2; ++a)
#pragma unroll
        for (int b = 0; b < 2; ++b)
#pragma unroll
            for (int m = 0; m < 4; ++m)
#pragma unroll
                for (int n = 0; n < 2; ++n) acc[a][b][m][n] = (f32x4){0.f, 0.f, 0.f, 0.f};
    bf16x8 At[4][2], B0[2][2], B1[2][2];
    const char* cA = cur.a; const char* cB = cur.b;
    PG8_STAGE(PG8_SB(0, 0), cB, voffB); PG8_STAGE(PG8_SB(0, 1), cB + hB, voffB); PG8_STAGE(PG8_SA(0, 0), cA, voffA); PG8_STAGE(PG8_SA(0, 1), cA + hA, voffA);
    if (wr == 1) PG8_BAR;
    PG8_WAIT_V(2); PG8_BAR;
    PG8_STAGE(PG8_SB(1, 0), cB + kstep, voffB); PG8_STAGE(PG8_SA(1, 0), cA + kstep, voffA); PG8_STAGE(PG8_SB(1, 1), cB + hB + kstep, voffB);
    PG8_WAIT_V(6); PG8_BAR;
    for (;;) {
        const bool has_next = S.next(ui + 1, nxt);
        const char* nA = has_next ? nxt.a : cA; const char* nB = has_next ? nxt.b : cB;
        const int nt = cur.nt;
        for (int t = 0; t < nt; t += 2) {
            const bool last = (t == nt - 2);
            const char* a1 = cA + (size_t)(t + 1) * kstep;
            const char* a2 = last ? nA : cA + (size_t)(t + 2) * kstep; const char* b2 = last ? nB : cB + (size_t)(t + 2) * kstep;
            const char* a3 = a2 + kstep; const char* b3 = b2 + kstep;
            PG8_LDB(B0, 0, 0); PG8_LDB(B1, 0, 1); PG8_SCHED; PG8_LDA(At, 0, 0); PG8_STAGE(PG8_SA(1, 1), a1 + hA, voffA);
            PG8_WAIT_V(8); PG8_WAIT_L(0); PG8_BAR; PG8_MMA(0, 0, At, B0); PG8_MMA(0, 1, At, B1); PG8_BAR; PG8_SCHED;
            PG8_LDA(At, 0, 1); PG8_STAGE(PG8_SB(0, 0), b2, voffB); PG8_STAGE(PG8_SB(0, 1), b2 + hB, voffB); PG8_STAGE(PG8_SA(0, 0), a2, voffA);
            PG8_WAIT_V(8); PG8_WAIT_L(0); PG8_BAR; PG8_MMA(1, 0, At, B0); PG8_MMA(1, 1, At, B1); PG8_BAR; PG8_SCHED;
            PG8_LDB(B0, 1, 0); PG8_LDB(B1, 1, 1); PG8_SCHED; PG8_LDA(At, 1, 0); PG8_STAGE(PG8_SA(0, 1), a2 + hA, voffA);
            PG8_WAIT_V(8); PG8_WAIT_L(0); PG8_BAR; PG8_MMA(0, 0, At, B0); PG8_MMA(0, 1, At, B1); PG8_BAR; PG8_SCHED;
            PG8_LDA(At, 1, 1); PG8_STAGE(PG8_SB(1, 0), b3, voffB); PG8_STAGE(PG8_SB(1, 1), b3 + hB, voffB); PG8_STAGE(PG8_SA(1, 0), a3, voffA);
            PG8_WAIT_V(8); PG8_WAIT_L(0); PG8_BAR; PG8_MMA(1, 0, At, B0); PG8_MMA(1, 1, At, B1); PG8_BAR; PG8_SCHED;
        }
        if constexpr (ALIGN_EPI) { if (wr == 0) PG8_BAR; }
        E(acc, cur, wr, wc, fr, fq);
        if (!has_next) break;
#pragma unroll
        for (int a = 0; a < 2; ++a)
#pragma unroll
            for (int b = 0; b < 2; ++b)
#pragma unroll
                for (int m = 0; m < 4; ++m)
#pragma unroll
                    for (int n = 0; n < 2; ++n) acc[a][b][m][n] = (f32x4){0.f, 0.f, 0.f, 0.f};
        cur = nxt; cA = nA; cB = nB; ++ui;
        if constexpr (ALIGN_EPI) { if (wr == 1) PG8_BAR; }
    }
    PG8_WAIT_V(0);
    if constexpr (!ALIGN_EPI) { if (wr == 0) PG8_BAR; }
    PG8_BAR;
#undef PG8_SA
#undef PG8_SB
#undef PG8_STAGE
#undef PG8_LDA
#undef PG8_LDB
#undef PG8_MMA
#undef PG8_WAIT_V
#undef PG8_WAIT_L
#undef PG8_BAR
#undef PG8_SCHED
}
}

namespace att {
constexpr int NW = 8, QBLK = 32, KVBLK = 64, LD = 1024, LDO = D;
constexpr float SCALE = 0.088388347648318440f, THR = 8.f;
constexpr int SHM_V = KVBLK * 128 * 2, SHM_K = KVBLK * 128 * 2, OFF_WS = 2 * SHM_V + 2 * SHM_K, OFF_RPB = OFF_WS + NW * 64 * 4, ATT_LDS = OFF_RPB + 2048;
#define KSWZ(row, colB) ((row) * 256 + ((colB) ^ (((row) & 7) << 4)))
#define SBAR() __builtin_amdgcn_sched_barrier(0)
__device__ __forceinline__ int crow(int r, int hi) { return (r & 3) + 8 * (r >> 2) + 4 * hi; }
__device__ __forceinline__ bf16x8 ld8(const bf16_t* p) { return *reinterpret_cast<const bf16x8*>(p); }

__device__ __forceinline__ void partialSM(f32x16& p0, f32x16& p1, float& m_reg, float& mn, float& alpha) {
  constexpr float C = SCALE * 1.4426950408889634f;
  float pmax = p0[0];
#pragma unroll
  for (int r = 1; r < 16; ++r) pmax = fmaxf(pmax, p0[r]);
#pragma unroll
  for (int r = 0; r < 16; ++r) pmax = fmaxf(pmax, p1[r]);
  { auto rr = __builtin_amdgcn_permlane32_swap(__float_as_uint(pmax), __float_as_uint(pmax), false, false);
    pmax = fmaxf(__uint_as_float(rr[0]), __uint_as_float(rr[1])); }
  if (__builtin_expect(__all(pmax - m_reg <= THR / SCALE), 1)) { mn = m_reg; alpha = 1.f; }
  else { mn = fmaxf(m_reg, pmax); alpha = __builtin_amdgcn_exp2f((m_reg - mn) * C); m_reg = mn; }
  float mnC = -mn * C;
#pragma unroll
  for (int r = 0; r < 16; ++r) p0[r] = fmaf(p0[r], C, mnC);
#pragma unroll
  for (int r = 0; r < 16; ++r) p1[r] = fmaf(p1[r], C, mnC);
#pragma unroll
  for (int r = 0; r < 16; ++r) p0[r] = __builtin_amdgcn_exp2f(p0[r]);
}
__device__ __forceinline__ void finishSM(f32x16& p0, f32x16& p1, float alpha, float& l_reg, bf16x8& pa0, bf16x8& pa1, bf16x8& pa2, bf16x8& pa3) {
#pragma unroll
  for (int r = 0; r < 16; ++r) p1[r] = __builtin_amdgcn_exp2f(p1[r]);
  float ps = 0;
#pragma unroll
  for (int r = 0; r < 16; ++r) ps += p0[r];
#pragma unroll
  for (int r = 0; r < 16; ++r) ps += p1[r];
  { auto rr = __builtin_amdgcn_permlane32_swap(__float_as_uint(ps), __float_as_uint(ps), false, false);
    ps = __uint_as_float(rr[0]) + __uint_as_float(rr[1]); }
  l_reg = l_reg * alpha + ps;
#define PK4(P, BASE, OUT) do { unsigned a0 = cvt_pk_bf16(P[BASE + 0], P[BASE + 1]), a1 = cvt_pk_bf16(P[BASE + 2], P[BASE + 3]);   \
    unsigned b0 = cvt_pk_bf16(P[BASE + 4], P[BASE + 5]), b1 = cvt_pk_bf16(P[BASE + 6], P[BASE + 7]);                              \
    auto r0 = __builtin_amdgcn_permlane32_swap(a0, b0, false, false); auto r1 = __builtin_amdgcn_permlane32_swap(a1, b1, false, false); \
    u32x4 w = {r0[0], r1[0], r0[1], r1[1]}; OUT = *reinterpret_cast<bf16x8*>(&w); } while (0)
  PK4(p0, 0, pa0); PK4(p0, 8, pa1); PK4(p1, 0, pa2); PK4(p1, 8, pa3);
#undef PK4
}
__device__ __forceinline__ void qkt(f32x16& p0, f32x16& p1, const char* Ks, const bf16x8* qr, int r32, int hi) {
  p0 = f32x16{}; p1 = f32x16{};
#pragma unroll
  for (int d0 = 0; d0 < 8; ++d0) { int cb = (d0 * 16 + hi * 8) * 2;
    bf16x8 b0 = *reinterpret_cast<const bf16x8*>(Ks + KSWZ(r32, cb));
    bf16x8 b1 = *reinterpret_cast<const bf16x8*>(Ks + KSWZ(32 + r32, cb));
    p0 = __builtin_amdgcn_mfma_f32_32x32x16_bf16(b0, qr[d0], p0, 0, 0, 0);
    p1 = __builtin_amdgcn_mfma_f32_32x32x16_bf16(b1, qr[d0], p1, 0, 0, 0); }
}
__device__ __forceinline__ int v_st(int k, int c) { const int kk = (k & ~0xC) | ((k & 4) << 1) | ((k & 8) >> 1); return ((kk >> 3) * 4 + (c >> 5)) * 512 + ((kk & 7) * 32 + (c & 31)) * 2; }
__device__ __forceinline__ int v_rd_base(int lane) { return ((lane & 3) << 3) | (((lane >> 2) & 3) << 6) | (((lane >> 4) & 1) << 5) | (((lane >> 5) & 1) << 8); }
constexpr int v_rd_off(int d0, int ks, int half) { return d0 * 512 + ks * 4096 + half * 2048; }
template <int OFF> __device__ __forceinline__ s16x4 tr_read(int vb) {
  s16x4 r; asm volatile("ds_read_b64_tr_b16 %0, %1 offset:%2" : "=&v"(r) : "v"(vb), "i"(OFF) : "memory"); return r;
}
template <int D0> __device__ __forceinline__ void pv_one(f32x16& od, int vb, bf16x8 pa0, bf16x8 pa1, bf16x8 pa2, bf16x8 pa3) {
  const s16x4 l0 = tr_read<v_rd_off(D0, 0, 0)>(vb), h0 = tr_read<v_rd_off(D0, 0, 1)>(vb), l1 = tr_read<v_rd_off(D0, 1, 0)>(vb), h1 = tr_read<v_rd_off(D0, 1, 1)>(vb);
  const s16x4 l2 = tr_read<v_rd_off(D0, 2, 0)>(vb), h2 = tr_read<v_rd_off(D0, 2, 1)>(vb), l3 = tr_read<v_rd_off(D0, 3, 0)>(vb), h3 = tr_read<v_rd_off(D0, 3, 1)>(vb);
  asm volatile("s_waitcnt lgkmcnt(0)" ::: "memory"); SBAR();
#define PK(L, H) (bf16x8){L[0], L[1], L[2], L[3], H[0], H[1], H[2], H[3]}
  od = __builtin_amdgcn_mfma_f32_32x32x16_bf16(pa0, PK(l0, h0), od, 0, 0, 0);
  od = __builtin_amdgcn_mfma_f32_32x32x16_bf16(pa1, PK(l1, h1), od, 0, 0, 0);
  od = __builtin_amdgcn_mfma_f32_32x32x16_bf16(pa2, PK(l2, h2), od, 0, 0, 0);
  od = __builtin_amdgcn_mfma_f32_32x32x16_bf16(pa3, PK(l3, h3), od, 0, 0, 0);
#undef PK
}
__device__ __forceinline__ void pv_d0(f32x16* o, int vb, bf16x8 pa0, bf16x8 pa1, bf16x8 pa2, bf16x8 pa3) {
  pv_one<0>(o[0], vb, pa0, pa1, pa2, pa3); pv_one<1>(o[1], vb, pa0, pa1, pa2, pa3); pv_one<2>(o[2], vb, pa0, pa1, pa2, pa3); pv_one<3>(o[3], vb, pa0, pa1, pa2, pa3);
}
__device__ __forceinline__ void apply_bias(f32x16& p0, f32x16& p1, int kr, int qr, int rs, int qc, int cs, const float* rpbs, int hi) {
  const bool row_ok = (unsigned)(kr - rs) < 8u;
  const int base = (kr - qr + 7) * 31 + 15 - qc;
  const float ninf = -__builtin_inff();
#pragma unroll
  for (int r = 0; r < 16; ++r) {
    const int kc0 = crow(r, hi), kc1 = 32 + kc0;
    const bool ok0 = row_ok && ((unsigned)(kc0 - cs) < 16u), ok1 = row_ok && ((unsigned)(kc1 - cs) < 16u);
    const float b0 = rpbs[ok0 ? base + kc0 : 0], b1 = rpbs[ok1 ? base + kc1 : 0];
    p0[r] = ok0 ? p0[r] + b0 : ninf; p1[r] = ok1 ? p1[r] + b1 : ninf;
  }
}
template <bool LAT>
__device__ __forceinline__ void body(const bf16_t* __restrict__ Qb, const bf16_t* __restrict__ K0, const bf16_t* __restrict__ V0, int nt0,
                                     const bf16_t* __restrict__ K1, const bf16_t* __restrict__ V1, int NT, bf16_t* __restrict__ Ob, char* lds, int kr0, int qrb) {
  int tid_ = threadIdx.x; asm volatile("" : "+v"(tid_));
  const int tid = tid_, wid = tid >> 6, lane = tid & 63, r32 = lane & 31, hi = lane >> 5;
  char* V_lds = lds; char* K_lds = lds + 2 * SHM_V;
  float* ws = (float*)(lds + OFF_WS) + wid * 64; float* li_l = ws; float* al_l = ws + 32;
  const float* rpbs = (const float*)(lds + OFF_RPB);
  const int qr = qrb + (wid >> 1), qc = (wid & 1) * 32 + r32;
  const int rs = min(max(qr - 4, 0), 8), cs = min(max(qc - 8, 0), 48);
  float m_reg = -1e30f, l_reg = 0; f32x16 o[4] = {}; bf16x8 qreg[8];
  const bf16_t* Qw = Qb + (long)(wid * QBLK + r32) * LD + hi * 8;
#pragma unroll
  for (int d0 = 0; d0 < 8; ++d0) qreg[d0] = ld8(Qw + d0 * 16);
  const int sr = tid >> 4, sc = (tid & 15) * 8, vst0 = v_st(sr, sc), vst1 = v_st(32 + sr, sc);
  const int vb0 = (int)(uintptr_t)V_lds + v_rd_base(lane);
  struct { bf16x8 vs0, vs1, ks0, ks1; } sr_[2];
#define SLOAD(i, t) do { const int t_ = (t); const bf16_t* kp_ = (t_ < nt0) ? K0 + (long)t_ * KVBLK * LD : K1 + (long)(t_ - nt0) * KVBLK * LD; \
    const bf16_t* vp_ = (t_ < nt0) ? V0 + (long)t_ * KVBLK * LD : V1 + (long)(t_ - nt0) * KVBLK * LD; \
    sr_[i].vs0 = ld8(vp_ + (long)sr * LD + sc); sr_[i].vs1 = ld8(vp_ + (long)(32 + sr) * LD + sc); \
    sr_[i].ks0 = ld8(kp_ + (long)sr * LD + sc); sr_[i].ks1 = ld8(kp_ + (long)(32 + sr) * LD + sc); } while (0)
#define SWRITE(b, i) do { *(bf16x8*)(V_lds + (b) * SHM_V + vst0) = sr_[i].vs0;          \
    *(bf16x8*)(V_lds + (b) * SHM_V + vst1) = sr_[i].vs1; int kc = sc * 2;               \
    *(bf16x8*)(K_lds + (b) * SHM_K + KSWZ(sr, kc)) = sr_[i].ks0;                       \
    *(bf16x8*)(K_lds + (b) * SHM_K + KSWZ(32 + sr, kc)) = sr_[i].ks1; } while (0)
#define SWAIT() asm volatile("s_waitcnt vmcnt(4)" ::: "memory")
#define RESC(a) do { if (__any((a) < 1.f)) { if (hi == 0) al_l[r32] = (a); asm volatile("s_waitcnt lgkmcnt(0)" ::: "memory"); \
    _Pragma("unroll") for (int d = 0; d < 4; ++d) _Pragma("unroll") for (int r = 0; r < 16; ++r) o[d][r] *= al_l[crow(r, hi)]; } } while (0)
#define BIAS(P0, P1, t) do { if (LAT) { const int t_ = (t); if (t_ < nt0) apply_bias(P0, P1, kr0 + t_, qr, rs, qc, cs, rpbs, hi); } } while (0)
  f32x16 pA0, pA1, pB0, pB1; float mnA, mnB, alA, alB; bf16x8 pa0, pa1, pa2, pa3;
  constexpr int SE = 0, SO = 1;
  SLOAD(SE, 0); asm volatile("s_waitcnt vmcnt(0)" ::: "memory"); SWRITE(0, SE); __syncthreads();
  qkt(pA0, pA1, K_lds, qreg, r32, hi); BIAS(pA0, pA1, 0); partialSM(pA0, pA1, m_reg, mnA, alA);
  SLOAD(SO, 1); if (2 < NT) SLOAD(SE, 2);
  SWAIT(); SWRITE(1, SO); __syncthreads();
  for (int j = 1; j + 1 < NT; j += 2) {
    SBAR(); qkt(pB0, pB1, K_lds + SHM_K, qreg, r32, hi);
    finishSM(pA0, pA1, alA, l_reg, pa0, pa1, pa2, pa3); SBAR();
    SLOAD(SO, j + 2); SBAR();
    pv_d0(o, vb0, pa0, pa1, pa2, pa3); BIAS(pB0, pB1, j); partialSM(pB0, pB1, m_reg, mnB, alB);
    __syncthreads(); SWAIT(); SWRITE(0, SE);
    RESC(alB); __syncthreads();
    SBAR(); qkt(pA0, pA1, K_lds, qreg, r32, hi);
    finishSM(pB0, pB1, alB, l_reg, pa0, pa1, pa2, pa3); SBAR();
    if (j + 3 < NT) SLOAD(SE, j + 3); SBAR();
    pv_d0(o, vb0 + SHM_V, pa0, pa1, pa2, pa3); BIAS(pA0, pA1, j + 1); partialSM(pA0, pA1, m_reg, mnA, alA);
    __syncthreads(); SWAIT(); SWRITE(1, SO);
    RESC(alA); __syncthreads();
  }
  SBAR(); qkt(pB0, pB1, K_lds + SHM_K, qreg, r32, hi);
  finishSM(pA0, pA1, alA, l_reg, pa0, pa1, pa2, pa3); SBAR();
  pv_d0(o, vb0, pa0, pa1, pa2, pa3); BIAS(pB0, pB1, NT - 1); partialSM(pB0, pB1, m_reg, mnB, alB);
  __syncthreads(); RESC(alB);
  finishSM(pB0, pB1, alB, l_reg, pa0, pa1, pa2, pa3); SBAR();
  pv_d0(o, vb0 + SHM_V, pa0, pa1, pa2, pa3);
  if (hi == 0) li_l[r32] = l_reg; asm volatile("s_waitcnt lgkmcnt(0)" ::: "memory");
  float rli[16];
#pragma unroll
  for (int r = 0; r < 16; ++r) rli[r] = __builtin_amdgcn_rcpf(li_l[crow(r, hi)]);
  bf16_t* Ow = Ob + (long)(wid * QBLK) * LDO;
#pragma unroll
  for (int r = 0; r < 16; ++r) { const int orow = crow(r, hi);
#pragma unroll
    for (int d0 = 0; d0 < 4; ++d0) Ow[(long)orow * LDO + d0 * 32 + r32] = (bf16_t)(cvt_pk_bf16(o[d0][r] * rli[r], 0.f) & 0xffffu); }
#undef SLOAD
#undef SWRITE
#undef SWAIT
#undef RESC
#undef BIAS
}
}

#define XB_TMO      128
#define XB_XCNT(j)  (256  + 64 * (j))
#define XB_XSUB(j)  (1280 + 64 * (j))
#define XB_XGEN(j)  (2304 + 64 * (j))
#define XB_TOP      3328
#define XB_TOPGEN   3392
#define XCD_BAR_WORDS 3456
#define XB_SPIN_CAP (1u << 18)
__device__ __forceinline__ unsigned xb_ld(unsigned* p)              { return __hip_atomic_load(p, __ATOMIC_RELAXED, __HIP_MEMORY_SCOPE_AGENT); }
__device__ __forceinline__ unsigned xb_add(unsigned* p, unsigned v) { return __hip_atomic_fetch_add(p, v, __ATOMIC_RELAXED, __HIP_MEMORY_SCOPE_AGENT); }
__device__ __forceinline__ unsigned xb_xcc_id() { return (unsigned)__builtin_amdgcn_s_getreg((3 << 11) | 20) & 0xFu; }
#define XB_SPIN(cond, bar) do { unsigned _sp = 0; while (cond) { __builtin_amdgcn_s_sleep(1); \
    if ((++_sp & 255u) == 0u) { if (xb_ld(&(bar)[XB_TMO])) break; if (_sp > XB_SPIN_CAP) { atomicAdd(&(bar)[XB_TMO], 1u); break; } } } } while (0)
struct XcdBarrier { unsigned* bar; unsigned x; volatile LAS unsigned* st; };
__device__ __forceinline__ XcdBarrier xcd_barrier_post(unsigned* bar, volatile LAS unsigned* st) {
    XcdBarrier b; b.bar = bar; b.x = xb_xcc_id(); b.st = st;
    if (threadIdx.x == 0) (void)xb_add(&bar[XB_XCNT(b.x)], 1u);
    return b;
}
__device__ __forceinline__ void xcd_barrier_complete(unsigned* bar, unsigned x, unsigned& nloc, unsigned& nx) {
    const unsigned G = gridDim.x * gridDim.y * gridDim.z;
    unsigned sum, cnt, mine, sp = 0u;
    for (;;) {
        sum = 0u; cnt = 0u; mine = 0u;
#pragma unroll
        for (unsigned j = 0; j < 16; ++j) { const unsigned c = xb_ld(&bar[XB_XCNT(j)]); sum += c; cnt += (c > 0u) ? 1u : 0u; mine = (j == x) ? c : mine; }
        if (sum == G) break;
        __builtin_amdgcn_s_sleep(1);
        if ((++sp & 255u) == 0u) { if (xb_ld(&bar[XB_TMO])) break; if (sp > XB_SPIN_CAP) { atomicAdd(&bar[XB_TMO], 1u); break; } }
    }
    nloc = mine > 0u ? mine : 1u; nx = cnt > 0u ? cnt : 1u;
}
__device__ __forceinline__ void xcd_barrier(const XcdBarrier& b) {
    asm volatile("s_waitcnt vmcnt(0)" ::: "memory");
    __syncthreads();
    if (threadIdx.x == 0) {
        unsigned* bar = b.bar;
        __builtin_amdgcn_s_waitcnt(0);
        unsigned nloc = b.st[0], nx = b.st[1];
        if (nloc == 0u) { xcd_barrier_complete(bar, b.x, nloc, nx); b.st[0] = nloc; b.st[1] = nx; }
        const unsigned old = xb_add(&bar[XB_XSUB(b.x)], 1u);
        const unsigned gen = old / nloc;
        if (old + 1u == (gen + 1u) * nloc) {
            __builtin_amdgcn_fence(__ATOMIC_RELEASE, "agent");
            asm volatile("s_waitcnt vmcnt(0)" ::: "memory");
            const unsigned og = xb_add(&bar[XB_TOP], 1u);
            const unsigned tg = og / nx;
            if (og + 1u == (tg + 1u) * nx) xb_add(&bar[XB_TOPGEN], 1u);
            else XB_SPIN(xb_ld(&bar[XB_TOPGEN]) == tg, bar);
            __builtin_amdgcn_fence(__ATOMIC_ACQUIRE, "agent");
            xb_add(&bar[XB_XGEN(b.x)], 1u);
            asm volatile("s_waitcnt vmcnt(0)" ::: "memory");
        } else {
            XB_SPIN(xb_ld(&bar[XB_XGEN(b.x)]) == gen, bar);
            __builtin_amdgcn_fence(__ATOMIC_ACQUIRE, "agent");
            asm volatile("s_waitcnt vmcnt(0)" ::: "memory");
        }
    }
    __syncthreads();
}

struct Args { const float* in[23]; float* out; unsigned char* ws; int ph_lo, ph_hi; };
enum { I_XP = 0, I_XS, I_CK, I_CV, I_C, I_CCTX, I_WADA, I_BADA, I_GPREMIX, I_GPOSTMIX, I_GPREMLP, I_GPOSTMLP, I_WIN, I_RPB, I_GSGU, I_WSP, I_BSP, I_WBRA, I_WBRF, I_WBRC, I_WOUT, I_W1, I_W2 };
constexpr int NPRE = 2, NLP = 10, NPH = NPRE + DEPTH * NLP;

struct Frame {
    LAS unsigned char* lds; char* ldsg;
    int tid, lane, wave, G, bx;
};
typedef const __attribute__((address_space(4))) Args* KArgs;
__device__ __forceinline__ KArgs kargs() { KArgs p = (KArgs)__builtin_amdgcn_kernarg_segment_ptr(); asm volatile("" : "+s"(p)); return p; }
__device__ __forceinline__ int fresh_tid() { int t = threadIdx.x; asm volatile("" : "+v"(t)); return t; }
__device__ __forceinline__ void refresh(Frame& F) { F.tid = fresh_tid(); F.lane = F.tid & 63; F.wave = __builtin_amdgcn_readfirstlane(F.tid >> 6); int g = gridDim.x, b = blockIdx.x; asm volatile("" : "+s"(g), "+s"(b)); F.G = g; F.bx = b; }

__device__ __forceinline__ void tr_item(const float* W, int N, bf16_t* WT, int ldt, int koff, LAS float* scr, int item, int lane) {
    const int nblk = N / 32, kb = item / nblk, nb = item % nblk, k0 = 64 * kb, n0 = 32 * nb;
#pragma unroll 8
    for (int i = 0; i < 32; ++i) { const int kk = 2 * i + (lane >> 5); scr[kk * 33 + (lane & 31)] = W[(size_t)(k0 + kk) * N + n0 + (lane & 31)]; }
    LDS_WAIT(); asm volatile("" ::: "memory");
    const int c = lane & 7;
#pragma unroll
    for (int j = 0; j < 4; ++j) { const int n = (lane >> 3) + 8 * j; const LAS float* s = scr + (8 * c) * 33 + n;
        u32x4 o; o.x = cvt_pk_bf16(s[0 * 33], s[1 * 33]); o.y = cvt_pk_bf16(s[2 * 33], s[3 * 33]); o.z = cvt_pk_bf16(s[4 * 33], s[5 * 33]); o.w = cvt_pk_bf16(s[6 * 33], s[7 * 33]);
        *(u32x4*)(WT + (size_t)(n0 + n) * ldt + koff + k0 + 8 * c) = o; }
    LDS_WAIT(); asm volatile("" ::: "memory");
}
__device__ __forceinline__ bf16_t f2bf(float v) { return (bf16_t)(cvt_pk_bf16(v, 0.f) & 0xffffu); }

__device__ __forceinline__ void p0_weights(Frame& F) {
    refresh(F); KArgs A = kargs(); unsigned char* ws = A->ws;
    LAS float* scr = (LAS float*)(F.lds + F.wave * 16384);
    const int gw = F.bx * 8 + F.wave, NGW = F.G * 8;
    constexpr int I_IN = 32 * 336, I_BA = 16 * 64, I_BF = 8 * 64, I_BC = 8 * 64, I_OUT = 32 * 64, I_1 = 32 * 256, I_2 = 128 * 64, NPL = I_IN + I_BA + I_BF + I_BC + I_OUT + I_1 + I_2;
    for (int it = gw; it < DEPTH * NPL; it += NGW) {
        const int l = it / NPL; int r = it % NPL;
        const float* W; int N; bf16_t* WT; int ldt = D, koff = 0;
        if (r < I_IN) { W = A->in[I_WIN] + (size_t)l * D * IN_W; N = IN_W; WT = (bf16_t*)(ws + WS_WIN + l * SZ_WIN); }
        else if ((r -= I_IN) < I_BA) { W = A->in[I_WBRA] + (size_t)l * 1024 * D; N = D; WT = (bf16_t*)(ws + WS_WBR + l * SZ_WSQ); }
        else if ((r -= I_BA) < I_BF) { W = A->in[I_WBRF] + (size_t)l * 512 * D; N = D; WT = (bf16_t*)(ws + WS_WBR + l * SZ_WSQ); koff = 1024; }
        else if ((r -= I_BF) < I_BC) { W = A->in[I_WBRC] + (size_t)l * 512 * D; N = D; WT = (bf16_t*)(ws + WS_WBR + l * SZ_WSQ); koff = 1536; }
        else if ((r -= I_BC) < I_OUT) { W = A->in[I_WOUT] + (size_t)l * D * D; N = D; WT = (bf16_t*)(ws + WS_WOUT + l * SZ_WSQ); }
        else if ((r -= I_OUT) < I_1) { W = A->in[I_W1] + (size_t)l * D * D_FF; N = D_FF; WT = (bf16_t*)(ws + WS_W1 + l * SZ_W1); }
        else { r -= I_1; W = A->in[I_W2] + (size_t)l * D_FF * D; N = D; WT = (bf16_t*)(ws + WS_W2 + l * SZ_W2); ldt = LDF; }
        tr_item(W, N, WT, ldt, koff, scr, r, F.lane);
    }
}
__device__ __forceinline__ void p0_tables(Frame& F) {
    refresh(F); KArgs A = kargs(); unsigned char* ws = A->ws;
    const int gt = F.bx * 512 + F.tid, GT = F.G * 512;
    bf16_t* tw256 = (bf16_t*)(ws + WS_TW256); bf16_t* tw1024 = (bf16_t*)(ws + WS_TW1024); bf16_t* wf = (bf16_t*)(ws + WS_WF);
    for (int i = gt; i < 256 * 512; i += GT) { const int k1 = i >> 9, cc = i & 511, n = cc & 255, ph = (k1 * n) & 255; const float a = (float)ph * (1.0f / 256.0f);
        tw256[i] = f2bf(cc < 256 ? __builtin_amdgcn_cosf(a) : -__builtin_amdgcn_sinf(a)); }
    for (int i = gt; i < 1024 * 2048; i += GT) { const int k1 = i >> 11, cc = i & 2047, n = cc & 1023, ph = (k1 * n) & 1023; const float a = (float)ph * (1.0f / 1024.0f);
        tw1024[i] = f2bf(cc < 1024 ? __builtin_amdgcn_cosf(a) : -__builtin_amdgcn_sinf(a)); }
    for (int i = gt; i < 1024 * 512; i += GT) { const int m = i >> 9, cc = i & 511, g = m >> 8, j = (m >> 7) & 1, k2 = m & 127, g2 = cc >> 7, n2 = cc & 127, ph = (k2 * n2) & 127; const float a = (float)ph * (1.0f / 128.0f);
        wf[i] = f2bf((g == g2) ? (j ? __builtin_amdgcn_sinf(a) : __builtin_amdgcn_cosf(a)) : 0.f); }
    { const f32x4* s = (const f32x4*)A->in[I_WSP]; u32x4* d = (u32x4*)(ws + WS_WSP);
      for (int i = gt; i < 4 * 4 * 128 * 128 / 8; i += GT) d[i] = pg8::pack8(s[2 * i], s[2 * i + 1]); }
    { const f32x4* s = (const f32x4*)A->in[I_CK]; u32x4* d = (u32x4*)(ws + WS_CK);
      for (int i = gt; i < 2 * 4 * 512 * 1024 / 8; i += GT) d[i] = pg8::pack8(s[2 * i], s[2 * i + 1]); }
    { const f32x4* s = (const f32x4*)A->in[I_CV]; u32x4* d = (u32x4*)(ws + WS_CV);
      for (int i = gt; i < 2 * 4 * 512 * 1024 / 8; i += GT) d[i] = pg8::pack8(s[2 * i], s[2 * i + 1]); }
}
__device__ __forceinline__ void p0_mod(Frame& F) {
    refresh(F); KArgs A = kargs();
    __syncthreads();
    LAS float* sv = (LAS float*)F.lds;
    LAS float* red = (LAS float*)(F.lds + 32768);
    { const float* cc = A->in[I_CCTX]; const float* c = A->in[I_C];
      for (int i = F.tid; i < 3 * D; i += 512) { const int v = i >> 11, k = i & 2047; const float x = v == 0 ? cc[k] : c[(v - 1) * D + k]; sv[i] = x * __builtin_amdgcn_rcpf(1.0f + __expf(-x)); } }
    __syncthreads();
    float* MOD = (float*)(A->ws + WS_MOD); const float* wada = A->in[I_WADA]; const float* bada = A->in[I_BADA];
    for (int item = F.bx; item < DEPTH * 192; item += F.G) {
        const int l = item / 192, j0 = (item % 192) * 64;
        const float* W = wada + (size_t)l * D * 12288 + j0 + (F.lane & 15) * 4;
        const int kbase = F.wave * 256 + (F.lane >> 4);
        f32x4 a0 = {0.f, 0.f, 0.f, 0.f}, a1 = a0, a2 = a0;
#pragma unroll 8
        for (int i = 0; i < 64; ++i) { const int k = kbase + 4 * i; const f32x4 w = *(const f32x4*)(W + (size_t)k * 12288);
            a0 += w * sv[k]; a1 += w * sv[D + k]; a2 += w * sv[2 * D + k]; }
#pragma unroll
        for (int e = 0; e < 4; ++e) { a0[e] += shx(a0[e], 16, F.lane); a0[e] += shx(a0[e], 32, F.lane); a1[e] += shx(a1[e], 16, F.lane); a1[e] += shx(a1[e], 32, F.lane); a2[e] += shx(a2[e], 16, F.lane); a2[e] += shx(a2[e], 32, F.lane); }
        if (F.lane < 16) { *(LAS f32x4*)(red + (F.wave * 3 + 0) * 64 + F.lane * 4) = a0; *(LAS f32x4*)(red + (F.wave * 3 + 1) * 64 + F.lane * 4) = a1; *(LAS f32x4*)(red + (F.wave * 3 + 2) * 64 + F.lane * 4) = a2; }
        __syncthreads();
        if (F.tid < 192) { const int v = F.tid >> 6, jj = F.tid & 63; float s = bada[l * 12288 + j0 + jj];
#pragma unroll
            for (int w = 0; w < 8; ++w) s += red[(w * 3 + v) * 64 + jj];
            MOD[(size_t)(l * 3 + v) * 12288 + j0 + jj] = s; }
        __syncthreads();
    }
}

__device__ __forceinline__ int mod_index(int m) { return m < M_CTX ? 0 : 1 + ((m - M_CTX) >> 10); }
__device__ __forceinline__ void load_row_f32(f32x4 (&v)[8], const float* row, int lane) {
#pragma unroll
    for (int j = 0; j < 4; ++j) { const f32x4* p = (const f32x4*)(row + 8 * (lane + 64 * j)); v[2 * j] = p[0]; v[2 * j + 1] = p[1]; }
}
__device__ __forceinline__ void store_row_f32(float* row, const f32x4 (&v)[8], int lane) {
#pragma unroll
    for (int j = 0; j < 4; ++j) { f32x4* p = (f32x4*)(row + 8 * (lane + 64 * j)); p[0] = v[2 * j]; p[1] = v[2 * j + 1]; }
}
__device__ __forceinline__ void norm_mod_store(const f32x4 (&v)[8], float rstd, const float* g, const float* sc, const float* sh, bf16_t* hrow, int lane) {
#pragma unroll
    for (int j = 0; j < 4; ++j) { const int c = 8 * (lane + 64 * j);
        f32x4 h[2];
#pragma unroll
        for (int e = 0; e < 2; ++e) { const f32x4 gg = *(const f32x4*)(g + c + 4 * e), s1 = *(const f32x4*)(sc + c + 4 * e), s0 = *(const f32x4*)(sh + c + 4 * e); h[e] = v[2 * j + e] * rstd * gg * (1.0f + s1) + s0; }
        *(u32x4*)(hrow + c) = pg8::pack8(h[0], h[1]); }
}
__device__ __forceinline__ float sumsq8(const f32x4 (&v)[8], int lane) {
    float s = 0.f;
#pragma unroll
    for (int j = 0; j < 8; ++j) s += (v[j][0] * v[j][0] + v[j][1] * v[j][1]) + (v[j][2] * v[j][2] + v[j][3] * v[j][3]);
    return wave_sum(s, lane);
}
__device__ __forceinline__ void p1_norm0(Frame& F) {
    refresh(F); KArgs A = kargs();
    const int gw = F.bx * 8 + F.wave, NGW = F.G * 8;
    const float* MOD = (const float*)(A->ws + WS_MOD); bf16_t* H = (bf16_t*)(A->ws + WS_H);
    const float* xp = A->in[I_XP]; const float* xs = A->in[I_XS]; const float* gpm = A->in[I_GPREMIX]; float* out = A->out;
    for (int m = gw; m < M; m += NGW) {
        const float* src = m < M_CTX ? xp + (size_t)m * D : xs + (size_t)(m - M_CTX) * D;
        f32x4 v[8]; load_row_f32(v, src, F.lane);
        const float rstd = __builtin_amdgcn_rsqf(sumsq8(v, F.lane) * (1.0f / D) + RMS_EPS);
        store_row_f32(out + (size_t)m * D, v, F.lane);
        const float* mv = MOD + (size_t)mod_index(m) * 12288;
        norm_mod_store(v, rstd, gpm, mv + 1 * D, mv + 0 * D, H + (size_t)m * D, F.lane);
    }
}
__device__ __forceinline__ void load_y(f32x4 (&y)[8], int m, const bf16_t* MIXB, const bf16_t* SLAB, int lane) {
    if (m < M_CTX) {
        const bf16_t* r = MIXB + (size_t)m * D;
#pragma unroll
        for (int j = 0; j < 4; ++j) { const u32x4 w = *(const u32x4*)(r + 8 * (lane + 64 * j));
            y[2 * j] = (f32x4){bflo(w.x), bfhi(w.x), bflo(w.y), bfhi(w.y)}; y[2 * j + 1] = (f32x4){bflo(w.z), bfhi(w.z), bflo(w.w), bfhi(w.w)}; }
    } else {
        const bf16_t* r = SLAB + (size_t)(m - M_CTX) * D;
        u32x4 w[4][4];
#pragma unroll
        for (int q = 0; q < 4; ++q)
#pragma unroll
            for (int j = 0; j < 4; ++j) w[q][j] = *(const u32x4*)(r + (size_t)q * M_LAT * D + 8 * (lane + 64 * j));
#pragma unroll
        for (int j = 0; j < 4; ++j) { f32x4 a = {0.f, 0.f, 0.f, 0.f}, b = a;
#pragma unroll
            for (int q = 0; q < 4; ++q) { const u32x4 v = w[q][j]; a = a + (f32x4){bflo(v.x), bfhi(v.x), bflo(v.y), bfhi(v.y)}; b = b + (f32x4){bflo(v.z), bfhi(v.z), bflo(v.w), bfhi(v.w)}; }
            y[2 * j] = a; y[2 * j + 1] = b; }
    }
}
__device__ __forceinline__ void thin_phase(Frame& F, int i_gpost, int l, int gate_off, int i_gnext, int ln, int sc_off, int sh_off) {
    refresh(F); KArgs A = kargs();
    const int gw = F.bx * 8 + F.wave, NGW = F.G * 8;
    bf16_t* H = (bf16_t*)(A->ws + WS_H); const bf16_t* MIXB = (const bf16_t*)(A->ws + WS_MIXB); const bf16_t* SLAB = (const bf16_t*)(A->ws + WS_SLAB); float* out = A->out;
    const float* g_post = A->in[i_gpost] + l * D; const float* modc = (const float*)(A->ws + WS_MOD) + (size_t)l * 3 * 12288;
    const float* g_next = i_gnext >= 0 ? A->in[i_gnext] + ln * D : nullptr; const float* modn = (const float*)(A->ws + WS_MOD) + (size_t)ln * 3 * 12288;
    f32x4 xa[8], ya[8], xb[8], yb[8];
    int m = gw;
    if (m < M) { load_row_f32(xa, out + (size_t)m * D, F.lane); load_y(ya, m, MIXB, SLAB, F.lane); }
#define THIN_ROW(X, Y, mm) do { const int mi = mod_index(mm); float* xr = out + (size_t)(mm) * D; \
        const float r1 = __builtin_amdgcn_rsqf(sumsq8(Y, F.lane) * (1.0f / D) + RMS_EPS); \
        const float* gt = modc + (size_t)mi * 12288 + gate_off; \
        _Pragma("unroll") for (int j = 0; j < 4; ++j) _Pragma("unroll") for (int e = 0; e < 2; ++e) { const int c = 8 * (F.lane + 64 * j) + 4 * e; \
            X[2 * j + e] = X[2 * j + e] + *(const f32x4*)(gt + c) * (Y[2 * j + e] * r1 * *(const f32x4*)(g_post + c)); } \
        store_row_f32(xr, X, F.lane); \
        if (g_next) { const float r2 = __builtin_amdgcn_rsqf(sumsq8(X, F.lane) * (1.0f / D) + RMS_EPS); const float* mv = modn + (size_t)mi * 12288; \
            norm_mod_store(X, r2, g_next, mv + sc_off, mv + sh_off, H + (size_t)(mm) * D, F.lane); } } while (0)
    while (m < M) {
        const int m1 = m + NGW;
        if (m1 < M) { load_row_f32(xb, out + (size_t)m1 * D, F.lane); load_y(yb, m1, MIXB, SLAB, F.lane); }
        THIN_ROW(xa, ya, m);
        if (m1 >= M) break;
        const int m2 = m1 + NGW;
        if (m2 < M) { load_row_f32(xa, out + (size_t)m2 * D, F.lane); load_y(ya, m2, MIXB, SLAB, F.lane); }
        THIN_ROW(xb, yb, m1);
        m = m2;
    }
#undef THIN_ROW
}
__device__ __forceinline__ void merge_latent(Frame& F) {
    refresh(F); KArgs A = kargs();
    const bf16_t* SLAB = (const bf16_t*)(A->ws + WS_SLAB); bf16_t* MRG = (bf16_t*)(A->ws + WS_MRG) + (size_t)M_CTX * D;
    for (int i = F.bx * 512 + F.tid; i < M_LAT * D / 8; i += F.G * 512) {
        f32x4 a = {0.f, 0.f, 0.f, 0.f}, b = a;
#pragma unroll
        for (int q = 0; q < 4; ++q) { const u32x4 v = ((const u32x4*)(SLAB + (size_t)q * M_LAT * D))[i]; a = a + (f32x4){bflo(v.x), bfhi(v.x), bflo(v.y), bfhi(v.y)}; b = b + (f32x4){bflo(v.z), bfhi(v.z), bflo(v.w), bfhi(v.w)}; }
        ((u32x4*)MRG)[i] = pg8::pack8(a, b);
    }
}

__device__ __forceinline__ void sg_unit(Frame& F, KArgs A, int l, int unit) {
    const int c = unit >> 2, g = unit & 3, row0 = c * 128;
    const bf16_t* P2 = (const bf16_t*)(A->ws + WS_P2); bf16_t* OBR = (bf16_t*)(A->ws + WS_OBR);
    LAS bf16_t* vT = (LAS bf16_t*)F.lds;
    {
        const int pos = F.tid >> 2, d0 = (F.tid & 3) * 32;
        const bf16_t* vp = P2 + (size_t)(row0 + pos) * P2W + P2_V + g * 128 + d0;
        u32x4 w[4];
#pragma unroll
        for (int i = 0; i < 4; ++i) w[i] = ((const u32x4*)vp)[i];
        float v[32];
#pragma unroll
        for (int i = 0; i < 4; ++i)
#pragma unroll
            for (int e = 0; e < 4; ++e) { v[i * 8 + e * 2] = bflo(w[i][e]); v[i * 8 + e * 2 + 1] = bfhi(w[i][e]); }
        float ss = 0.f;
#pragma unroll
        for (int i = 0; i < 32; ++i) ss += v[i] * v[i];
        ss += shx(ss, 1, F.lane); ss += shx(ss, 2, F.lane);
        const float rstd = __builtin_amdgcn_rsqf(ss * (1.0f / 128.0f) + RMS_EPS);
        const float* gs = A->in[I_GSGU] + (l * 4 + g) * 128 + d0;
#pragma unroll
        for (int i = 0; i < 32; ++i) vT[(d0 + i) * 136 + pos] = f2bf(v[i] * rstd * gs[i]);
    }
    __syncthreads();
    {
        const int fr = F.lane & 15, quad = F.lane >> 4, pcol = F.wave * 16 + fr;
        const bf16_t* wp = (const bf16_t*)(A->ws + WS_WSP) + ((size_t)(l * 4 + g) * 128 + pcol) * 128 + quad * 8;
        bf16x8 bfr[4];
#pragma unroll
        for (int kk = 0; kk < 4; ++kk) bfr[kk] = *(const bf16x8*)(wp + kk * 32);
        f32x4 acc[8];
#pragma unroll
        for (int dt = 0; dt < 8; ++dt) { acc[dt] = (f32x4){0.f, 0.f, 0.f, 0.f};
#pragma unroll
            for (int kk = 0; kk < 4; ++kk) { const bf16x8 afr = *(const LAS bf16x8*)(vT + (dt * 16 + fr) * 136 + kk * 32 + quad * 8);
                acc[dt] = __builtin_amdgcn_mfma_f32_16x16x32_bf16(afr, bfr[kk], acc[dt], 0, 0, 0); } }
        const float bias = A->in[I_BSP][(l * 4 + g) * 128 + pcol];
        const bf16_t* up = P2 + (size_t)(row0 + pcol) * P2W + P2_U + g * 128 + quad * 4;
        bf16_t* op = OBR + (size_t)(row0 + pcol) * D + OB_C + g * 128 + quad * 4;
#pragma unroll
        for (int dt = 0; dt < 8; ++dt) { const u32x2 uw = *(const u32x2*)(up + dt * 16);
            u32x2 o; o.x = cvt_pk_bf16(bflo(uw.x) * (acc[dt][0] + bias), bfhi(uw.x) * (acc[dt][1] + bias)); o.y = cvt_pk_bf16(bflo(uw.y) * (acc[dt][2] + bias), bfhi(uw.y) * (acc[dt][3] + bias));
            *(u32x2*)(op + dt * 16) = o; }
    }
    __syncthreads();
}

__global__ void __launch_bounds__(512, 2) fwd(Args args) {
    extern __shared__ __attribute__((aligned(16))) unsigned char lds[];
    Frame F;
    F.lds = (LAS unsigned char*)lds; F.ldsg = (char*)lds;
    refresh(F);
    volatile LAS unsigned* MISC = (volatile LAS unsigned*)(F.lds + MISC_OFF);
    for (int u = F.tid; u < (LDS_BYTES - RING_BYTES) / 4; u += 512) ((LAS unsigned*)(F.lds + RING_BYTES))[u] = 0u;
    __syncthreads();
    const int lo = args.ph_lo, hi = args.ph_hi;
    XcdBarrier bar; bar.bar = (unsigned*)(args.ws + WS_CTL) + CW_BAR; bar.x = 0; bar.st = nullptr;
    if (hi - lo > 1) bar = xcd_barrier_post((unsigned*)(args.ws + WS_CTL) + CW_BAR, MISC + 8);
#define IN(p) (lo <= (p) && (p) < hi)
#define SEAM(p) do { if ((p) + 1 < hi) { XcdBarrier b_ = bar; asm volatile("" : "+s"(b_.bar)); xcd_barrier(b_); } } while (0)

    if (IN(0)) { p0_weights(F); p0_tables(F); p0_mod(F); SEAM(0); }
    if (IN(1)) { p1_norm0(F); SEAM(1); }

    for (int l = 0; l < DEPTH; ++l) {
        const int pb = NPRE + l * NLP;
        if (pb + NLP <= lo || pb >= hi) continue;
        if (IN(pb + 0)) {
            refresh(F); KArgs A = kargs(); unsigned char* ws = A->ws;
            pg8::Dims g{D, D, D}; pg8::TileOrder S; S.init(ws + WS_H, D, ws + WS_WIN + l * SZ_WIN, D, M, IN_W, D, F.G, F.bx);
            pg8::EpiProj E{(bf16_t*)(ws + WS_QKV), (bf16_t*)(ws + WS_P2), A->out + OUT_CK + (size_t)l * 256 * 1024, A->out + OUT_CV + (size_t)l * 256 * 1024};
            pg8::gemm_phase<pg8::EpiProj, pg8::TileOrder, true>(F.lds, g, S, E);
            SEAM(pb + 0);
        }
        if (IN(pb + 1)) {
            refresh(F); KArgs A = kargs(); unsigned char* ws = A->ws;
            pg8::Dims g{512, P2W, 512}; pg8::TileOrder S; S.init(ws + WS_WF, 512, (bf16_t*)(ws + WS_P2) + P2_F, P2W, 1024, M, 512, F.G, F.bx);
            pg8::EpiTT E{(bf16_t*)(ws + WS_TT), (bf16_t*)(ws + WS_TTL)};
            pg8::gemm_phase<pg8::EpiTT, pg8::TileOrder, true>(F.lds, g, S, E);
            SEAM(pb + 1);
        }
        if (IN(pb + 2)) {
            {
                refresh(F); KArgs A = kargs(); unsigned char* ws = A->ws;
                pg8::Dims g{2048, 2048, 2048};
                pg8::BatchOrder S{(const char*)(ws + WS_TW1024), (const char*)(ws + WS_TTL), (size_t)256 * 2048 * 2, (size_t)256 * 2048 * 2, (size_t)512 * 2048 * 2, 4, 2, 2, F.G, F.bx < 16 ? F.bx : -1, 32, 32};
                pg8::EpiFour2 E{(bf16_t*)(ws + WS_OBR), 0.00276213586400995f};
                pg8::gemm_phase<pg8::EpiFour2, pg8::BatchOrder, true>(F.lds, g, S, E);
            }
            {
                refresh(F); KArgs A = kargs(); unsigned char* ws = A->ws;
                pg8::Dims g{512, 512, 512};
                pg8::BatchOrder S{(const char*)(ws + WS_TW256), (const char*)(ws + WS_TT), (size_t)256 * 512 * 2, (size_t)256 * 512 * 2, (size_t)512 * 512 * 2, 1, 2, 32, F.G, F.bx >= 192 ? F.bx - 192 : -1, 0, 8};
                pg8::EpiFour2 E{(bf16_t*)(ws + WS_OBR), 0.005524271728019903f};
                pg8::gemm_phase<pg8::EpiFour2, pg8::BatchOrder, true>(F.lds, g, S, E);
            }
            {
                refresh(F); KArgs A = kargs(); unsigned char* ws = A->ws;
                const bf16_t* QKV = (const bf16_t*)(ws + WS_QKV); bf16_t* OBR = (bf16_t*)(ws + WS_OBR);
                const int u0 = F.bx < 160 ? 2 * (F.bx - 80) : F.bx, nu = F.bx < 80 ? 0 : (F.bx < 160 ? 2 : 1);
                for (int k = 0; k < nu; ++k) {
                    const int u = u0 + k, b = u >> 3, h = u & 7;
                    const bf16_t* Qb = QKV + (size_t)(b * 256) * 1024 + h * 128;
                    __syncthreads();
                    att::body<false>(Qb, Qb + (size_t)M * 1024, Qb + (size_t)2 * M * 1024, 4, nullptr, nullptr, 4, OBR + (size_t)(b * 256) * D + OB_A + h * 128, F.ldsg, 0, 0);
                }
            }
            {
                refresh(F); KArgs A = kargs(); unsigned char* ws = A->ws;
                const bf16_t* QKV = (const bf16_t*)(ws + WS_QKV); bf16_t* OBR = (bf16_t*)(ws + WS_OBR);
                if (F.bx >= 16 && F.bx < 80) {
                    const int u = F.bx - 16, j = u & 3, h = (u >> 2) & 7, b = u >> 5;
                    const int kr0 = j == 0 ? 0 : (j == 1 ? 0 : (j == 2 ? 4 : 8)), nt0 = (j == 0 || j == 3) ? 8 : 12;
                    __syncthreads();
                    { const int t = fresh_tid(); if (t < 465) ((float*)(F.ldsg + att::OFF_RPB))[t] = A->in[I_RPB][(l * 8 + h) * 465 + t] * (1.0f / att::SCALE); }
                    __syncthreads();
                    const size_t r0 = (size_t)M_CTX + b * 1024;
                    const bf16_t* Qb = QKV + (r0 + 256 * j) * 1024 + h * 128;
                    const bf16_t* K0 = QKV + (size_t)M * 1024 + (r0 + kr0 * 64) * 1024 + h * 128;
                    const bf16_t* K1 = (const bf16_t*)(ws + WS_CK) + ((size_t)(b * 4 + l) * 512) * 1024 + h * 128;
                    const bf16_t* V1 = (const bf16_t*)(ws + WS_CV) + ((size_t)(b * 4 + l) * 512) * 1024 + h * 128;
                    att::body<true>(Qb, K0, K0 + (size_t)M * 1024, nt0, K1, V1, nt0 + 8, OBR + (r0 + 256 * j) * D + OB_A + h * 128, F.ldsg, kr0, 4 * j);
                }
                __syncthreads();
            }
            {
                refresh(F); KArgs A = kargs();
                const int u0 = F.bx < 160 ? 2 * (F.bx - 80) : 160 + 5 * (F.bx - 160), nu = F.bx < 80 ? 0 : (F.bx < 160 ? 2 : (F.bx < 192 ? 5 : 0));
                for (int k = 0; k < nu; ++k) sg_unit(F, A, l, u0 + k);
            }
            SEAM(pb + 2);
        }
        if (IN(pb + 3)) {
            refresh(F); KArgs A = kargs(); unsigned char* ws = A->ws;
            pg8::Dims g{D, D, D};
            typedef pg8::BalOrder<3, 16, 24, 32> BO3; BO3 S{(const char*)(ws + WS_OBR), (const char*)(ws + WS_WBR + l * SZ_WSQ), (size_t)256 * D * 2, (size_t)256 * D * 2, F.bx, 8, (F.bx >> 3) & 3};
            pg8::EpiBranch E{(const bf16_t*)(ws + WS_P2), (bf16_t*)(ws + WS_MRG), (bf16_t*)(ws + WS_SLAB)};
            pg8::gemm_phase<pg8::EpiBranch, BO3, true>(F.lds, g, S, E);
            SEAM(pb + 3);
        }
        if (IN(pb + 4)) { merge_latent(F); SEAM(pb + 4); }
        if (IN(pb + 5)) {
            refresh(F); KArgs A = kargs(); unsigned char* ws = A->ws;
            pg8::Dims g{D, D, D};
            typedef pg8::BalOrder<1, 32, 0, 0> BO1; BO1 S{(const char*)(ws + WS_MRG), (const char*)(ws + WS_WOUT + l * SZ_WSQ), (size_t)256 * D * 2, (size_t)256 * D * 2, F.bx, 8, (F.bx >> 3) & 1};
            pg8::EpiOut E{(bf16_t*)(ws + WS_MIXB), (bf16_t*)(ws + WS_SLAB)};
            pg8::gemm_phase<pg8::EpiOut, BO1, true>(F.lds, g, S, E);
            SEAM(pb + 5);
        }
        if (IN(pb + 6)) {
            thin_phase(F, I_GPOSTMIX, l, 2 * D, I_GPREMLP, l, 4 * D, 3 * D);
            SEAM(pb + 6);
        }
        if (IN(pb + 7)) {
            refresh(F); KArgs A = kargs(); unsigned char* ws = A->ws;
            pg8::Dims g{D, D, D}; pg8::TileOrder S; S.init(ws + WS_H, D, ws + WS_W1 + l * SZ_W1, D, M, D_FF, D, F.G, F.bx);
            pg8::EpiRelu2 E{(bf16_t*)(ws + WS_FF1), LDF}; pg8::gemm_phase<pg8::EpiRelu2, pg8::TileOrder, true>(F.lds, g, S, E);
            SEAM(pb + 7);
        }
        if (IN(pb + 8)) {
            refresh(F); KArgs A = kargs(); unsigned char* ws = A->ws;
            pg8::Dims g{LDF, LDF, D_FF};
            typedef pg8::BalOrder<1, 128, 0, 0> BO1; BO1 S{(const char*)(ws + WS_FF1), (const char*)(ws + WS_W2 + l * SZ_W2), (size_t)256 * LDF * 2, (size_t)256 * LDF * 2, F.bx, 32, (F.bx >> 3) & 1};
            pg8::EpiOut E{(bf16_t*)(ws + WS_MIXB), (bf16_t*)(ws + WS_SLAB)};
            pg8::gemm_phase<pg8::EpiOut, BO1, true>(F.lds, g, S, E);
            SEAM(pb + 8);
        }
        if (IN(pb + 9)) {
            const bool nx = l + 1 < DEPTH;
            thin_phase(F, I_GPOSTMLP, l, 5 * D, nx ? I_GPREMIX : -1, nx ? l + 1 : l, 1 * D, 0);
            SEAM(pb + 9);
        }
    }
#undef IN
#undef SEAM
}

extern "C" void kernel_launch(void* const* d_in, const int* in_sizes, int n_in, void* d_out, int out_size, void* d_ws, size_t ws_size, hipStream_t stream) {
    static int grid = 0;
    if (grid == 0) {
        if (n_in != 23 || out_size != (int)(OUT_CV + (size_t)32 * 4 * 256 * 1024) || ws_size < WS_END) {
            fprintf(stderr, "kernel_launch: shape mismatch: n_in %d out %d ws %zu (need %zu); nothing launched\n", n_in, out_size, ws_size, (size_t)WS_END); grid = -1; return; }
        int dev = 0, cus = 0, per_cu = 0;
        if (hipGetDevice(&dev) != hipSuccess || hipDeviceGetAttribute(&cus, hipDeviceAttributeMultiprocessorCount, dev) != hipSuccess) { fprintf(stderr, "kernel_launch: device query failed\n"); grid = -1; return; }
        if (hipFuncSetAttribute((const void*)fwd, hipFuncAttributeMaxDynamicSharedMemorySize, LDS_BYTES) != hipSuccess) { fprintf(stderr, "kernel_launch: hipFuncSetAttribute failed\n"); grid = -1; return; }
        if (hipOccupancyMaxActiveBlocksPerMultiprocessor(&per_cu, (const void*)fwd, 512, LDS_BYTES) != hipSuccess || per_cu < 1)
            fprintf(stderr, "kernel_launch: note: occupancy query reports %d workgroups per CU\n", per_cu);
        (void)hipGetLastError();
        if (cus != 256) { fprintf(stderr, "kernel_launch: built for a 256-CU device (got %d); nothing launched\n", cus); grid = -1; return; }
        grid = cus;
    }
    if (grid < 0) return;
    if (hipMemsetAsync((char*)d_ws + WS_CTL, 0, CTL_BYTES, stream) != hipSuccess) { fprintf(stderr, "kernel_launch: memset failed\n"); return; }
    Args a{};
    for (int i = 0; i < 23; ++i) a.in[i] = (const float*)d_in[i];
    a.out = (float*)d_out; a.ws = (unsigned char*)d_ws;
#if MK_PER_PHASE
    for (int p = 0; p < NPH; ++p) { a.ph_lo = p; a.ph_hi = p + 1; hipLaunchKernelGGL(fwd, dim3(grid), dim3(512), LDS_BYTES, stream, a); }
#else
    a.ph_lo = 0; a.ph_hi = NPH; hipLaunchKernelGGL(fwd, dim3(grid), dim3(512), LDS_BYTES, stream, a);
#endif
    const hipError_t le = hipPeekAtLastError();
    if (le != hipSuccess) fprintf(stderr, "kernel_launch: launch failed: %s\n", hipGetErrorName(le));
}
```

```cpp
#include <hip/hip_runtime.h>
#include <cstdio>
#include <cstdint>

#ifndef MK_PER_PHASE
#define MK_PER_PHASE 0
#endif

#define LAS __attribute__((address_space(3)))
#define GAS __attribute__((address_space(1)))
typedef unsigned short bf16_t;
typedef short bf16x8 __attribute__((ext_vector_type(8)));
typedef short s16x4 __attribute__((ext_vector_type(4)));
typedef float f32x2 __attribute__((ext_vector_type(2)));
typedef float f32x4 __attribute__((ext_vector_type(4)));
typedef float f32x16 __attribute__((ext_vector_type(16)));
typedef unsigned u32x2 __attribute__((ext_vector_type(2)));
typedef unsigned u32x4 __attribute__((ext_vector_type(4)));

constexpr int D = 2048, M_CTX = 8192, M_LAT = 2048, M = M_CTX + M_LAT, DEPTH = 4;
constexpr int IN_W = 10752, D_FF = 8192, LDF = D_FF + 0, P2W = 7680;
constexpr int P2_F = 0, P2_U = 512, P2_V = 1024, P2_GA = 1536, P2_GF = 3584, P2_GC = 5632;
constexpr int OB_A = 0, OB_F = 1024, OB_C = 1536;
constexpr float RMS_EPS = 1e-6f;
constexpr size_t OUT_YS = (size_t)M_CTX * D, OUT_CK = (size_t)M * D, OUT_CV = OUT_CK + (size_t)32 * 4 * 256 * 1024;

constexpr size_t MiB = 1u << 20;
constexpr size_t WS_CTL = 0, CTL_BYTES = MiB;
constexpr size_t SZ_WIN = (size_t)IN_W * D * 2, SZ_WSQ = (size_t)D * D * 2, SZ_W1 = (size_t)D_FF * D * 2, SZ_W2 = (size_t)D * LDF * 2;
constexpr size_t WS_WIN = CTL_BYTES;
constexpr size_t WS_WBR = WS_WIN + 4 * SZ_WIN;
constexpr size_t WS_WOUT = WS_WBR + 4 * SZ_WSQ;
constexpr size_t WS_W1 = WS_WOUT + 4 * SZ_WSQ;
constexpr size_t WS_W2 = WS_W1 + 4 * SZ_W1;
constexpr size_t WS_TW256 = WS_W2 + 4 * SZ_W2;
constexpr size_t WS_TW1024 = WS_TW256 + 256 * 512 * 2;
constexpr size_t WS_WF = WS_TW1024 + 1024 * 2048 * 2;
constexpr size_t WS_WSP = WS_WF + 1024 * 512 * 2;
constexpr size_t WS_CK = WS_WSP + 4 * 4 * 128 * 128 * 2;
constexpr size_t WS_CV = WS_CK + (size_t)2 * 4 * 512 * 1024 * 2;
constexpr size_t WS_MOD = WS_CV + (size_t)2 * 4 * 512 * 1024 * 2;
constexpr size_t WS_H = ((WS_MOD + 4 * 3 * 12288 * 4) + 4095) & ~(size_t)4095;
constexpr size_t WS_QKV = WS_H + (size_t)M * D * 2;
constexpr size_t WS_P2 = WS_QKV + (size_t)3 * M * 1024 * 2;
constexpr size_t WS_FF1 = WS_QKV;
constexpr size_t WS_TT = WS_P2 + (size_t)M * P2W * 2;
constexpr size_t WS_TTL = WS_TT + (size_t)32 * 4 * 128 * 512 * 2;
constexpr size_t WS_OBR = WS_TT + (size_t)M * 1024 * 2;
constexpr size_t WS_MRG = WS_OBR + (size_t)M * D * 2;
constexpr size_t WS_SLAB = WS_MRG + (size_t)M * D * 2;
constexpr size_t WS_MIXB = WS_SLAB + (size_t)4 * M_LAT * D * 4;
constexpr size_t WS_XB = WS_MIXB + (size_t)M_CTX * D * 2;
constexpr size_t WS_END = WS_XB + (size_t)M * D * 2;
static_assert((size_t)M * LDF * 2 <= (size_t)3 * M * 1024 * 2 + (size_t)M * P2W * 2, "FF1 overlay fits");
constexpr int CW_BAR = 4096;

constexpr int RING_BYTES = 131072, MISC_OFF = RING_BYTES + 320, LDS_BYTES = 147456;

#define LDS_WAIT() asm volatile("s_waitcnt lgkmcnt(0)" ::: "memory")
#define VM_WAIT() asm volatile("s_waitcnt vmcnt(0)" ::: "memory")

__device__ __forceinline__ unsigned cvt_pk_bf16(float lo, float hi) { unsigned r; asm volatile("v_cvt_pk_bf16_f32 %0, %1, %2" : "=v"(r) : "v"(lo), "v"(hi)); return r; }
__device__ __forceinline__ float bf2f(unsigned short h) { return __uint_as_float((unsigned)h << 16); }
__device__ __forceinline__ float bflo(unsigned w) { return __uint_as_float(w << 16); }
__device__ __forceinline__ float bfhi(unsigned w) { return __uint_as_float(w & 0xffff0000u); }
__device__ __forceinline__ float shx(float v, int o, int lane) { return __int_as_float(__builtin_amdgcn_ds_bpermute((lane ^ o) << 2, __float_as_int(v))); }
__device__ __forceinline__ float wave_sum(float v, int lane) {
#pragma unroll
    for (int o = 1; o < 64; o <<= 1) v += shx(v, o, lane);
    return v;
}

namespace pg8 {
constexpr int BM = 256, BK = 64, HALF = 128, HTB = HALF * BK * 2, STAGE_BYTES = 8 * HTB, NXCD = 8, WGM = 8;
__host__ __device__ __forceinline__ int lds_byte(int r, int c) { const int st = (r >> 4) * 2 + (c >> 5), rr = r & 15, cc = c & 31, ob = rr * 64 + cc * 2; return st * 1024 + (ob ^ (((ob >> 9) & 1) << 5)); }
__host__ __device__ __forceinline__ void stage_rc(int b, int& R, int& C) { const int st = b / 1024, sb = b % 1024, swz = sb ^ (((sb >> 9) & 1) << 5); R = (st >> 1) * 16 + swz / 64; C = (st & 1) * 32 + (swz % 64) / 2; }
__host__ __device__ __forceinline__ int perm32(int rho) { const int n = rho >> 4, i = rho & 15; return 8 * (i >> 2) + 4 * n + (i & 3); }

struct Unit { int pm, pn; const char* a; const char* b; int nt, aux; };
struct Dims { int lda, ldb, K; };

struct TileOrder {
    const char* A; const char* Bt; size_t tA, tB; int nM, nN, nwg, G, c, nt;
    __device__ __forceinline__ void init(const void* A_, size_t lda, const void* Bt_, size_t ldb, int M_, int N_, int K_, int G_, int c_) {
        A = (const char*)A_; Bt = (const char*)Bt_; tA = (size_t)BM * lda * 2; tB = (size_t)BM * ldb * 2; nM = M_ / BM; nN = N_ / BM; nwg = nM * nN; G = G_; c = c_; nt = K_ / BK; }
    __device__ __forceinline__ bool next(int i, Unit& u) const {
        const long L = (long)i * G + c; if (c < 0 || L >= nwg) return false;
        int wgid = (int)L; { const int q = nwg / NXCD, r = nwg % NXCD, xcd = wgid % NXCD, off = wgid / NXCD; wgid = (xcd < r ? xcd * (q + 1) : r * (q + 1) + (xcd - r) * q) + off; }
        const int nig = WGM * nN, gid = wgid / nig, fm = gid * WGM, gsz = (nM - fm) < WGM ? (nM - fm) : WGM;
        u.pm = fm + ((wgid % nig) % gsz); u.pn = (wgid % nig) / gsz; u.a = A + (size_t)u.pm * tA; u.b = Bt + (size_t)u.pn * tB; u.nt = nt; u.aux = 0; return true;
    }
};
struct BatchOrder {
    const char* A; const char* Bt; size_t tA, tB, bB; int nM, nN, nB, G, c, rt0, nt;
    __device__ __forceinline__ bool next(int i, Unit& u) const {
        const long L = (long)i * G + c; if (c < 0 || L >= (long)nB * nM * nN) return false;
        const int b = (int)L / (nM * nN), r = (int)L % (nM * nN), pm = r / nN, pn = r % nN;
        u.a = A + (size_t)pm * tA; u.b = Bt + (size_t)b * bB + (size_t)pn * tB; u.pm = rt0 + b * nM + pm; u.pn = pn; u.nt = nt; u.aux = 0; return true;
    }
};
template <int NSEG, int K1, int K2, int K3> struct BalOrder {
    const char* A; const char* Bt; size_t tA, tB; int c, ntq, rot;
    __device__ __forceinline__ bool next(int i, Unit& u) const {
        const int x = c & 7, s = c >> 3;
        if (i > NSEG) return false;
        int j = i + rot; if (j > NSEG) j -= NSEG + 1;
        if (j < NSEG) { const int k0 = j == 0 ? 0 : (j == 1 ? K1 : K2), k1 = j == 0 ? K1 : (j == 1 ? K2 : K3);
            const bool first = (rot == NSEG) ? (i == 1) : (i == 0);
            u.pm = 4 * x + (s >> 3); u.pn = s & 7; u.a = A + (size_t)u.pm * tA + (size_t)k0 * (BK * 2); u.b = Bt + (size_t)u.pn * tB + (size_t)k0 * (BK * 2); u.nt = k1 - k0; u.aux = j | (first ? 8 : 0); return true; }
        const int q = s & 3; u.pm = 32 + x; u.pn = s >> 2; u.a = A + (size_t)u.pm * tA + (size_t)q * ntq * (BK * 2); u.b = Bt + (size_t)u.pn * tB + (size_t)q * ntq * (BK * 2); u.nt = ntq; u.aux = 16 + q; return true;
    }
};

__device__ __forceinline__ f32x2 gelu_pk(f32x2 v) {
    const f32x2 av = __builtin_elementwise_abs(v), d = av * 0.2316418882f + 1.0f;
    f32x2 t; t.x = __builtin_amdgcn_rcpf(d.x); t.y = __builtin_amdgcn_rcpf(d.y);
    f32x2 q = t * 0.5307027145f + (-0.7265760135f); q = q * t + 0.7107068705f; q = q * t + (-0.142248368f); q = q * t + 0.127414796f; q = q * t;
    const f32x2 s = (v * v) * (-0.72134752044f);
    f32x2 e; e.x = __builtin_amdgcn_exp2f(s.x); e.y = __builtin_amdgcn_exp2f(s.y);
    const f32x2 m = v * (q * e), r = v - m;
    f32x2 o; o.x = v.x < 0.f ? m.x : r.x; o.y = v.y < 0.f ? m.y : r.y; return o;
}
__device__ __forceinline__ float sigmoidf_(float x) { return __builtin_amdgcn_rcpf(1.0f + __builtin_amdgcn_exp2f(-1.4426950408889634f * x)); }

typedef f32x4 Acc[2][2][4][2];
__device__ __forceinline__ u32x4 pack8(f32x4 v0, f32x4 v1) { u32x4 w; w.x = cvt_pk_bf16(v0[0], v0[1]); w.y = cvt_pk_bf16(v0[2], v0[3]); w.z = cvt_pk_bf16(v1[0], v1[1]); w.w = cvt_pk_bf16(v1[2], v1[3]); return w; }

struct EpiProj {
    static constexpr bool PERM = true;
    bf16_t* QKV; bf16_t* P2; float* ck; float* cv;
    __device__ __forceinline__ void operator()(const Acc& acc, const Unit& u, int wr, int wc, int fr, int fq) const {
        const int row0 = u.pm * BM + wr * 64 + fr, colw = wc * 32 + 8 * fq, pn = u.pn;
        if (pn < 12) {
            const int t = pn >> 2, cb = (pn & 3) * 256 + colw;
            bf16_t* base = QKV + (size_t)t * M * 1024 + cb;
            float* cbase = (t == 1 ? ck : cv) + cb;
            const bool wc_ = (t >= 1) && (u.pm < 32);
#pragma unroll
            for (int ai = 0; ai < 2; ++ai)
#pragma unroll
                for (int m = 0; m < 4; ++m) { const int row = row0 + ai * HALF + m * 16;
#pragma unroll
                    for (int bj = 0; bj < 2; ++bj) { const f32x4 v0 = acc[ai][bj][m][0], v1 = acc[ai][bj][m][1];
                        *(u32x4*)(base + (size_t)row * 1024 + bj * HALF) = pack8(v0, v1);
                        if (wc_) { float* cp = cbase + ((size_t)(row >> 8) * 1024 + (row & 255)) * 1024 + bj * HALF; *(f32x4*)cp = v0; *(f32x4*)(cp + 4) = v1; } } }
        } else {
            const int act = (pn >= 14 && pn < 18) ? 1 : 0;
            bf16_t* base = P2 + (pn - 12) * 256 + colw;
#pragma unroll
            for (int ai = 0; ai < 2; ++ai)
#pragma unroll
                for (int m = 0; m < 4; ++m) { const int row = row0 + ai * HALF + m * 16;
#pragma unroll
                    for (int bj = 0; bj < 2; ++bj) { f32x4 v0 = acc[ai][bj][m][0], v1 = acc[ai][bj][m][1];
                        if (act == 1) { f32x2 a = gelu_pk((f32x2){v0[0], v0[1]}), b = gelu_pk((f32x2){v0[2], v0[3]}), c = gelu_pk((f32x2){v1[0], v1[1]}), d = gelu_pk((f32x2){v1[2], v1[3]});
                            v0 = (f32x4){a.x, a.y, b.x, b.y}; v1 = (f32x4){c.x, c.y, d.x, d.y}; }
                        *(u32x4*)(base + (size_t)row * P2W + bj * HALF) = pack8(v0, v1); } }
        }
    }
};
struct EpiTT {
    static constexpr bool PERM = true;
    bf16_t* TTC; bf16_t* TTL;
    __device__ __forceinline__ void operator()(const Acc& acc, const Unit& u, int wr, int wc, int fr, int fq) const {
        const int g = u.pm, tok0 = u.pn * BM + wc * 32 + 8 * fq;
#pragma unroll
        for (int bj = 0; bj < 2; ++bj) { const int tok = tok0 + bj * HALF;
            bf16_t* colp; int rs, js;
            if (tok < M_CTX) { const int b = tok >> 8, n1 = tok & 255; colp = TTC + ((size_t)(b * 4 + g) * 128) * 512 + n1; rs = 512; js = 256; }
            else { const int tl = tok - M_CTX, b = tl >> 10, n1 = tl & 1023; colp = TTL + ((size_t)(b * 4 + g) * 128) * 2048 + n1; rs = 2048; js = 1024; }
#pragma unroll
            for (int ai = 0; ai < 2; ++ai)
#pragma unroll
                for (int m = 0; m < 4; ++m) { const int k2 = wr * 64 + m * 16 + fr;
                    *(u32x4*)(colp + (size_t)k2 * rs + ai * js) = pack8(acc[ai][bj][m][0], acc[ai][bj][m][1]); } }
    }
};
struct EpiFour2 {
    static constexpr bool PERM = true;
    bf16_t* OBR; float scale;
    __device__ __forceinline__ void operator()(const Acc& acc, const Unit& u, int wr, int wc, int fr, int fq) const {
        const int row0 = u.pm * BM + wr * 64 + fr, col0 = OB_F + u.pn * BM + wc * 32 + 8 * fq;
#pragma unroll
        for (int ai = 0; ai < 2; ++ai)
#pragma unroll
            for (int m = 0; m < 4; ++m) { bf16_t* rowp = OBR + (size_t)(row0 + ai * HALF + m * 16) * D + col0;
#pragma unroll
                for (int bj = 0; bj < 2; ++bj) *(u32x4*)(rowp + bj * HALF) = pack8(acc[ai][bj][m][0] * scale, acc[ai][bj][m][1] * scale); }
    }
};
struct EpiBranch {
    static constexpr bool PERM = true;
    const bf16_t* P2; bf16_t* MRG; bf16_t* SLAB;
    __device__ __forceinline__ void operator()(const Acc& acc, const Unit& u, int wr, int wc, int fr, int fq) const {
        const int row0 = u.pm * BM + wr * 64 + fr, col0 = u.pn * BM + wc * 32 + 8 * fq, aux = u.aux;
        const bool piece = aux >= 16, rmw = !piece && !(aux & 8);
        const int q = aux - 16, seg = piece ? (q < 2 ? 0 : q - 1) : (aux & 7);
        const bf16_t* gate = P2 + (seg == 0 ? P2_GA : (seg == 1 ? P2_GF : P2_GC));
        bf16_t* dst = piece ? SLAB + (size_t)q * M_LAT * D - (size_t)M_CTX * D : MRG;
#pragma unroll
        for (int ai = 0; ai < 2; ++ai) {
            u32x4 gw[4][2], tw[4][2];
#pragma unroll
            for (int m = 0; m < 4; ++m)
#pragma unroll
                for (int bj = 0; bj < 2; ++bj) { const size_t row = (size_t)(row0 + ai * HALF + m * 16); const int col = col0 + bj * HALF;
                    gw[m][bj] = *(const u32x4*)(gate + row * P2W + col);
                    tw[m][bj] = (u32x4){0u, 0u, 0u, 0u}; if (rmw) tw[m][bj] = *(const u32x4*)(MRG + row * D + col); }
            __builtin_amdgcn_sched_barrier(0);
#pragma unroll
            for (int m = 0; m < 4; ++m)
#pragma unroll
                for (int bj = 0; bj < 2; ++bj) { const size_t row = (size_t)(row0 + ai * HALF + m * 16); const int col = col0 + bj * HALF;
                    const u32x4 g4 = gw[m][bj], t4 = tw[m][bj];
                    f32x4 v0 = acc[ai][bj][m][0], v1 = acc[ai][bj][m][1];
                    v0 = v0 * (f32x4){sigmoidf_(bflo(g4.x)), sigmoidf_(bfhi(g4.x)), sigmoidf_(bflo(g4.y)), sigmoidf_(bfhi(g4.y))};
                    v1 = v1 * (f32x4){sigmoidf_(bflo(g4.z)), sigmoidf_(bfhi(g4.z)), sigmoidf_(bflo(g4.w)), sigmoidf_(bfhi(g4.w))};
                    v0 = v0 + (f32x4){bflo(t4.x), bfhi(t4.x), bflo(t4.y), bfhi(t4.y)}; v1 = v1 + (f32x4){bflo(t4.z), bfhi(t4.z), bflo(t4.w), bfhi(t4.w)};
                    *(u32x4*)(dst + row * D + col) = pack8(v0, v1); }
            __builtin_amdgcn_sched_barrier(0);
        }
    }
};
struct EpiOut {
    static constexpr bool PERM = true;
    bf16_t* MIXB; bf16_t* SLAB;
    __device__ __forceinline__ void operator()(const Acc& acc, const Unit& u, int wr, int wc, int fr, int fq) const {
        const int row0 = u.pm * BM + wr * 64 + fr, col0 = u.pn * BM + wc * 32 + 8 * fq, aux = u.aux;
        bf16_t* dst = aux >= 16 ? SLAB + (size_t)(aux - 16) * M_LAT * D - (size_t)M_CTX * D : MIXB;
#pragma unroll
        for (int ai = 0; ai < 2; ++ai)
#pragma unroll
            for (int m = 0; m < 4; ++m) { const size_t row = (size_t)(row0 + ai * HALF + m * 16);
#pragma unroll
                for (int bj = 0; bj < 2; ++bj) *(u32x4*)(dst + row * D + col0 + bj * HALF) = pack8(acc[ai][bj][m][0], acc[ai][bj][m][1]); }
    }
};
struct EpiF32 {
    static constexpr bool PERM = false;
    float* O; int ldc;
    __device__ __forceinline__ void operator()(const Acc& acc, const Unit& u, int wr, int wc, int fr, int fq) const {
        const int row0 = u.pm * BM + wr * 64 + fr, col0 = u.pn * BM + wc * 32 + 4 * fq;
#pragma unroll
        for (int ai = 0; ai < 2; ++ai)
#pragma unroll
            for (int m = 0; m < 4; ++m) { float* rowp = O + (size_t)(row0 + ai * HALF + m * 16) * ldc + col0;
#pragma unroll
                for (int bj = 0; bj < 2; ++bj)
#pragma unroll
                    for (int n = 0; n < 2; ++n) *(f32x4*)(rowp + bj * HALF + n * 16) = acc[ai][bj][m][n]; }
    }
};
struct EpiRelu2 {
    static constexpr bool PERM = true;
    bf16_t* O; int ldc;
    __device__ __forceinline__ void operator()(const Acc& acc, const Unit& u, int wr, int wc, int fr, int fq) const {
        const int row0 = u.pm * BM + wr * 64 + fr, col0 = u.pn * BM + wc * 32 + 8 * fq;
#pragma unroll
        for (int ai = 0; ai < 2; ++ai)
#pragma unroll
            for (int m = 0; m < 4; ++m) { bf16_t* rowp = O + (size_t)(row0 + ai * HALF + m * 16) * ldc + col0;
#pragma unroll
                for (int bj = 0; bj < 2; ++bj) { f32x4 v0 = acc[ai][bj][m][0], v1 = acc[ai][bj][m][1];
#pragma unroll
                    for (int e = 0; e < 4; ++e) { const float a = fmaxf(v0[e], 0.f), b = fmaxf(v1[e], 0.f); v0[e] = a * a; v1[e] = b * b; }
                    *(u32x4*)(rowp + bj * HALF) = pack8(v0, v1); } }
    }
};

template <class Epi, class Sched, bool ALIGN_EPI>
__device__ __forceinline__ void gemm_phase(LAS unsigned char* lds, const Dims g, const Sched& S, const Epi& E) {
    int tid_ = threadIdx.x; asm volatile("" : "+v"(tid_));
    const int tid = tid_, wid = __builtin_amdgcn_readfirstlane(tid >> 6), lane = tid & 63, wr = wid >> 2, wc = wid & 3, fr = lane & 15, fq = lane >> 4;
    unsigned voffA[2], voffB[2];
#pragma unroll
    for (int i = 0; i < 2; ++i) { int R, C; stage_rc(tid * 16 + i * 8192, R, C); const int Rb = Epi::PERM ? ((R & ~31) + perm32(R & 31)) : R;
        voffA[i] = (unsigned)(R * g.lda + C) * 2u; voffB[i] = (unsigned)(Rb * g.ldb + C) * 2u; }
    const size_t kstep = (size_t)(BK * 2);
    const size_t hA = (size_t)HALF * g.lda * 2, hB = (size_t)HALF * g.ldb * 2;
    const unsigned ldsw = (unsigned)wid * 1024u;
    const int aoff = lds_byte(wr * 64 + fr, fq * 8), boff = lds_byte(wc * 32 + fr, fq * 8);
#define PG8_SA(b, h) (((b) * 2 + (h)) * HTB)
#define PG8_SB(b, h) ((4 + (b) * 2 + (h)) * HTB)
#define PG8_STAGE(bufoff, gbase, voff) do { _Pragma("unroll") for (int _i = 0; _i < 2; ++_i) \
        __builtin_amdgcn_global_load_lds((const unsigned*)((const char*)(gbase) + (voff)[_i]), (LAS unsigned*)(lds + (bufoff) + ldsw + _i * 8192), 16, 0, 0); } while (0)
#define PG8_LDA(dst, b, h) do { _Pragma("unroll") for (int m = 0; m < 4; ++m) _Pragma("unroll") for (int k = 0; k < 2; ++k) dst[m][k] = *(const LAS bf16x8*)(lds + PG8_SA(b, h) + aoff + m * 2048 + k * 1024); } while (0)
#define PG8_LDB(dst, b, h) do { _Pragma("unroll") for (int n = 0; n < 2; ++n) _Pragma("unroll") for (int k = 0; k < 2; ++k) dst[n][k] = *(const LAS bf16x8*)(lds + PG8_SB(b, h) + boff + n * 2048 + k * 1024); } while (0)
#define PG8_MMA(ai, bj, At, Bt) do { __builtin_amdgcn_s_setprio(1); _Pragma("unroll") for (int m = 0; m < 4; ++m) _Pragma("unroll") for (int n = 0; n < 2; ++n) _Pragma("unroll") for (int k = 0; k < 2; ++k) \
        acc[ai][bj][m][n] = __builtin_amdgcn_mfma_f32_16x16x32_bf16(Bt[n][k], At[m][k], acc[ai][bj][m][n], 0, 0, 0); __builtin_amdgcn_s_setprio(0); } while (0)
#define PG8_WAIT_V(n) asm volatile("s_waitcnt vmcnt(" #n ")" ::: "memory")
#define PG8_WAIT_L(n) asm volatile("s_waitcnt lgkmcnt(" #n ")" ::: "memory")
#define PG8_BAR __builtin_amdgcn_s_barrier()
#define PG8_SCHED __builtin_amdgcn_sched_barrier(0)
    Unit cur, nxt; int ui = 0;
    if (!S.next(0, cur)) return;
    Acc acc;
#pragma unroll
    for (int a = 0; a < 2; ++a)
#pragma unroll
        for (int b = 0; b < 2; ++b)
#pragma unroll
            for (int m = 0; m < 4; ++m)
#pragma unroll
                for (int n = 0; n < 2; ++n) acc[a][b][m][n] = (f32x4){0.f, 0.f, 0.f, 0.f};
    bf16x8 At[4][2], B0[2][2], B1[2][2];
    const char* cA = cur.a; const char* cB = cur.b;
    PG8_STAGE(PG8_SB(0, 0), cB, voffB); PG8_STAGE(PG8_SB(0, 1), cB + hB, voffB); PG8_STAGE(PG8_SA(0, 0), cA, voffA); PG8_STAGE(PG8_SA(0, 1), cA + hA, voffA);
    if (wr == 1) PG8_BAR;
    PG8_WAIT_V(2); PG8_BAR;
    PG8_STAGE(PG8_SB(1, 0), cB + kstep, voffB); PG8_STAGE(PG8_SA(1, 0), cA + kstep, voffA); PG8_STAGE(PG8_SB(1, 1), cB + hB + kstep, voffB);
    PG8_WAIT_V(6); PG8_BAR;
    for (;;) {
        const bool has_next = S.next(ui + 1, nxt);
        const char* nA = has_next ? nxt.a : cA; const char* nB = has_next ? nxt.b : cB;
        const int nt = cur.nt;
        for (int t = 0; t < nt; t += 2) {
            const bool last = (t == nt - 2);
            const char* a1 = cA + (size_t)(t + 1) * kstep;
            const char* a2 = last ? nA : cA + (size_t)(t + 2) * kstep; const char* b2 = last ? nB : cB + (size_t)(t + 2) * kstep;
            const char* a3 = a2 + kstep; const char* b3 = b2 + kstep;
            PG8_LDB(B0, 0, 0); PG8_LDB(B1, 0, 1); PG8_SCHED; PG8_LDA(At, 0, 0); PG8_STAGE(PG8_SA(1, 1), a1 + hA, voffA);
            PG8_WAIT_V(8); PG8_WAIT_L(0); PG8_BAR; PG8_MMA(0, 0, At, B0); PG8_MMA(0, 1, At, B1); PG8_BAR; PG8_SCHED;
            PG8_LDA(At, 0, 1); PG8_STAGE(PG8_SB(0, 0), b2, voffB); PG8_STAGE(PG8_SB(0, 1), b2 + hB, voffB); PG8_STAGE(PG8_SA(0, 0), a2, voffA);
            PG8_WAIT_V(8); PG8_WAIT_L(0); PG8_BAR; PG8_MMA(1, 0, At, B0); PG8_MMA(1, 1, At, B1); PG8_BAR; PG8_SCHED;
            PG8_LDB(B0, 1, 0); PG8_LDB(B1, 1, 1); PG8_SCHED; PG8_LDA(At, 1, 0); PG8_STAGE(PG8_SA(0, 1), a2 + hA, voffA);
            PG8_WAIT_V(8); PG8_WAIT_L(0); PG8_BAR; PG8_MMA(0, 0, At, B0); PG8_MMA(0, 1, At, B1); PG8_BAR; PG8_SCHED;
            PG8_LDA(At, 1, 1); PG8_STAGE(PG8_SB(1, 0), b3, voffB); PG8_STAGE(PG8_SB(1, 1), b3 + hB, voffB); PG8_STAGE(PG8_SA(1, 0), a3, voffA);
            PG8_WAIT_V(8); PG8_WAIT_L(0); PG8_BAR; PG8_MMA(1, 0, At, B0); PG8_MMA(1, 1, At, B1); PG8_BAR; PG8_SCHED;
        }
        if constexpr (ALIGN_EPI) { if (wr == 0) PG8_BAR; }
        E(acc, cur, wr, wc, fr, fq);
        if (!has_next) break;
#pragma unroll
        for (int a = 0; a < 2; ++a)
#pragma unroll
            for (int b = 0; b < 2; ++b)
#pragma unroll
                for (int m = 0; m < 4; ++m)
#pragma unroll
                    for (int n = 0; n < 2; ++n) acc[a][b][m][n] = (f32x4){0.f, 0.f, 0.f, 0.f};
        cur = nxt; cA = nA; cB = nB; ++ui;
        if constexpr (ALIGN_EPI) { if (wr == 1) PG8_BAR; }
    }
    PG8_WAIT_V(0);
    if constexpr (!ALIGN_EPI) { if (wr == 0) PG8_BAR; }
    PG8_BAR;
#undef PG8_SA
#undef PG8_SB
#undef PG8_STAGE
#undef PG8_LDA
#undef PG8_LDB
#undef PG8_MMA
#undef PG8_WAIT_V
#undef PG8_WAIT_L
#undef PG8_BAR
#undef PG8_SCHED
}
}

namespace att {
constexpr int NW = 8, QBLK = 32, KVBLK = 64, LD = 1024, LDO = D;
constexpr float SCALE = 0.088388347648318440f, THR = 8.f;
constexpr int SHM_V = KVBLK * 128 * 2, SHM_K = KVBLK * 128 * 2, OFF_WS = 2 * SHM_V + 2 * SHM_K, OFF_RPB = OFF_WS + NW * 64 * 4, ATT_LDS = OFF_RPB + 2048;
#define KSWZ(row, colB) ((row) * 256 + ((colB) ^ (((row) & 7) << 4)))
#define SBAR() __builtin_amdgcn_sched_barrier(0)
__device__ __forceinline__ int crow(int r, int hi) { return (r & 3) + 8 * (r >> 2) + 4 * hi; }
__device__ __forceinline__ bf16x8 ld8(const bf16_t* p) { return *reinterpret_cast<const bf16x8*>(p); }

__device__ __forceinline__ void partialSM(f32x16& p0, f32x16& p1, float& m_reg, float& mn, float& alpha) {
  constexpr float C = SCALE * 1.4426950408889634f;
  float pmax = p0[0];
#pragma unroll
  for (int r = 1; r < 16; ++r) pmax = fmaxf(pmax, p0[r]);
#pragma unroll
  for (int r = 0; r < 16; ++r) pmax = fmaxf(pmax, p1[r]);
  { auto rr = __builtin_amdgcn_permlane32_swap(__float_as_uint(pmax), __float_as_uint(pmax), false, false);
    pmax = fmaxf(__uint_as_float(rr[0]), __uint_as_float(rr[1])); }
  if (__builtin_expect(__all(pmax - m_reg <= THR / SCALE), 1)) { mn = m_reg; alpha = 1.f; }
  else { mn = fmaxf(m_reg, pmax); alpha = __builtin_amdgcn_exp2f((m_reg - mn) * C); m_reg = mn; }
  float mnC = -mn * C;
#pragma unroll
  for (int r = 0; r < 16; ++r) p0[r] = fmaf(p0[r], C, mnC);
#pragma unroll
  for (int r = 0; r < 16; ++r) p1[r] = fmaf(p1[r], C, mnC);
#pragma unroll
  for (int r = 0; r < 16; ++r) p0[r] = __builtin_amdgcn_exp2f(p0[r]);
}
__device__ __forceinline__ void finishSM(f32x16& p0, f32x16& p1, float alpha, float& l_reg, bf16x8& pa0, bf16x8& pa1, bf16x8& pa2, bf16x8& pa3) {
#pragma unroll
  for (int r = 0; r < 16; ++r) p1[r] = __builtin_amdgcn_exp2f(p1[r]);
  float ps = 0;
#pragma unroll
  for (int r = 0; r < 16; ++r) ps += p0[r];
#pragma unroll
  for (int r = 0; r < 16; ++r) ps += p1[r];
  { auto rr = __builtin_amdgcn_permlane32_swap(__float_as_uint(ps), __float_as_uint(ps), false, false);
    ps = __uint_as_float(rr[0]) + __uint_as_float(rr[1]); }
  l_reg = l_reg * alpha + ps;
#define PK4(P, BASE, OUT) do { unsigned a0 = cvt_pk_bf16(P[BASE + 0], P[BASE + 1]), a1 = cvt_pk_bf16(P[BASE + 2], P[BASE + 3]);   \
    unsigned b0 = cvt_pk_bf16(P[BASE + 4], P[BASE + 5]), b1 = cvt_pk_bf16(P[BASE + 6], P[BASE + 7]);                              \
    auto r0 = __builtin_amdgcn_permlane32_swap(a0, b0, false, false); auto r1 = __builtin_amdgcn_permlane32_swap(a1, b1, false, false); \
    u32x4 w = {r0[0], r1[0], r0[1], r1[1]}; OUT = *reinterpret_cast<bf16x8*>(&w); } while (0)
  PK4(p0, 0, pa0); PK4(p0, 8, pa1); PK4(p1, 0, pa2); PK4(p1, 8, pa3);
#undef PK4
}
__device__ __forceinline__ void qkt(f32x16& p0, f32x16& p1, const char* Ks, const bf16x8* qr, int r32, int hi) {
  p0 = f32x16{}; p1 = f32x16{};
#pragma unroll
  for (int d0 = 0; d0 < 8; ++d0) { int cb = (d0 * 16 + hi * 8) * 2;
    bf16x8 b0 = *reinterpret_cast<const bf16x8*>(Ks + KSWZ(r32, cb));
    bf16x8 b1 = *reinterpret_cast<const bf16x8*>(Ks + KSWZ(32 + r32, cb));
    p0 = __builtin_amdgcn_mfma_f32_32x32x16_bf16(b0, qr[d0], p0, 0, 0, 0);
    p1 = __builtin_amdgcn_mfma_f32_32x32x16_bf16(b1, qr[d0], p1, 0, 0, 0); }
}
__device__ __forceinline__ int v_st(int k, int c) { const int kk = (k & ~0xC) | ((k & 4) << 1) | ((k & 8) >> 1); return ((kk >> 3) * 4 + (c >> 5)) * 512 + ((kk & 7) * 32 + (c & 31)) * 2; }
__device__ __forceinline__ int v_rd_base(int lane) { return ((lane & 3) << 3) | (((lane >> 2) & 3) << 6) | (((lane >> 4) & 1) << 5) | (((lane >> 5) & 1) << 8); }
constexpr int v_rd_off(int d0, int ks, int half) { return d0 * 512 + ks * 4096 + half * 2048; }
template <int OFF> __device__ __forceinline__ s16x4 tr_read(int vb) {
  s16x4 r; asm volatile("ds_read_b64_tr_b16 %0, %1 offset:%2" : "=&v"(r) : "v"(vb), "i"(OFF) : "memory"); return r;
}
template <int D0> __device__ __forceinline__ void pv_one(f32x16& od, int vb, bf16x8 pa0, bf16x8 pa1, bf16x8 pa2, bf16x8 pa3) {
  const s16x4 l0 = tr_read<v_rd_off(D0, 0, 0)>(vb), h0 = tr_read<v_rd_off(D0, 0, 1)>(vb), l1 = tr_read<v_rd_off(D0, 1, 0)>(vb), h1 = tr_read<v_rd_off(D0, 1, 1)>(vb);
  const s16x4 l2 = tr_read<v_rd_off(D0, 2, 0)>(vb), h2 = tr_read<v_rd_off(D0, 2, 1)>(vb), l3 = tr_read<v_rd_off(D0, 3, 0)>(vb), h3 = tr_read<v_rd_off(D0, 3, 1)>(vb);
  asm volatile("s_waitcnt lgkmcnt(0)" ::: "memory"); SBAR();
#define PK(L, H) (bf16x8){L[0], L[1], L[2], L[3], H[0], H[1], H[2], H[3]}
  od = __builtin_amdgcn_mfma_f32_32x32x16_bf16(pa0, PK(l0, h0), od, 0, 0, 0);
  od = __builtin_amdgcn_mfma_f32_32x32x16_bf16(pa1, PK(l1, h1), od, 0, 0, 0);
  od = __builtin_amdgcn_mfma_f32_32x32x16_bf16(pa2, PK(l2, h2), od, 0, 0, 0);
  od = __builtin_amdgcn_mfma_f32_32x32x16_bf16(pa3, PK(l3, h3), od, 0, 0, 0);
#undef PK
}
__device__ __forceinline__ void pv_d0(f32x16* o, int vb, bf16x8 pa0, bf16x8 pa1, bf16x8 pa2, bf16x8 pa3) {
  pv_one<0>(o[0], vb, pa0, pa1, pa2, pa3); pv_one<1>(o[1], vb, pa0, pa1, pa2, pa3); pv_one<2>(o[2], vb, pa0, pa1, pa2, pa3); pv_one<3>(o[3], vb, pa0, pa1, pa2, pa3);
}
__device__ __forceinline__ void apply_bias(f32x16& p0, f32x16& p1, int kr, int qr, int rs, int qc, int cs, const float* rpbs, int hi) {
  const bool row_ok = (unsigned)(kr - rs) < 8u;
  const int base = (kr - qr + 7) * 31 + 15 - qc;
  const float ninf = -__builtin_inff();
#pragma unroll
  for (int r = 0; r < 16; ++r) {
    const int kc0 = crow(r, hi), kc1 = 32 + kc0;
    const bool ok0 = row_ok && ((unsigned)(kc0 - cs) < 16u), ok1 = row_ok && ((unsigned)(kc1 - cs) < 16u);
    const float b0 = rpbs[ok0 ? base + kc0 : 0], b1 = rpbs[ok1 ? base + kc1 : 0];
    p0[r] = ok0 ? p0[r] + b0 : ninf; p1[r] = ok1 ? p1[r] + b1 : ninf;
  }
}
template <bool LAT>
__device__ __forceinline__ void body(const bf16_t* __restrict__ Qb, const bf16_t* __restrict__ K0, const bf16_t* __restrict__ V0, int nt0,
                                     const bf16_t* __restrict__ K1, const bf16_t* __restrict__ V1, int NT, bf16_t* __restrict__ Ob, char* lds, int kr0, int qrb) {
  int tid_ = threadIdx.x; asm volatile("" : "+v"(tid_));
  const int tid = tid_, wid = tid >> 6, lane = tid & 63, r32 = lane & 31, hi = lane >> 5;
  char* V_lds = lds; char* K_lds = lds + 2 * SHM_V;
  float* ws = (float*)(lds + OFF_WS) + wid * 64; float* li_l = ws; float* al_l = ws + 32;
  const float* rpbs = (const float*)(lds + OFF_RPB);
  const int qr = qrb + (wid >> 1), qc = (wid & 1) * 32 + r32;
  const int rs = min(max(qr - 4, 0), 8), cs = min(max(qc - 8, 0), 48);
  float m_reg = -1e30f, l_reg = 0; f32x16 o[4] = {}; bf16x8 qreg[8];
  const bf16_t* Qw = Qb + (long)(wid * QBLK + r32) * LD + hi * 8;
#pragma unroll
  for (int d0 = 0; d0 < 8; ++d0) qreg[d0] = ld8(Qw + d0 * 16);
  const int sr = tid >> 4, sc = (tid & 15) * 8, vst0 = v_st(sr, sc), vst1 = v_st(32 + sr, sc);
  const int vb0 = (int)(uintptr_t)V_lds + v_rd_base(lane);
  struct { bf16x8 vs0, vs1, ks0, ks1; } sr_[2];
#define SLOAD(i, t) do { const int t_ = (t); const bf16_t* kp_ = (t_ < nt0) ? K0 + (long)t_ * KVBLK * LD : K1 + (long)(t_ - nt0) * KVBLK * LD; \
    const bf16_t* vp_ = (t_ < nt0) ? V0 + (long)t_ * KVBLK * LD : V1 + (long)(t_ - nt0) * KVBLK * LD; \
    sr_[i].vs0 = ld8(vp_ + (long)sr * LD + sc); sr_[i].vs1 = ld8(vp_ + (long)(32 + sr) * LD + sc); \
    sr_[i].ks0 = ld8(kp_ + (long)sr * LD + sc); sr_[i].ks1 = ld8(kp_ + (long)(32 + sr) * LD + sc); } while (0)
#define SWRITE(b, i) do { *(bf16x8*)(V_lds + (b) * SHM_V + vst0) = sr_[i].vs0;          \
    *(bf16x8*)(V_lds + (b) * SHM_V + vst1) = sr_[i].vs1; int kc = sc * 2;               \
    *(bf16x8*)(K_lds + (b) * SHM_K + KSWZ(sr, kc)) = sr_[i].ks0;                       \
    *(bf16x8*)(K_lds + (b) * SHM_K + KSWZ(32 + sr, kc)) = sr_[i].ks1; } while (0)
#define SWAIT() asm volatile("s_waitcnt vmcnt(4)" ::: "memory")
#define RESC(a) do { if (__any((a) < 1.f)) { if (hi == 0) al_l[r32] = (a); asm volatile("s_waitcnt lgkmcnt(0)" ::: "memory"); \
    _Pragma("unroll") for (int d = 0; d < 4; ++d) _Pragma("unroll") for (int r = 0; r < 16; ++r) o[d][r] *= al_l[crow(r, hi)]; } } while (0)
#define BIAS(P0, P1, t) do { if (LAT) { const int t_ = (t); if (t_ < nt0) apply_bias(P0, P1, kr0 + t_, qr, rs, qc, cs, rpbs, hi); } } while (0)
  f32x16 pA0, pA1, pB0, pB1; float mnA, mnB, alA, alB; bf16x8 pa0, pa1, pa2, pa3;
  constexpr int SE = 0, SO = 1;
  SLOAD(SE, 0); asm volatile("s_waitcnt vmcnt(0)" ::: "memory"); SWRITE(0, SE); __syncthreads();
  qkt(pA0, pA1, K_lds, qreg, r32, hi); BIAS(pA0, pA1, 0); partialSM(pA0, pA1, m_reg, mnA, alA);
  SLOAD(SO, 1); if (2 < NT) SLOAD(SE, 2);
  SWAIT(); SWRITE(1, SO); __syncthreads();
  for (int j = 1; j + 1 < NT; j += 2) {
    SBAR(); qkt(pB0, pB1, K_lds + SHM_K, qreg, r32, hi);
    finishSM(pA0, pA1, alA, l_reg, pa0, pa1, pa2, pa3); SBAR();
    SLOAD(SO, j + 2); SBAR();
    pv_d0(o, vb0, pa0, pa1, pa2, pa3); BIAS(pB0, pB1, j); partialSM(pB0, pB1, m_reg, mnB, alB);
    __syncthreads(); SWAIT(); SWRITE(0, SE);
    RESC(alB); __syncthreads();
    SBAR(); qkt(pA0, pA1, K_lds, qreg, r32, hi);
    finishSM(pB0, pB1, alB, l_reg, pa0, pa1, pa2, pa3); SBAR();
    if (j + 3 < NT) SLOAD(SE, j + 3); SBAR();
    pv_d0(o, vb0 + SHM_V, pa0, pa1, pa2, pa3); BIAS(pA0, pA1, j + 1); partialSM(pA0, pA1, m_reg, mnA, alA);
    __syncthreads(); SWAIT(); SWRITE(1, SO);
    RESC(alA); __syncthreads();
  }
  SBAR(); qkt(pB0, pB1, K_lds + SHM_K, qreg, r32, hi);
  finishSM(pA0, pA1, alA, l_reg, pa0, pa1, pa2, pa3); SBAR();
  pv_d0(o, vb0, pa0, pa1, pa2, pa3); BIAS(pB0, pB1, NT - 1); partialSM(pB0, pB1, m_reg, mnB, alB);
  __syncthreads(); RESC(alB);
  finishSM(pB0, pB1, alB, l_reg, pa0, pa1, pa2, pa3); SBAR();
  pv_d0(o, vb0 + SHM_V, pa0, pa1, pa2, pa3);
  if (hi == 0) li_l[r32] = l_reg; asm volatile("s_waitcnt lgkmcnt(0)" ::: "memory");
  float rli[16];
#pragma unroll
  for (int r = 0; r < 16; ++r) rli[r] = __builtin_amdgcn_rcpf(li_l[crow(r, hi)]);
  bf16_t* Ow = Ob + (long)(wid * QBLK) * LDO;
#pragma unroll
  for (int r = 0; r < 16; ++r) { const int orow = crow(r, hi);
#pragma unroll
    for (int d0 = 0; d0 < 4; ++d0) Ow[(long)orow * LDO + d0 * 32 + r32] = (bf16_t)(cvt_pk_bf16(o[d0][r] * rli[r], 0.f) & 0xffffu); }
#undef SLOAD
#undef SWRITE
#undef SWAIT
#undef RESC
#undef BIAS
}
}

#define XB_TMO      128
#define XB_XCNT(j)  (256  + 64 * (j))
#define XB_XSUB(j)  (1280 + 64 * (j))
#define XB_XGEN(j)  (2304 + 64 * (j))
#define XB_TOP      3328
#define XB_TOPGEN   3392
#define XCD_BAR_WORDS 3456
#define XB_SPIN_CAP (1u << 18)
__device__ __forceinline__ unsigned xb_ld(unsigned* p)              { return __hip_atomic_load(p, __ATOMIC_RELAXED, __HIP_MEMORY_SCOPE_AGENT); }
__device__ __forceinline__ unsigned xb_add(unsigned* p, unsigned v) { return __hip_atomic_fetch_add(p, v, __ATOMIC_RELAXED, __HIP_MEMORY_SCOPE_AGENT); }
__device__ __forceinline__ unsigned xb_xcc_id() { return (unsigned)__builtin_amdgcn_s_getreg((3 << 11) | 20) & 0xFu; }
#define XB_SPIN(cond, bar) do { unsigned _sp = 0; while (cond) { __builtin_amdgcn_s_sleep(1); \
    if ((++_sp & 255u) == 0u) { if (xb_ld(&(bar)[XB_TMO])) break; if (_sp > XB_SPIN_CAP) { atomicAdd(&(bar)[XB_TMO], 1u); break; } } } } while (0)
struct XcdBarrier { unsigned* bar; unsigned x; volatile LAS unsigned* st; };
__device__ __forceinline__ XcdBarrier xcd_barrier_post(unsigned* bar, volatile LAS unsigned* st) {
    XcdBarrier b; b.bar = bar; b.x = xb_xcc_id(); b.st = st;
    if (threadIdx.x == 0) (void)xb_add(&bar[XB_XCNT(b.x)], 1u);
    return b;
}
__device__ __forceinline__ void xcd_barrier_complete(unsigned* bar, unsigned x, unsigned& nloc, unsigned& nx) {
    const unsigned G = gridDim.x * gridDim.y * gridDim.z;
    unsigned sum, cnt, mine, sp = 0u;
    for (;;) {
        sum = 0u; cnt = 0u; mine = 0u;
#pragma unroll
        for (unsigned j = 0; j < 16; ++j) { const unsigned c = xb_ld(&bar[XB_XCNT(j)]); sum += c; cnt += (c > 0u) ? 1u : 0u; mine = (j == x) ? c : mine; }
        if (sum == G) break;
        __builtin_amdgcn_s_sleep(1);
        if ((++sp & 255u) == 0u) { if (xb_ld(&bar[XB_TMO])) break; if (sp > XB_SPIN_CAP) { atomicAdd(&bar[XB_TMO], 1u); break; } }
    }
    nloc = mine > 0u ? mine : 1u; nx = cnt > 0u ? cnt : 1u;
}
__device__ __forceinline__ void xcd_barrier(const XcdBarrier& b) {
    asm volatile("s_waitcnt vmcnt(0)" ::: "memory");
    __syncthreads();
    if (threadIdx.x == 0) {
        unsigned* bar = b.bar;
        __builtin_amdgcn_s_waitcnt(0);
        unsigned nloc = b.st[0], nx = b.st[1];
        if (nloc == 0u) { xcd_barrier_complete(bar, b.x, nloc, nx); b.st[0] = nloc; b.st[1] = nx; }
        const unsigned old = xb_add(&bar[XB_XSUB(b.x)], 1u);
        const unsigned gen = old / nloc;
        if (old + 1u == (gen + 1u) * nloc) {
            __builtin_amdgcn_fence(__ATOMIC_RELEASE, "agent");
            asm volatile("s_waitcnt vmcnt(0)" ::: "memory");
            const unsigned og = xb_add(&bar[XB_TOP], 1u);
            const unsigned tg = og / nx;
            if (og + 1u == (tg + 1u) * nx) xb_add(&bar[XB_TOPGEN], 1u);
            else XB_SPIN(xb_ld(&bar[XB_TOPGEN]) == tg, bar);
            __builtin_amdgcn_fence(__ATOMIC_ACQUIRE, "agent");
            xb_add(&bar[XB_XGEN(b.x)], 1u);
            asm volatile("s_waitcnt vmcnt(0)" ::: "memory");
        } else {
            XB_SPIN(xb_ld(&bar[XB_XGEN(b.x)]) == gen, bar);
            __builtin_amdgcn_fence(__ATOMIC_ACQUIRE, "agent");
            asm volatile("s_waitcnt vmcnt(0)" ::: "memory");
        }
    }
    __syncthreads();
}

struct Args { const float* in[23]; float* out; unsigned char* ws; int ph_lo, ph_hi; };
enum { I_XP = 0, I_XS, I_CK, I_CV, I_C, I_CCTX, I_WADA, I_BADA, I_GPREMIX, I_GPOSTMIX, I_GPREMLP, I_GPOSTMLP, I_WIN, I_RPB, I_GSGU, I_WSP, I_BSP, I_WBRA, I_WBRF, I_WBRC, I_WOUT, I_W1, I_W2 };
constexpr int NPRE = 2, NLP = 10, NPH = NPRE + DEPTH * NLP;

struct Frame {
    LAS unsigned char* lds; char* ldsg;
    int tid, lane, wave, G, bx;
};
typedef const __attribute__((address_space(4))) Args* KArgs;
__device__ __forceinline__ KArgs kargs() { KArgs p = (KArgs)__builtin_amdgcn_kernarg_segment_ptr(); asm volatile("" : "+s"(p)); return p; }
__device__ __forceinline__ int fresh_tid() { int t = threadIdx.x; asm volatile("" : "+v"(t)); return t; }
__device__ __forceinline__ void refresh(Frame& F) { F.tid = fresh_tid(); F.lane = F.tid & 63; F.wave = __builtin_amdgcn_readfirstlane(F.tid >> 6); int g = gridDim.x, b = blockIdx.x; asm volatile("" : "+s"(g), "+s"(b)); F.G = g; F.bx = b; }

__device__ __forceinline__ void tr_item(const float* W, int N, bf16_t* WT, int ldt, int koff, LAS float* scr, int item, int lane) {
    const int nblk = N / 32, kb = item / nblk, nb = item % nblk, k0 = 64 * kb, n0 = 32 * nb;
#pragma unroll 8
    for (int i = 0; i < 32; ++i) { const int kk = 2 * i + (lane >> 5); scr[kk * 33 + (lane & 31)] = W[(size_t)(k0 + kk) * N + n0 + (lane & 31)]; }
    LDS_WAIT(); asm volatile("" ::: "memory");
    const int c = lane & 7;
#pragma unroll
    for (int j = 0; j < 4; ++j) { const int n = (lane >> 3) + 8 * j; const LAS float* s = scr + (8 * c) * 33 + n;
        u32x4 o; o.x = cvt_pk_bf16(s[0 * 33], s[1 * 33]); o.y = cvt_pk_bf16(s[2 * 33], s[3 * 33]); o.z = cvt_pk_bf16(s[4 * 33], s[5 * 33]); o.w = cvt_pk_bf16(s[6 * 33], s[7 * 33]);
        *(u32x4*)(WT + (size_t)(n0 + n) * ldt + koff + k0 + 8 * c) = o; }
    LDS_WAIT(); asm volatile("" ::: "memory");
}
__device__ __forceinline__ bf16_t f2bf(float v) { return (bf16_t)(cvt_pk_bf16(v, 0.f) & 0xffffu); }

__device__ __forceinline__ void p0_weights(Frame& F) {
    refresh(F); KArgs A = kargs(); unsigned char* ws = A->ws;
    LAS float* scr = (LAS float*)(F.lds + F.wave * 16384);
    const int gw = F.bx * 8 + F.wave, NGW = F.G * 8;
    constexpr int I_IN = 32 * 336, I_BA = 16 * 64, I_BF = 8 * 64, I_BC = 8 * 64, I_OUT = 32 * 64, I_1 = 32 * 256, I_2 = 128 * 64, NPL = I_IN + I_BA + I_BF + I_BC + I_OUT + I_1 + I_2;
    for (int it = gw; it < DEPTH * NPL; it += NGW) {
        const int l = it / NPL; int r = it % NPL;
        const float* W; int N; bf16_t* WT; int ldt = D, koff = 0;
        if (r < I_IN) { W = A->in[I_WIN] + (size_t)l * D * IN_W; N = IN_W; WT = (bf16_t*)(ws + WS_WIN + l * SZ_WIN); }
        else if ((r -= I_IN) < I_BA) { W = A->in[I_WBRA] + (size_t)l * 1024 * D; N = D; WT = (bf16_t*)(ws + WS_WBR + l * SZ_WSQ); }
        else if ((r -= I_BA) < I_BF) { W = A->in[I_WBRF] + (size_t)l * 512 * D; N = D; WT = (bf16_t*)(ws + WS_WBR + l * SZ_WSQ); koff = 1024; }
        else if ((r -= I_BF) < I_BC) { W = A->in[I_WBRC] + (size_t)l * 512 * D; N = D; WT = (bf16_t*)(ws + WS_WBR + l * SZ_WSQ); koff = 1536; }
        else if ((r -= I_BC) < I_OUT) { W = A->in[I_WOUT] + (size_t)l * D * D; N = D; WT = (bf16_t*)(ws + WS_WOUT + l * SZ_WSQ); }
        else if ((r -= I_OUT) < I_1) { W = A->in[I_W1] + (size_t)l * D * D_FF; N = D_FF; WT = (bf16_t*)(ws + WS_W1 + l * SZ_W1); }
        else { r -= I_1; W = A->in[I_W2] + (size_t)l * D_FF * D; N = D; WT = (bf16_t*)(ws + WS_W2 + l * SZ_W2); ldt = LDF; }
        tr_item(W, N, WT, ldt, koff, scr, r, F.lane);
    }
}
__device__ __forceinline__ void p0_tables(Frame& F) {
    refresh(F); KArgs A = kargs(); unsigned char* ws = A->ws;
    const int gt = F.bx * 512 + F.tid, GT = F.G * 512;
    bf16_t* tw256 = (bf16_t*)(ws + WS_TW256); bf16_t* tw1024 = (bf16_t*)(ws + WS_TW1024); bf16_t* wf = (bf16_t*)(ws + WS_WF);
    for (int i = gt; i < 256 * 512; i += GT) { const int k1 = i >> 9, cc = i & 511, n = cc & 255, ph = (k1 * n) & 255; const float a = (float)ph * (1.0f / 256.0f);
        tw256[i] = f2bf(cc < 256 ? __builtin_amdgcn_cosf(a) : -__builtin_amdgcn_sinf(a)); }
    for (int i = gt; i < 1024 * 2048; i += GT) { const int k1 = i >> 11, cc = i & 2047, n = cc & 1023, ph = (k1 * n) & 1023; const float a = (float)ph * (1.0f / 1024.0f);
        tw1024[i] = f2bf(cc < 1024 ? __builtin_amdgcn_cosf(a) : -__builtin_amdgcn_sinf(a)); }
    for (int i = gt; i < 1024 * 512; i += GT) { const int m = i >> 9, cc = i & 511, g = m >> 8, j = (m >> 7) & 1, k2 = m & 127, g2 = cc >> 7, n2 = cc & 127, ph = (k2 * n2) & 127; const float a = (float)ph * (1.0f / 128.0f);
        wf[i] = f2bf((g == g2) ? (j ? __builtin_amdgcn_sinf(a) : __builtin_amdgcn_cosf(a)) : 0.f); }
    { const f32x4* s = (const f32x4*)A->in[I_WSP]; u32x4* d = (u32x4*)(ws + WS_WSP);
      for (int i = gt; i < 4 * 4 * 128 * 128 / 8; i += GT) d[i] = pg8::pack8(s[2 * i], s[2 * i + 1]); }
    { const f32x4* s = (const f32x4*)A->in[I_CK]; u32x4* d = (u32x4*)(ws + WS_CK);
      for (int i = gt; i < 2 * 4 * 512 * 1024 / 8; i += GT) d[i] = pg8::pack8(s[2 * i], s[2 * i + 1]); }
    { const f32x4* s = (const f32x4*)A->in[I_CV]; u32x4* d = (u32x4*)(ws + WS_CV);
      for (int i = gt; i < 2 * 4 * 512 * 1024 / 8; i += GT) d[i] = pg8::pack8(s[2 * i], s[2 * i + 1]); }
}
__device__ __forceinline__ void p0_mod(Frame& F) {
    refresh(F); KArgs A = kargs();
    __syncthreads();
    LAS float* sv = (LAS float*)F.lds;
    LAS float* red = (LAS float*)(F.lds + 32768);
    { const float* cc = A->in[I_CCTX]; const float* c = A->in[I_C];
      for (int i = F.tid; i < 3 * D; i += 512) { const int v = i >> 11, k = i & 2047; const float x = v == 0 ? cc[k] : c[(v - 1) * D + k]; sv[i] = x * __builtin_amdgcn_rcpf(1.0f + __expf(-x)); } }
    __syncthreads();
    float* MOD = (float*)(A->ws + WS_MOD); const float* wada = A->in[I_WADA]; const float* bada = A->in[I_BADA];
    for (int item = F.bx; item < DEPTH * 192; item += F.G) {
        const int l = item / 192, j0 = (item % 192) * 64;
        const float* W = wada + (size_t)l * D * 12288 + j0 + (F.lane & 15) * 4;
        const int kbase = F.wave * 256 + (F.lane >> 4);
        f32x4 a0 = {0.f, 0.f, 0.f, 0.f}, a1 = a0, a2 = a0;
#pragma unroll 8
        for (int i = 0; i < 64; ++i) { const int k = kbase + 4 * i; const f32x4 w = *(const f32x4*)(W + (size_t)k * 12288);
            a0 += w * sv[k]; a1 += w * sv[D + k]; a2 += w * sv[2 * D + k]; }
#pragma unroll
        for (int e = 0; e < 4; ++e) { a0[e] += shx(a0[e], 16, F.lane); a0[e] += shx(a0[e], 32, F.lane); a1[e] += shx(a1[e], 16, F.lane); a1[e] += shx(a1[e], 32, F.lane); a2[e] += shx(a2[e], 16, F.lane); a2[e] += shx(a2[e], 32, F.lane); }
        if (F.lane < 16) { *(LAS f32x4*)(red + (F.wave * 3 + 0) * 64 + F.lane * 4) = a0; *(LAS f32x4*)(red + (F.wave * 3 + 1) * 64 + F.lane * 4) = a1; *(LAS f32x4*)(red + (F.wave * 3 + 2) * 64 + F.lane * 4) = a2; }
        __syncthreads();
        if (F.tid < 192) { const int v = F.tid >> 6, jj = F.tid & 63; float s = bada[l * 12288 + j0 + jj];
#pragma unroll
            for (int w = 0; w < 8; ++w) s += red[(w * 3 + v) * 64 + jj];
            MOD[(size_t)(l * 3 + v) * 12288 + j0 + jj] = s; }
        __syncthreads();
    }
}

__device__ __forceinline__ int mod_index(int m) { return m < M_CTX ? 0 : 1 + ((m - M_CTX) >> 10); }
__device__ __forceinline__ void load_row_f32(f32x4 (&v)[8], const float* row, int lane) {
#pragma unroll
    for (int j = 0; j < 4; ++j) { const f32x4* p = (const f32x4*)(row + 8 * (lane + 64 * j)); v[2 * j] = p[0]; v[2 * j + 1] = p[1]; }
}
__device__ __forceinline__ void store_row_f32(float* row, const f32x4 (&v)[8], int lane) {
#pragma unroll
    for (int j = 0; j < 4; ++j) { f32x4* p = (f32x4*)(row + 8 * (lane + 64 * j)); p[0] = v[2 * j]; p[1] = v[2 * j + 1]; }
}
__device__ __forceinline__ void norm_mod_store(const f32x4 (&v)[8], float rstd, const float* g, const float* sc, const float* sh, bf16_t* hrow, int lane) {
#pragma unroll
    for (int j = 0; j < 4; ++j) { const int c = 8 * (lane + 64 * j);
        f32x4 h[2];
#pragma unroll
        for (int e = 0; e < 2; ++e) { const f32x4 gg = *(const f32x4*)(g + c + 4 * e), s1 = *(const f32x4*)(sc + c + 4 * e), s0 = *(const f32x4*)(sh + c + 4 * e); h[e] = v[2 * j + e] * rstd * gg * (1.0f + s1) + s0; }
        *(u32x4*)(hrow + c) = pg8::pack8(h[0], h[1]); }
}
__device__ __forceinline__ float sumsq8(const f32x4 (&v)[8], int lane) {
    float s = 0.f;
#pragma unroll
    for (int j = 0; j < 8; ++j) s += (v[j][0] * v[j][0] + v[j][1] * v[j][1]) + (v[j][2] * v[j][2] + v[j][3] * v[j][3]);
    return wave_sum(s, lane);
}
__device__ __forceinline__ void p1_norm0(Frame& F) {
    refresh(F); KArgs A = kargs();
    const int gw = F.bx * 8 + F.wave, NGW = F.G * 8;
    const float* MOD = (const float*)(A->ws + WS_MOD); bf16_t* H = (bf16_t*)(A->ws + WS_H);
    const float* xp = A->in[I_XP]; const float* xs = A->in[I_XS]; const float* gpm = A->in[I_GPREMIX];
    for (int m = gw; m < M; m += NGW) {
        const float* src = m < M_CTX ? xp + (size_t)m * D : xs + (size_t)(m - M_CTX) * D;
        f32x4 v[8]; load_row_f32(v, src, F.lane);
        const float rstd = __builtin_amdgcn_rsqf(sumsq8(v, F.lane) * (1.0f / D) + RMS_EPS);
        const float* mv = MOD + (size_t)mod_index(m) * 12288;
        norm_mod_store(v, rstd, gpm, mv + 1 * D, mv + 0 * D, H + (size_t)m * D, F.lane);
    }
}
__device__ __forceinline__ void load_y(f32x4 (&y)[8], int m, const bf16_t* MIXB, const bf16_t* SLAB, int lane) {
    if (m < M_CTX) {
        const bf16_t* r = MIXB + (size_t)m * D;
#pragma unroll
        for (int j = 0; j < 4; ++j) { const u32x4 w = *(const u32x4*)(r + 8 * (lane + 64 * j));
            y[2 * j] = (f32x4){bflo(w.x), bfhi(w.x), bflo(w.y), bfhi(w.y)}; y[2 * j + 1] = (f32x4){bflo(w.z), bfhi(w.z), bflo(w.w), bfhi(w.w)}; }
    } else {
        const bf16_t* r = SLAB + (size_t)(m - M_CTX) * D;
        u32x4 w[4][4];
#pragma unroll
        for (int q = 0; q < 4; ++q)
#pragma unroll
            for (int j = 0; j < 4; ++j) w[q][j] = *(const u32x4*)(r + (size_t)q * M_LAT * D + 8 * (lane + 64 * j));
#pragma unroll
        for (int j = 0; j < 4; ++j) { f32x4 a = {0.f, 0.f, 0.f, 0.f}, b = a;
#pragma unroll
            for (int q = 0; q < 4; ++q) { const u32x4 v = w[q][j]; a = a + (f32x4){bflo(v.x), bfhi(v.x), bflo(v.y), bfhi(v.y)}; b = b + (f32x4){bflo(v.z), bfhi(v.z), bflo(v.w), bfhi(v.w)}; }
            y[2 * j] = a; y[2 * j + 1] = b; }
    }
}
__device__ __forceinline__ void load_x(f32x4 (&x)[8], int m, bool from_input, const float* xp, const float* xs, const bf16_t* XB, int lane) {
    if (from_input) load_row_f32(x, m < M_CTX ? xp + (size_t)m * D : xs + (size_t)(m - M_CTX) * D, lane);
    else { const bf16_t* r = XB + (size_t)m * D;
#pragma unroll
        for (int j = 0; j < 4; ++j) { const u32x4 w = *(const u32x4*)(r + 8 * (lane + 64 * j));
            x[2 * j] = (f32x4){bflo(w.x), bfhi(w.x), bflo(w.y), bfhi(w.y)}; x[2 * j + 1] = (f32x4){bflo(w.z), bfhi(w.z), bflo(w.w), bfhi(w.w)}; } }
}
__device__ __forceinline__ void thin_phase(Frame& F, int i_gpost, int l, int gate_off, int i_gnext, int ln, int sc_off, int sh_off, bool x_from_input, bool x_to_output) {
    refresh(F); KArgs A = kargs();
    const int gw = F.bx * 8 + F.wave, NGW = F.G * 8;
    bf16_t* H = (bf16_t*)(A->ws + WS_H); const bf16_t* MIXB = (const bf16_t*)(A->ws + WS_MIXB); const bf16_t* SLAB = (const bf16_t*)(A->ws + WS_SLAB); float* out = A->out;
    bf16_t* XB = (bf16_t*)(A->ws + WS_XB); const float* xp = A->in[I_XP]; const float* xs = A->in[I_XS];
    const bool has_next = i_gnext >= 0;
    LAS float* V = (LAS float*)F.lds;
    {
        const float* g_post = A->in[i_gpost] + l * D; const float* modc = (const float*)(A->ws + WS_MOD) + (size_t)l * 3 * 12288;
        const float* g_next = has_next ? A->in[i_gnext] + ln * D : g_post; const float* modn = (const float*)(A->ws + WS_MOD) + (size_t)ln * 3 * 12288;
        for (int i = F.tid; i < 3 * (D / 4); i += 512) { const int mi = i / (D / 4), c = (i % (D / 4)) * 4;
            const f32x4 gp = *(const f32x4*)(g_post + c), gt = *(const f32x4*)(modc + (size_t)mi * 12288 + gate_off + c);
            const f32x4 gn = *(const f32x4*)(g_next + c), sc = *(const f32x4*)(modn + (size_t)mi * 12288 + sc_off + c), sh = *(const f32x4*)(modn + (size_t)mi * 12288 + sh_off + c);
            *(LAS f32x4*)(V + (mi * 3 + 0) * D + c) = gt * gp; *(LAS f32x4*)(V + (mi * 3 + 1) * D + c) = gn * (1.0f + sc); *(LAS f32x4*)(V + (mi * 3 + 2) * D + c) = sh; }
        __syncthreads();
    }
    f32x4 xa[8], ya[8], xb[8], yb[8];
    int m = gw;
    if (m < M) { load_x(xa, m, x_from_input, xp, xs, XB, F.lane); load_y(ya, m, MIXB, SLAB, F.lane); }
#define THIN_ROW(X, Y, mm) do { const LAS float* vv = V + mod_index(mm) * 3 * D; \
        const float r1 = __builtin_amdgcn_rsqf(sumsq8(Y, F.lane) * (1.0f / D) + RMS_EPS); \
        _Pragma("unroll") for (int j = 0; j < 4; ++j) _Pragma("unroll") for (int e = 0; e < 2; ++e) { const int c = 8 * (F.lane + 64 * j) + 4 * e; \
            X[2 * j + e] = X[2 * j + e] + *(const LAS f32x4*)(vv + c) * (Y[2 * j + e] * r1); } \
        if (x_to_output) store_row_f32(out + (size_t)(mm) * D, X, F.lane); \
        else { bf16_t* xr = XB + (size_t)(mm) * D; _Pragma("unroll") for (int j = 0; j < 4; ++j) *(u32x4*)(xr + 8 * (F.lane + 64 * j)) = pg8::pack8(X[2 * j], X[2 * j + 1]); } \
        if (has_next) { const float r2 = __builtin_amdgcn_rsqf(sumsq8(X, F.lane) * (1.0f / D) + RMS_EPS); bf16_t* hrow = H + (size_t)(mm) * D; \
            _Pragma("unroll") for (int j = 0; j < 4; ++j) { const int c = 8 * (F.lane + 64 * j); \
                const f32x4 h0 = X[2 * j] * r2 * *(const LAS f32x4*)(vv + D + c) + *(const LAS f32x4*)(vv + 2 * D + c); \
                const f32x4 h1 = X[2 * j + 1] * r2 * *(const LAS f32x4*)(vv + D + c + 4) + *(const LAS f32x4*)(vv + 2 * D + c + 4); \
                *(u32x4*)(hrow + c) = pg8::pack8(h0, h1); } } } while (0)
    while (m < M) {
        const int m1 = m + NGW;
        if (m1 < M) { load_x(xb, m1, x_from_input, xp, xs, XB, F.lane); load_y(yb, m1, MIXB, SLAB, F.lane); }
        THIN_ROW(xa, ya, m);
        if (m1 >= M) break;
        const int m2 = m1 + NGW;
        if (m2 < M) { load_x(xa, m2, x_from_input, xp, xs, XB, F.lane); load_y(ya, m2, MIXB, SLAB, F.lane); }
        THIN_ROW(xb, yb, m1);
        m = m2;
    }
#undef THIN_ROW
    __syncthreads();
}
__device__ __forceinline__ void merge_latent(Frame& F) {
    refresh(F); KArgs A = kargs();
    const bf16_t* SLAB = (const bf16_t*)(A->ws + WS_SLAB); bf16_t* MRG = (bf16_t*)(A->ws + WS_MRG) + (size_t)M_CTX * D;
    for (int i = F.bx * 512 + F.tid; i < M_LAT * D / 8; i += F.G * 512) {
        f32x4 a = {0.f, 0.f, 0.f, 0.f}, b = a;
#pragma unroll
        for (int q = 0; q < 4; ++q) { const u32x4 v = ((const u32x4*)(SLAB + (size_t)q * M_LAT * D))[i]; a = a + (f32x4){bflo(v.x), bfhi(v.x), bflo(v.y), bfhi(v.y)}; b = b + (f32x4){bflo(v.z), bfhi(v.z), bflo(v.w), bfhi(v.w)}; }
        ((u32x4*)MRG)[i] = pg8::pack8(a, b);
    }
}

__device__ __forceinline__ void sg_unit(Frame& F, KArgs A, int l, int unit) {
    const int c = unit >> 2, g = unit & 3, row0 = c * 128;
    const bf16_t* P2 = (const bf16_t*)(A->ws + WS_P2); bf16_t* OBR = (bf16_t*)(A->ws + WS_OBR);
    LAS bf16_t* vT = (LAS bf16_t*)F.lds;
    {
        const int pos = F.tid >> 2, d0 = (F.tid & 3) * 32;
        const bf16_t* vp = P2 + (size_t)(row0 + pos) * P2W + P2_V + g * 128 + d0;
        u32x4 w[4];
#pragma unroll
        for (int i = 0; i < 4; ++i) w[i] = ((const u32x4*)vp)[i];
        float v[32];
#pragma unroll
        for (int i = 0; i < 4; ++i)
#pragma unroll
            for (int e = 0; e < 4; ++e) { v[i * 8 + e * 2] = bflo(w[i][e]); v[i * 8 + e * 2 + 1] = bfhi(w[i][e]); }
        float ss = 0.f;
#pragma unroll
        for (int i = 0; i < 32; ++i) ss += v[i] * v[i];
        ss += shx(ss, 1, F.lane); ss += shx(ss, 2, F.lane);
        const float rstd = __builtin_amdgcn_rsqf(ss * (1.0f / 128.0f) + RMS_EPS);
        const float* gs = A->in[I_GSGU] + (l * 4 + g) * 128 + d0;
#pragma unroll
        for (int i = 0; i < 32; ++i) vT[(d0 + i) * 136 + pos] = f2bf(v[i] * rstd * gs[i]);
    }
    __syncthreads();
    {
        const int fr = F.lane & 15, quad = F.lane >> 4, pcol = F.wave * 16 + fr;
        const bf16_t* wp = (const bf16_t*)(A->ws + WS_WSP) + ((size_t)(l * 4 + g) * 128 + pcol) * 128 + quad * 8;
        bf16x8 bfr[4];
#pragma unroll
        for (int kk = 0; kk < 4; ++kk) bfr[kk] = *(const bf16x8*)(wp + kk * 32);
        f32x4 acc[8];
#pragma unroll
        for (int dt = 0; dt < 8; ++dt) { acc[dt] = (f32x4){0.f, 0.f, 0.f, 0.f};
#pragma unroll
            for (int kk = 0; kk < 4; ++kk) { const bf16x8 afr = *(const LAS bf16x8*)(vT + (dt * 16 + fr) * 136 + kk * 32 + quad * 8);
                acc[dt] = __builtin_amdgcn_mfma_f32_16x16x32_bf16(afr, bfr[kk], acc[dt], 0, 0, 0); } }
        const float bias = A->in[I_BSP][(l * 4 + g) * 128 + pcol];
        const bf16_t* up = P2 + (size_t)(row0 + pcol) * P2W + P2_U + g * 128 + quad * 4;
        bf16_t* op = OBR + (size_t)(row0 + pcol) * D + OB_C + g * 128 + quad * 4;
#pragma unroll
        for (int dt = 0; dt < 8; ++dt) { const u32x2 uw = *(const u32x2*)(up + dt * 16);
            u32x2 o; o.x = cvt_pk_bf16(bflo(uw.x) * (acc[dt][0] + bias), bfhi(uw.x) * (acc[dt][1] + bias)); o.y = cvt_pk_bf16(bflo(uw.y) * (acc[dt][2] + bias), bfhi(uw.y) * (acc[dt][3] + bias));
            *(u32x2*)(op + dt * 16) = o; }
    }
    __syncthreads();
}

__global__ void __launch_bounds__(512, 2) fwd(Args args) {
    extern __shared__ __attribute__((aligned(16))) unsigned char lds[];
    Frame F;
    F.lds = (LAS unsigned char*)lds; F.ldsg = (char*)lds;
    refresh(F);
    volatile LAS unsigned* MISC = (volatile LAS unsigned*)(F.lds + MISC_OFF);
    for (int u = F.tid; u < (LDS_BYTES - RING_BYTES) / 4; u += 512) ((LAS unsigned*)(F.lds + RING_BYTES))[u] = 0u;
    __syncthreads();
    const int lo = args.ph_lo, hi = args.ph_hi;
    XcdBarrier bar; bar.bar = (unsigned*)(args.ws + WS_CTL) + CW_BAR; bar.x = 0; bar.st = nullptr;
    if (hi - lo > 1) bar = xcd_barrier_post((unsigned*)(args.ws + WS_CTL) + CW_BAR, MISC + 8);
#define IN(p) (lo <= (p) && (p) < hi)
#define SEAM(p) do { if ((p) + 1 < hi) { XcdBarrier b_ = bar; asm volatile("" : "+s"(b_.bar)); xcd_barrier(b_); } } while (0)

    if (IN(0)) { p0_weights(F); p0_tables(F); p0_mod(F); SEAM(0); }
    if (IN(1)) { p1_norm0(F); SEAM(1); }

    for (int l = 0; l < DEPTH; ++l) {
        const int pb = NPRE + l * NLP;
        if (pb + NLP <= lo || pb >= hi) continue;
        if (IN(pb + 0)) {
            refresh(F); KArgs A = kargs(); unsigned char* ws = A->ws;
            pg8::Dims g{D, D, D}; pg8::TileOrder S; S.init(ws + WS_H, D, ws + WS_WIN + l * SZ_WIN, D, M, IN_W, D, F.G, F.bx);
            pg8::EpiProj E{(bf16_t*)(ws + WS_QKV), (bf16_t*)(ws + WS_P2), A->out + OUT_CK + (size_t)l * 256 * 1024, A->out + OUT_CV + (size_t)l * 256 * 1024};
            pg8::gemm_phase<pg8::EpiProj, pg8::TileOrder, true>(F.lds, g, S, E);
            SEAM(pb + 0);
        }
        if (IN(pb + 1)) {
            refresh(F); KArgs A = kargs(); unsigned char* ws = A->ws;
            pg8::Dims g{512, P2W, 512}; pg8::TileOrder S; S.init(ws + WS_WF, 512, (bf16_t*)(ws + WS_P2) + P2_F, P2W, 1024, M, 512, F.G, F.bx);
            pg8::EpiTT E{(bf16_t*)(ws + WS_TT), (bf16_t*)(ws + WS_TTL)};
            pg8::gemm_phase<pg8::EpiTT, pg8::TileOrder, true>(F.lds, g, S, E);
            SEAM(pb + 1);
        }
        if (IN(pb + 2)) {
            {
                refresh(F); KArgs A = kargs(); unsigned char* ws = A->ws;
                pg8::Dims g{2048, 2048, 2048};
                pg8::BatchOrder S{(const char*)(ws + WS_TW1024), (const char*)(ws + WS_TTL), (size_t)256 * 2048 * 2, (size_t)256 * 2048 * 2, (size_t)512 * 2048 * 2, 4, 2, 2, F.G, F.bx < 16 ? F.bx : -1, 32, 32};
                pg8::EpiFour2 E{(bf16_t*)(ws + WS_OBR), 0.00276213586400995f};
                pg8::gemm_phase<pg8::EpiFour2, pg8::BatchOrder, true>(F.lds, g, S, E);
            }
            {
                refresh(F); KArgs A = kargs(); unsigned char* ws = A->ws;
                pg8::Dims g{512, 512, 512};
                pg8::BatchOrder S{(const char*)(ws + WS_TW256), (const char*)(ws + WS_TT), (size_t)256 * 512 * 2, (size_t)256 * 512 * 2, (size_t)512 * 512 * 2, 1, 2, 32, F.G, F.bx >= 192 ? F.bx - 192 : -1, 0, 8};
                pg8::EpiFour2 E{(bf16_t*)(ws + WS_OBR), 0.005524271728019903f};
                pg8::gemm_phase<pg8::EpiFour2, pg8::BatchOrder, true>(F.lds, g, S, E);
            }
            {
                refresh(F); KArgs A = kargs(); unsigned char* ws = A->ws;
                const bf16_t* QKV = (const bf16_t*)(ws + WS_QKV); bf16_t* OBR = (bf16_t*)(ws + WS_OBR);
                const int u0 = F.bx < 160 ? 2 * (F.bx - 80) : F.bx, nu = F.bx < 80 ? 0 : (F.bx < 160 ? 2 : 1);
                for (int k = 0; k < nu; ++k) {
                    const int u = u0 + k, b = u >> 3, h = u & 7;
                    const bf16_t* Qb = QKV + (size_t)(b * 256) * 1024 + h * 128;
                    __syncthreads();
                    att::body<false>(Qb, Qb + (size_t)M * 1024, Qb + (size_t)2 * M * 1024, 4, nullptr, nullptr, 4, OBR + (size_t)(b * 256) * D + OB_A + h * 128, F.ldsg, 0, 0);
                }
            }
            {
                refresh(F); KArgs A = kargs(); unsigned char* ws = A->ws;
                const bf16_t* QKV = (const bf16_t*)(ws + WS_QKV); bf16_t* OBR = (bf16_t*)(ws + WS_OBR);
                if (F.bx >= 16 && F.bx < 80) {
                    const int u = F.bx - 16, j = u & 3, h = (u >> 2) & 7, b = u >> 5;
                    const int kr0 = j == 0 ? 0 : (j == 1 ? 0 : (j == 2 ? 4 : 8)), nt0 = (j == 0 || j == 3) ? 8 : 12;
                    __syncthreads();
                    { const int t = fresh_tid(); if (t < 465) ((float*)(F.ldsg + att::OFF_RPB))[t] = A->in[I_RPB][(l * 8 + h) * 465 + t] * (1.0f / att::SCALE); }
                    __syncthreads();
                    const size_t r0 = (size_t)M_CTX + b * 1024;
                    const bf16_t* Qb = QKV + (r0 + 256 * j) * 1024 + h * 128;
                    const bf16_t* K0 = QKV + (size_t)M * 1024 + (r0 + kr0 * 64) * 1024 + h * 128;
                    const bf16_t* K1 = (const bf16_t*)(ws + WS_CK) + ((size_t)(b * 4 + l) * 512) * 1024 + h * 128;
                    const bf16_t* V1 = (const bf16_t*)(ws + WS_CV) + ((size_t)(b * 4 + l) * 512) * 1024 + h * 128;
                    att::body<true>(Qb, K0, K0 + (size_t)M * 1024, nt0, K1, V1, nt0 + 8, OBR + (r0 + 256 * j) * D + OB_A + h * 128, F.ldsg, kr0, 4 * j);
                }
                __syncthreads();
            }
            {
                refresh(F); KArgs A = kargs();
                const int u0 = F.bx < 160 ? 2 * (F.bx - 80) : 160 + 5 * (F.bx - 160), nu = F.bx < 80 ? 0 : (F.bx < 160 ? 2 : (F.bx < 192 ? 5 : 0));
                for (int k = 0; k < nu; ++k) sg_unit(F, A, l, u0 + k);
            }
            SEAM(pb + 2);
        }
        if (IN(pb + 3)) {
            refresh(F); KArgs A = kargs(); unsigned char* ws = A->ws;
            pg8::Dims g{D, D, D};
            typedef pg8::BalOrder<3, 16, 24, 32> BO3; BO3 S{(const char*)(ws + WS_OBR), (const char*)(ws + WS_WBR + l * SZ_WSQ), (size_t)256 * D * 2, (size_t)256 * D * 2, F.bx, 8, (F.bx >> 3) & 3};
            pg8::EpiBranch E{(const bf16_t*)(ws + WS_P2), (bf16_t*)(ws + WS_MRG), (bf16_t*)(ws + WS_SLAB)};
            pg8::gemm_phase<pg8::EpiBranch, BO3, true>(F.lds, g, S, E);
            SEAM(pb + 3);
        }
        if (IN(pb + 4)) { merge_latent(F); SEAM(pb + 4); }
        if (IN(pb + 5)) {
            refresh(F); KArgs A = kargs(); unsigned char* ws = A->ws;
            pg8::Dims g{D, D, D};
            typedef pg8::BalOrder<1, 32, 0, 0> BO1; BO1 S{(const char*)(ws + WS_MRG), (const char*)(ws + WS_WOUT + l * SZ_WSQ), (size_t)256 * D * 2, (size_t)256 * D * 2, F.bx, 8, (F.bx >> 3) & 1};
            pg8::EpiOut E{(bf16_t*)(ws + WS_MIXB), (bf16_t*)(ws + WS_SLAB)};
            pg8::gemm_phase<pg8::EpiOut, BO1, true>(F.lds, g, S, E);
            SEAM(pb + 5);
        }
        if (IN(pb + 6)) {
            thin_phase(F, I_GPOSTMIX, l, 2 * D, I_GPREMLP, l, 4 * D, 3 * D, l == 0, false);
            SEAM(pb + 6);
        }
        if (IN(pb + 7)) {
            refresh(F); KArgs A = kargs(); unsigned char* ws = A->ws;
            pg8::Dims g{D, D, D}; pg8::TileOrder S; S.init(ws + WS_H, D, ws + WS_W1 + l * SZ_W1, D, M, D_FF, D, F.G, F.bx);
            pg8::EpiRelu2 E{(bf16_t*)(ws + WS_FF1), LDF}; pg8::gemm_phase<pg8::EpiRelu2, pg8::TileOrder, true>(F.lds, g, S, E);
            SEAM(pb + 7);
        }
        if (IN(pb + 8)) {
            refresh(F); KArgs A = kargs(); unsigned char* ws = A->ws;
            pg8::Dims g{LDF, LDF, D_FF};
            typedef pg8::BalOrder<1, 128, 0, 0> BO1; BO1 S{(const char*)(ws + WS_FF1), (const char*)(ws + WS_W2 + l * SZ_W2), (size_t)256 * LDF * 2, (size_t)256 * LDF * 2, F.bx, 32, (F.bx >> 3) & 1};
            pg8::EpiOut E{(bf16_t*)(ws + WS_MIXB), (bf16_t*)(ws + WS_SLAB)};
            pg8::gemm_phase<pg8::EpiOut, BO1, true>(F.lds, g, S, E);
            SEAM(pb + 8);
        }
        if (IN(pb + 9)) {
            const bool nx = l + 1 < DEPTH;
            thin_phase(F, I_GPOSTMLP, l, 5 * D, nx ? I_GPREMIX : -1, nx ? l + 1 : l, 1 * D, 0, false, !nx);
            SEAM(pb + 9);
        }
    }
#undef IN
#undef SEAM
}

extern "C" void kernel_launch(void* const* d_in, const int* in_sizes, int n_in, void* d_out, int out_size, void* d_ws, size_t ws_size, hipStream_t stream) {
    static int grid = 0;
    if (grid == 0) {
        if (n_in != 23 || out_size != (int)(OUT_CV + (size_t)32 * 4 * 256 * 1024) || ws_size < WS_END) {
            fprintf(stderr, "kernel_launch: shape mismatch: n_in %d out %d ws %zu (need %zu); nothing launched\n", n_in, out_size, ws_size, (size_t)WS_END); grid = -1; return; }
        int dev = 0, cus = 0, per_cu = 0;
        if (hipGetDevice(&dev) != hipSuccess || hipDeviceGetAttribute(&cus, hipDeviceAttributeMultiprocessorCount, dev) != hipSuccess) { fprintf(stderr, "kernel_launch: device query failed\n"); grid = -1; return; }
        if (hipFuncSetAttribute((const void*)fwd, hipFuncAttributeMaxDynamicSharedMemorySize, LDS_BYTES) != hipSuccess) { fprintf(stderr, "kernel_launch: hipFuncSetAttribute failed\n"); grid = -1; return; }
        if (hipOccupancyMaxActiveBlocksPerMultiprocessor(&per_cu, (const void*)fwd, 512, LDS_BYTES) != hipSuccess || per_cu < 1)
            fprintf(stderr, "kernel_launch: note: occupancy query reports %d workgroups per CU\n", per_cu);
        (void)hipGetLastError();
        if (cus != 256) { fprintf(stderr, "kernel_launch: built for a 256-CU device (got %d); nothing launched\n", cus); grid = -1; return; }
        grid = cus;
    }
    if (grid < 0) return;
    if (hipMemsetAsync((char*)d_ws + WS_CTL, 0, CTL_BYTES, stream) != hipSuccess) { fprintf(stderr, "kernel_launch: memset failed\n"); return; }
    Args a{};
    for (int i = 0; i < 23; ++i) a.in[i] = (const float*)d_in[i];
    a.out = (float*)d_out; a.ws = (unsigned char*)d_ws;
#if MK_PER_PHASE
    for (int p = 0; p < NPH; ++p) { a.ph_lo = p; a.ph_hi = p + 1; hipLaunchKernelGGL(fwd, dim3(grid), dim3(512), LDS_BYTES, stream, a); }
#else
    a.ph_lo = 0; a.ph_hi = NPH; hipLaunchKernelGGL(fwd, dim3(grid), dim3(512), LDS_BYTES, stream, a);
#endif
    const hipError_t le = hipPeekAtLastError();
    if (le != hipSuccess) fprintf(stderr, "kernel_launch: launch failed: %s\n", hipGetErrorName(le));
}
```
